# Optimizing an MI355X kernel written in HIP

```python
import jax, jax.numpy as jnp
from jax import lax
import numpy as np

D_MODEL = 1024
BATCH = 2
SEQ = 8192
DEPTH = 1

HEAD_DIM = 128
ATT_HEADS = 4
DILATED_PAIRS = ((128, 1), (512, 4), (2048, 16))
N_DIL_GROUPS = len(DILATED_PAIRS)
Q_W = N_DIL_GROUPS * ATT_HEADS * HEAD_DIM
KV_W = ATT_HEADS * HEAD_DIM
POOL_WINDOWS = (2, 4, 8, 16)
N_POOL_GROUPS = len(POOL_WINDOWS)
POOL_GROUP_DIM = 128
POOL_W = N_POOL_GROUPS * POOL_GROUP_DIM
MIX_W = KV_W + POOL_W
IN_W = Q_W + 2 * KV_W + POOL_W
BLOCK = 128
ROT_DIM = HEAD_DIM // 4
ROT_HALF = ROT_DIM // 2
ROPE_THETA = 500000.0
N_MEM = 256
X_HEADS = 4
X_W = X_HEADS * HEAD_DIM
D_FF = ((8 * D_MODEL // 3 + 255) // 256) * 256
EPS = 1e-6
NEG_INF = -1e30

kernel_name = "hybrid_pool_dilated_attn_block"


def rms_norm(x, g):
    xf = x.astype(jnp.float32)
    y = xf * lax.rsqrt(jnp.mean(xf * xf, axis=-1, keepdims=True) + EPS)
    return (y * g.astype(jnp.float32)).astype(x.dtype)


def rope_partial(t, cos, sin):
    ex = tuple(range(2, t.ndim - 1))
    c = jnp.expand_dims(cos, ex)
    s = jnp.expand_dims(sin, ex)
    tr = t[..., :ROT_DIM].astype(jnp.float32)
    x1, x2 = tr[..., :ROT_HALF], tr[..., ROT_HALF:]
    rot = jnp.concatenate([x1 * c - x2 * s, x2 * c + x1 * s], axis=-1).astype(t.dtype)
    return jnp.concatenate([rot, t[..., ROT_DIM:]], axis=-1)


def dilated_branch(q, k, v, window, dilation):
    B, S, H, D = q.shape
    n_back = window // dilation
    L = S // dilation
    nb = -(-L // BLOCK)
    Lp = nb * BLOCK

    def to_sub(t):
        t = t.astype(jnp.float32).reshape(B, L, dilation, H, D).transpose(0, 2, 3, 1, 4)
        return jnp.pad(t, ((0, 0), (0, 0), (0, 0), (0, Lp - L), (0, 0)))

    def windows(t):
        tp = jnp.pad(t, ((0, 0), (0, 0), (0, 0), (BLOCK, 0), (0, 0)))
        tp = tp.reshape(B, dilation, H, nb + 1, BLOCK, D)
        return jnp.concatenate([tp[:, :, :, :-1], tp[:, :, :, 1:]], axis=4)

    qb = to_sub(q).reshape(B, dilation, H, nb, BLOCK, D)
    kw = windows(to_sub(k))
    vw = windows(to_sub(v))
    s = jnp.einsum('bdhnqc,bdhnkc->bdhnqk', qb, kw)
    qi = jnp.arange(BLOCK)[:, None]
    kj = jnp.arange(2 * BLOCK)[None, :]
    delta = qi + BLOCK - kj
    key_idx = jnp.arange(nb)[:, None, None] * BLOCK - BLOCK + kj[None]
    valid = (delta >= 0) & (delta <= n_back) & (key_idx >= 0)
    s = jnp.where(valid, s, NEG_INF)
    m = jnp.max(s, axis=-1)
    p = jnp.exp(s - m[..., None])
    l = jnp.sum(p, axis=-1)
    acc = jnp.einsum('bdhnqk,bdhnkc->bdhnqc', p, vw)
    acc = acc.reshape(B, dilation, H, Lp, D)[:, :, :, :L].transpose(0, 3, 1, 2, 4).reshape(B, S, H, D)
    m = m.reshape(B, dilation, H, Lp)[..., :L].transpose(0, 3, 1, 2).reshape(B, S, H)
    l = l.reshape(B, dilation, H, Lp)[..., :L].transpose(0, 3, 1, 2).reshape(B, S, H)
    return acc, m, l


def pool_mixer(u, pool_w, pool_scale):
    B, S, _ = u.shape
    uf = u.astype(jnp.float32).reshape(B, S, N_POOL_GROUPS, POOL_GROUP_DIM)
    c = jnp.cumsum(uf, axis=1)
    t = jnp.arange(S)
    outs = []
    for g, w in enumerate(POOL_WINDOWS):
        cg = c[:, :, g]
        shifted = jnp.pad(cg, ((0, 0), (w, 0), (0, 0)))[:, :S]
        count = jnp.minimum(t + 1, w).astype(jnp.float32)[None, :, None]
        outs.append((cg - shifted) / count - uf[:, :, g])
    d = jnp.stack(outs, axis=2).astype(u.dtype)
    y = jnp.einsum('bsgc,gce->bsge', d, pool_w).reshape(B, S, POOL_W)
    return y * pool_scale


def parallel_mixer(xn, cos, sin, w_in, q_norm_g, k_norm_g, pool_w, pool_scale, w_out):
    B, S, _ = xn.shape
    proj = xn @ w_in
    q, k, v, u = jnp.split(proj, [Q_W, Q_W + KV_W, Q_W + 2 * KV_W], axis=-1)
    q = q.reshape(B, S, N_DIL_GROUPS, ATT_HEADS, HEAD_DIM)
    k = k.reshape(B, S, ATT_HEADS, HEAD_DIM)
    v = v.reshape(B, S, ATT_HEADS, HEAD_DIM)
    q = rope_partial(rms_norm(q, q_norm_g), cos, sin) * (HEAD_DIM ** -0.5)
    k = rope_partial(rms_norm(k, k_norm_g), cos, sin)
    accs, ms, ls = [], [], []
    for g, (window, dilation) in enumerate(DILATED_PAIRS):
        a, m, l = dilated_branch(q[:, :, g], k, v, window, dilation)
        accs.append(a); ms.append(m); ls.append(l)
    ms = jnp.stack(ms)
    wts = jnp.exp(ms - jnp.max(ms, axis=0, keepdims=True))
    num = jnp.sum(wts[..., None] * jnp.stack(accs), axis=0)
    den = jnp.sum(wts * jnp.stack(ls), axis=0)
    attn = (num / den[..., None]).astype(xn.dtype).reshape(B, S, KV_W)
    pooled = pool_mixer(u, pool_w, pool_scale)
    return jnp.concatenate([attn, pooled], axis=-1) @ w_out


def memory_cross_attention(hn, mem_n, w_cq, w_ckv, cq_norm_g, ck_norm_g, w_co):
    B, S, _ = hn.shape
    M = mem_n.shape[1]
    q = (hn @ w_cq).reshape(B, S, X_HEADS, HEAD_DIM)
    k, v = jnp.split(mem_n @ w_ckv, 2, axis=-1)
    k = k.reshape(B, M, X_HEADS, HEAD_DIM)
    v = v.reshape(B, M, X_HEADS, HEAD_DIM)
    q = rms_norm(q, cq_norm_g).astype(jnp.float32) * (HEAD_DIM ** -0.5)
    k = rms_norm(k, ck_norm_g).astype(jnp.float32)
    p = jax.nn.softmax(jnp.einsum('bshd,bmhd->bhsm', q, k), axis=-1)
    o = jnp.einsum('bhsm,bmhd->bshd', p, v.astype(jnp.float32)).astype(hn.dtype)
    return o.reshape(B, S, X_W) @ w_co


def swiglu_ffn(hn, w_gate_up, w_down):
    g, u = jnp.split(hn @ w_gate_up, 2, axis=-1)
    return (jax.nn.silu(g) * u) @ w_down


def setup_inputs(seed: int = 0) -> dict:
    key = jax.random.key(seed)
    ks = jax.random.split(key, 24)
    f32 = jnp.float32

    def w(k, shape, fan_in):
        return jax.random.normal(k, shape, f32) * (fan_in ** -0.5)

    def gain(k, shape):
        return 1.0 + 0.02 * jax.random.normal(k, shape, f32)

    x = jax.random.normal(ks[0], (BATCH, SEQ, D_MODEL), f32)
    mem = jax.random.normal(ks[1], (BATCH, N_MEM, D_MODEL), f32)
    offset = jax.random.randint(ks[2], (BATCH, 1), 0, 4096, dtype=jnp.int32)
    positions = jnp.arange(SEQ, dtype=jnp.int32)[None, :] + offset
    return {
        "x": x,
        "mem": mem,
        "positions": positions,
        "mix_norm_g": gain(ks[3], (DEPTH, D_MODEL)),
        "w_in": w(ks[4], (DEPTH, D_MODEL, IN_W), D_MODEL),
        "q_norm_g": gain(ks[5], (DEPTH, HEAD_DIM)),
        "k_norm_g": gain(ks[6], (DEPTH, HEAD_DIM)),
        "pool_w": w(ks[7], (DEPTH, N_POOL_GROUPS, POOL_GROUP_DIM, POOL_GROUP_DIM), POOL_GROUP_DIM),
        "pool_scale": gain(ks[8], (DEPTH, POOL_W)),
        "w_out": w(ks[9], (DEPTH, MIX_W, D_MODEL), MIX_W),
        "cross_norm_g": gain(ks[10], (DEPTH, D_MODEL)),
        "mem_norm_g": gain(ks[11], (DEPTH, D_MODEL)),
        "w_cq": w(ks[12], (DEPTH, D_MODEL, X_W), D_MODEL),
        "w_ckv": w(ks[13], (DEPTH, D_MODEL, 2 * X_W), D_MODEL),
        "cq_norm_g": gain(ks[14], (DEPTH, HEAD_DIM)),
        "ck_norm_g": gain(ks[15], (DEPTH, HEAD_DIM)),
        "w_co": w(ks[16], (DEPTH, X_W, D_MODEL), X_W),
        "ffn_norm_g": gain(ks[17], (DEPTH, D_MODEL)),
        "w_gate_up": w(ks[18], (DEPTH, D_MODEL, 2 * D_FF), D_MODEL),
        "w_down": w(ks[19], (DEPTH, D_FF, D_MODEL), D_FF),
    }


def reference(x, mem, positions, mix_norm_g, w_in, q_norm_g, k_norm_g, pool_w, pool_scale, w_out,
              cross_norm_g, mem_norm_g, w_cq, w_ckv, cq_norm_g, ck_norm_g, w_co,
              ffn_norm_g, w_gate_up, w_down):
    inv_freq = ROPE_THETA ** (-jnp.arange(0, ROT_DIM, 2, dtype=jnp.float32) / ROT_DIM)
    ang = positions.astype(jnp.float32)[..., None] * inv_freq
    cos, sin = jnp.cos(ang), jnp.sin(ang)
    h = x
    for layer in range(DEPTH):
        h = h + parallel_mixer(rms_norm(h, mix_norm_g[layer]), cos, sin, w_in[layer],
                               q_norm_g[layer], k_norm_g[layer], pool_w[layer],
                               pool_scale[layer], w_out[layer])
        h = h + memory_cross_attention(rms_norm(h, cross_norm_g[layer]),
                                       rms_norm(mem, mem_norm_g[layer]), w_cq[layer],
                                       w_ckv[layer], cq_norm_g[layer], ck_norm_g[layer],
                                       w_co[layer])
        h = h + swiglu_ffn(rms_norm(h, ffn_norm_g[layer]), w_gate_up[layer], w_down[layer])
    return h
```

```cpp
#include <hip/hip_runtime.h>
#include <hip/hip_cooperative_groups.h>
#include <cstdio>
#include <cstdint>
#include <cmath>
namespace cg = cooperative_groups;
namespace pg8 {
#define PG8_LAS __attribute__((address_space(3)))
typedef unsigned short bf16_t;
typedef short bf16x8 __attribute__((ext_vector_type(8)));
typedef float f32x4 __attribute__((ext_vector_type(4)));
typedef unsigned u32x4 __attribute__((ext_vector_type(4)));
constexpr int BM = 256, BK = 64, HALF = 128, HTB = HALF * BK * 2  , STAGE_BYTES = 8 * HTB, NXCD = 8, WGM = 8;

__host__ __device__ __forceinline__ int lds_byte(int r, int c) { const int st = (r >> 4) * 2 + (c >> 5), rr = r & 15, cc = c & 31, ob = rr * 64 + cc * 2; return st * 1024 + (ob ^ (((ob >> 9) & 1) << 5)); }
__host__ __device__ __forceinline__ void stage_rc(int b, int& R, int& C) { const int st = b / 1024, sb = b % 1024, swz = sb ^ (((sb >> 9) & 1) << 5); R = (st >> 1) * 16 + swz / 64; C = (st & 1) * 32 + (swz % 64) / 2; }
__host__ __device__ __forceinline__ int perm32(int rho) { const int n = rho >> 4, i = rho & 15; return 8 * (i >> 2) + 4 * n + (i & 3); }

struct Unit { int pm, pn; };
struct Gemm { const bf16_t* A; const bf16_t* Bt; int M, N, K; };

struct StaticOrder {
    int nM, nN, nwg, G, c;
    __host__ __device__ void init(int M, int N, int G_, int c_) { nM = M / BM; nN = N / BM; nwg = nM * nN; G = G_; c = c_; }
    __host__ __device__ bool next(int i, Unit& u) const {
        const long L = (long)i * G + c; if (L >= nwg) return false;
        int wgid = (int)L; { const int q = nwg / NXCD, r = nwg % NXCD, xcd = wgid % NXCD, off = wgid / NXCD; wgid = (xcd < r ? xcd * (q + 1) : r * (q + 1) + (xcd - r) * q) + off; }
        const int nig = WGM * nN, gid = wgid / nig, fm = gid * WGM, gsz = (nM - fm) < WGM ? (nM - fm) : WGM;
        u.pm = fm + ((wgid % nig) % gsz); u.pn = (wgid % nig) / gsz; return true;
    }
    __device__ __forceinline__ void a_ready(const Unit&) const {}
    __device__ __forceinline__ void done(const Unit&) const {}
};

__device__ __forceinline__ unsigned cvt_pk_bf16(float lo, float hi) { unsigned r; asm volatile("v_cvt_pk_bf16_f32 %0, %1, %2" : "=v"(r) : "v"(lo), "v"(hi)); return r; }
typedef float f32x2 __attribute__((ext_vector_type(2)));
__device__ __forceinline__ int fresh_lane() { int l; asm volatile("v_mbcnt_lo_u32_b32 %0, -1, 0\n\tv_mbcnt_hi_u32_b32 %0, -1, %0" : "=v"(l)); return l; }
template <class Epi, class Sched, bool ALIGN_EPI = false, bool SP2 = false>
__device__ __forceinline__ void gemm_phase(PG8_LAS unsigned char* lds, const Gemm g, const Sched& S, const Epi& E, const int wid) {
    const int lane = fresh_lane(), tid = wid * 64 + lane, wr = wid >> 2, wc = wid & 3, fr = lane & 15, fq = lane >> 4;
    const int K = g.K, nt = K / BK;
    unsigned voffA[2], voffB[2];
#pragma unroll
    for (int i = 0; i < 2; ++i) { int R, C; stage_rc(tid * 16 + i * 8192, R, C); const int Rb = Epi::PERM ? ((R & ~31) + perm32(R & 31)) : R;
        voffA[i] = (unsigned)(R * K + C) * 2u; voffB[i] = (unsigned)(Rb * K + C) * 2u; }
    const size_t kstep = (size_t)(BK * 2);
    const size_t hstep = (size_t)HALF * K * 2;
    const size_t tstep = 2 * hstep;
    const unsigned ldsw = (unsigned)wid * 1024u;
    const int aoff = lds_byte(wr * 64 + fr, fq * 8), boff = lds_byte(wc * 32 + fr, fq * 8);
#define PG8_SA(b, h) (((b) * 2 + (h)) * HTB)
#define PG8_SB(b, h) ((4 + (b) * 2 + (h)) * HTB)
#define PG8_STAGE(bufoff, gbase, voff) do { _Pragma("unroll") for (int _i = 0; _i < 2; ++_i) \
        __builtin_amdgcn_global_load_lds((const unsigned*)((const char*)(gbase) + (voff)[_i]), (PG8_LAS unsigned*)(lds + (bufoff) + ldsw + _i * 8192), 16, 0, 0); } while (0)
#define PG8_LDA(dst, b, h) do { _Pragma("unroll") for (int m = 0; m < 4; ++m) _Pragma("unroll") for (int k = 0; k < 2; ++k) dst[m][k] = *(const PG8_LAS bf16x8*)(lds + PG8_SA(b, h) + aoff + m * 2048 + k * 1024); } while (0)
#define PG8_LDB(dst, b, h) do { _Pragma("unroll") for (int n = 0; n < 2; ++n) _Pragma("unroll") for (int k = 0; k < 2; ++k) dst[n][k] = *(const PG8_LAS bf16x8*)(lds + PG8_SB(b, h) + boff + n * 2048 + k * 1024); } while (0)
#define PG8_MMA(ai, bj, At, Bt) do { __builtin_amdgcn_s_setprio(1); _Pragma("unroll") for (int m = 0; m < 4; ++m) _Pragma("unroll") for (int n = 0; n < 2; ++n) _Pragma("unroll") for (int k = 0; k < 2; ++k) \
        acc[ai][bj][m][n] = __builtin_amdgcn_mfma_f32_16x16x32_bf16(Bt[n][k], At[m][k], acc[ai][bj][m][n], 0, 0, 0); __builtin_amdgcn_s_setprio(0); } while (0)
#define PG8_WAIT_V(n) asm volatile("s_waitcnt vmcnt(" #n ")" ::: "memory")
#define PG8_WAIT_L(n) asm volatile("s_waitcnt lgkmcnt(" #n ")" ::: "memory")
#define PG8_BAR __builtin_amdgcn_s_barrier()
#define PG8_SCHED __builtin_amdgcn_sched_barrier(0)
    Unit cur, nxt; int ui = 0;
    if (!S.next(0, cur)) return;
    f32x4 acc[2][2][4][2];
#pragma unroll
    for (int a = 0; a < 2; ++a)
#pragma unroll
        for (int b = 0; b < 2; ++b)
#pragma unroll
            for (int m = 0; m < 4; ++m)
#pragma unroll
                for (int n = 0; n < 2; ++n) acc[a][b][m][n] = (f32x4){0.f, 0.f, 0.f, 0.f};
    bf16x8 At[4][2], B0[2][2], B1[2][2];
    const char* cA = (const char*)g.A + (size_t)cur.pm * tstep; const char* cB = (const char*)g.Bt + (size_t)cur.pn * tstep;
    S.a_ready(cur);
    if constexpr (SP2) {
        PG8_STAGE(PG8_SB(0, 0), cB, voffB); PG8_STAGE(PG8_SB(0, 1), cB + hstep, voffB); PG8_STAGE(PG8_SA(0, 0), cA, voffA); PG8_STAGE(PG8_SA(0, 1), cA + hstep, voffA);
        if (wr == 1) PG8_BAR;
        PG8_WAIT_V(2); PG8_BAR;
        PG8_STAGE(PG8_SB(1, 0), cB + kstep, voffB); PG8_STAGE(PG8_SA(1, 0), cA + kstep, voffA); PG8_STAGE(PG8_SB(1, 1), cB + hstep + kstep, voffB);
        PG8_WAIT_V(6); PG8_BAR;
    } else {
        PG8_STAGE(PG8_SB(0, 0), cB, voffB); PG8_STAGE(PG8_SA(0, 0), cA, voffA); PG8_STAGE(PG8_SB(0, 1), cB + hstep, voffB); PG8_STAGE(PG8_SA(0, 1), cA + hstep, voffA);
        if (wr == 1) PG8_BAR;
        PG8_WAIT_V(4); PG8_BAR;
        PG8_STAGE(PG8_SB(1, 0), cB + kstep, voffB); PG8_STAGE(PG8_SA(1, 0), cA + kstep, voffA); PG8_STAGE(PG8_SB(1, 1), cB + hstep + kstep, voffB);
        PG8_WAIT_V(6); PG8_BAR;
    }
    for (;;) {
        const bool has_next = S.next(ui + 1, nxt);
        const char* nA = has_next ? (const char*)g.A + (size_t)nxt.pm * tstep : cA; const char* nB = has_next ? (const char*)g.Bt + (size_t)nxt.pn * tstep : cB;
        for (int t = 0; t < nt; t += 2) {
            const bool last = (t == nt - 2);
            const char* a1 = cA + (size_t)(t + 1) * kstep;
            const char* a2 = last ? nA : cA + (size_t)(t + 2) * kstep; const char* b2 = last ? nB : cB + (size_t)(t + 2) * kstep;
            const char* a3 = a2 + kstep; const char* b3 = b2 + kstep;
            if (last && has_next) S.a_ready(nxt);
            if constexpr (SP2) {
            PG8_LDB(B0, 0, 0); PG8_LDB(B1, 0, 1); PG8_SCHED; PG8_LDA(At, 0, 0); PG8_STAGE(PG8_SA(1, 1), a1 + hstep, voffA);
            PG8_WAIT_V(8); PG8_WAIT_L(0); PG8_BAR; PG8_MMA(0, 0, At, B0); PG8_MMA(0, 1, At, B1); PG8_BAR; PG8_SCHED;
            PG8_LDA(At, 0, 1); PG8_STAGE(PG8_SB(0, 0), b2, voffB); PG8_STAGE(PG8_SB(0, 1), b2 + hstep, voffB); PG8_STAGE(PG8_SA(0, 0), a2, voffA);
            PG8_WAIT_V(8); PG8_WAIT_L(0); PG8_BAR; PG8_MMA(1, 0, At, B0); PG8_MMA(1, 1, At, B1); PG8_BAR; PG8_SCHED;
            PG8_LDB(B0, 1, 0); PG8_LDB(B1, 1, 1); PG8_SCHED; PG8_LDA(At, 1, 0); PG8_STAGE(PG8_SA(0, 1), a2 + hstep, voffA);
            PG8_WAIT_V(8); PG8_WAIT_L(0); PG8_BAR; PG8_MMA(0, 0, At, B0); PG8_MMA(0, 1, At, B1); PG8_BAR; PG8_SCHED;
            PG8_LDA(At, 1, 1); PG8_STAGE(PG8_SB(1, 0), b3, voffB); PG8_STAGE(PG8_SB(1, 1), b3 + hstep, voffB); PG8_STAGE(PG8_SA(1, 0), a3, voffA);
            PG8_WAIT_V(8); PG8_WAIT_L(0); PG8_BAR; PG8_MMA(1, 0, At, B0); PG8_MMA(1, 1, At, B1); PG8_BAR; PG8_SCHED;
            } else {
            PG8_LDB(B0, 0, 0); PG8_SCHED; PG8_LDA(At, 0, 0); PG8_STAGE(PG8_SA(1, 1), a1 + hstep, voffA);
            PG8_WAIT_L(8); PG8_BAR; PG8_WAIT_L(0); PG8_MMA(0, 0, At, B0); PG8_BAR; PG8_SCHED;
            PG8_LDB(B1, 0, 1); PG8_STAGE(PG8_SB(0, 0), b2, voffB);
            PG8_BAR; PG8_WAIT_L(0); PG8_MMA(0, 1, At, B1); PG8_BAR;
            PG8_LDA(At, 0, 1); PG8_STAGE(PG8_SA(0, 0), a2, voffA);
            PG8_BAR; PG8_WAIT_L(0); PG8_MMA(1, 0, At, B0); PG8_BAR; PG8_SCHED;
            PG8_STAGE(PG8_SB(0, 1), b2 + hstep, voffB);
            PG8_WAIT_V(6); PG8_BAR; PG8_MMA(1, 1, At, B1); PG8_BAR;
            PG8_LDB(B0, 1, 0); PG8_SCHED; PG8_LDA(At, 1, 0); PG8_STAGE(PG8_SA(0, 1), a2 + hstep, voffA);
            PG8_WAIT_L(8); PG8_BAR; PG8_WAIT_L(0); PG8_MMA(0, 0, At, B0); PG8_BAR; PG8_SCHED;
            PG8_LDB(B1, 1, 1); PG8_STAGE(PG8_SB(1, 0), b3, voffB);
            PG8_BAR; PG8_WAIT_L(0); PG8_MMA(0, 1, At, B1); PG8_BAR;
            PG8_LDA(At, 1, 1); PG8_STAGE(PG8_SA(1, 0), a3, voffA);
            PG8_BAR; PG8_WAIT_L(0); PG8_MMA(1, 0, At, B0); PG8_BAR; PG8_SCHED;
            PG8_STAGE(PG8_SB(1, 1), b3 + hstep, voffB);
            PG8_WAIT_V(6); PG8_BAR; PG8_MMA(1, 1, At, B1); PG8_BAR;
            }
        }
        if constexpr (ALIGN_EPI) { if (wr == 0) PG8_BAR; }
        if constexpr (!Epi::AFTER_DRAIN) { E(acc, cur, wr, wc, fr, fq); S.done(cur); }
        if (!has_next) break;
#pragma unroll
        for (int a = 0; a < 2; ++a)
#pragma unroll
            for (int b = 0; b < 2; ++b)
#pragma unroll
                for (int m = 0; m < 4; ++m)
#pragma unroll
                    for (int n = 0; n < 2; ++n) acc[a][b][m][n] = (f32x4){0.f, 0.f, 0.f, 0.f};
        cur = nxt; cA = nA; cB = nB; ++ui;
        if constexpr (ALIGN_EPI) { if (wr == 1) PG8_BAR; }
    }
    PG8_WAIT_V(0);
    if constexpr (!ALIGN_EPI) { if (wr == 0) PG8_BAR; }
    PG8_BAR;
    if constexpr (Epi::AFTER_DRAIN) { E.fused(acc, cur, wr, wc, fr, fq, lds, wid, lane); S.done(cur); }
#undef PG8_SA
#undef PG8_SB
#undef PG8_STAGE
#undef PG8_LDA
#undef PG8_LDB
#undef PG8_MMA
#undef PG8_WAIT_V
#undef PG8_WAIT_L
#undef PG8_BAR
#undef PG8_SCHED
}
}

namespace pg8 {
__device__ __forceinline__ u32x4 pack8(const f32x4 v0, const f32x4 v1) {
    u32x4 w; w.x = cvt_pk_bf16(v0[0], v0[1]); w.y = cvt_pk_bf16(v0[2], v0[3]); w.z = cvt_pk_bf16(v1[0], v1[1]); w.w = cvt_pk_bf16(v1[2], v1[3]); return w; }
__device__ __forceinline__ float quad_sum(float s) { s += __shfl_xor(s, 16); s += __shfl_xor(s, 32); return s; }
__device__ __forceinline__ float sq8(const f32x4 a, const f32x4 b) { return (a[0] * a[0] + a[1] * a[1]) + (a[2] * a[2] + a[3] * a[3]) + (b[0] * b[0] + b[1] * b[1]) + (b[2] * b[2] + b[3] * b[3]); }
__device__ __forceinline__ float row_rstd16(const float* rs, int row) {
    const f32x4* p = (const f32x4*)(rs + (size_t)row * 16); const f32x4 a = (p[0] + p[1]) + (p[2] + p[3]);
    return rsqrtf(((a[0] + a[1]) + (a[2] + a[3])) * (1.0f / 1024.0f) + 1e-6f); }

struct EpiProj {
    static constexpr bool PERM = true, AFTER_DRAIN = false;
    bf16_t* O; float* ssq; const float* cosT; const float* sinT; const float* gq; const float* gk;
    __device__ __forceinline__ void operator()(const f32x4 (&acc)[2][2][4][2], const Unit& u, int wr, int wc, int fr, int fq) const {
        const int pn = u.pn, row0 = u.pm * BM + wr * 64 + fr, cw = wc * 32 + 8 * fq;
        if (pn >= 8) {
#pragma unroll
            for (int ai = 0; ai < 2; ++ai)
#pragma unroll
                for (int m = 0; m < 4; ++m) { bf16_t* rowp = O + (size_t)(row0 + ai * HALF + m * 16) * 3072 + pn * BM + cw;
#pragma unroll
                    for (int bj = 0; bj < 2; ++bj) *(u32x4*)(rowp + bj * HALF) = pack8(acc[ai][bj][m][0], acc[ai][bj][m][1]); }
        } else {
            const bool isq = pn < 6; const float* g = isq ? gq : gk;
            const f32x4 g0 = *(const f32x4*)(g + cw), g1 = *(const f32x4*)(g + cw + 4);
            const float sc = isq ? 0.08838834764831845f : 1.0f;
            const float sg = (fq < 2) ? -1.0f : 1.0f;
#pragma unroll
            for (int ai = 0; ai < 2; ++ai)
#pragma unroll
                for (int m = 0; m < 4; ++m) { const int row = row0 + ai * HALF + m * 16;
                    f32x4 c0 = {0.f, 0.f, 0.f, 0.f}, c1 = c0, s0 = c0, s1 = c0;
                    if (wc == 0) { const float* cp = cosT + (size_t)row * 16 + 8 * (fq & 1); const float* sp = sinT + (size_t)row * 16 + 8 * (fq & 1);
                        c0 = *(const f32x4*)cp; c1 = *(const f32x4*)(cp + 4); s0 = *(const f32x4*)sp; s1 = *(const f32x4*)(sp + 4); }
                    bf16_t* rowp = O + (size_t)row * 3072 + pn * BM + cw;
#pragma unroll
                    for (int bj = 0; bj < 2; ++bj) { f32x4 v0 = acc[ai][bj][m][0], v1 = acc[ai][bj][m][1];
                        const float ss = quad_sum(sq8(v0, v1));
                        if (fq == 0) ssq[(size_t)row * 64 + (pn * 2 + bj) * 4 + wc] = ss;
                        v0 = v0 * g0; v1 = v1 * g1;
                        if (wc == 0) { f32x4 p0, p1;
#pragma unroll
                            for (int j = 0; j < 4; ++j) { p0[j] = __shfl_xor(v0[j], 32); p1[j] = __shfl_xor(v1[j], 32); }
                            v0 = v0 * c0 + (p0 * s0) * sg; v1 = v1 * c1 + (p1 * s1) * sg; }
                        v0 = v0 * sc; v1 = v1 * sc;
                        *(u32x4*)(rowp + bj * HALF) = pack8(v0, v1); } }
        }
    }
};
struct EpiRes {
    static constexpr bool PERM = true, AFTER_DRAIN = false;
    const float* base; float* outF; bf16_t* outB; float* rs;
    __device__ __forceinline__ void operator()(const f32x4 (&acc)[2][2][4][2], const Unit& u, int wr, int wc, int fr, int fq) const {
        const int row0 = u.pm * BM + wr * 64 + fr, col0 = u.pn * BM + wc * 32 + 8 * fq;
#pragma unroll
        for (int ai = 0; ai < 2; ++ai)
#pragma unroll
            for (int m = 0; m < 4; ++m) { const int row = row0 + ai * HALF + m * 16; const size_t off = (size_t)row * 1024 + col0; float ss = 0.f;
#pragma unroll
                for (int bj = 0; bj < 2; ++bj) { const float* bp = base + off + bj * HALF;
                    const f32x4 v0 = acc[ai][bj][m][0] + *(const f32x4*)bp, v1 = acc[ai][bj][m][1] + *(const f32x4*)(bp + 4);
                    *(f32x4*)(outF + off + bj * HALF) = v0; *(f32x4*)(outF + off + bj * HALF + 4) = v1;
                    if (outB) *(u32x4*)(outB + off + bj * HALF) = pack8(v0, v1);
                    ss += sq8(v0, v1); }
                if (rs) { ss = quad_sum(ss); if (fq == 0) rs[(size_t)row * 16 + u.pn * 4 + wc] = ss; } }
    }
};
struct EpiCq {
    static constexpr bool PERM = true, AFTER_DRAIN = false;
    const float* rs1; bf16_t* O; float* ssqc; const float* g;
    __device__ __forceinline__ void operator()(const f32x4 (&acc)[2][2][4][2], const Unit& u, int wr, int wc, int fr, int fq) const {
        const int row0 = u.pm * BM + wr * 64 + fr, cw = wc * 32 + 8 * fq;
        const f32x4 g0 = *(const f32x4*)(g + cw) * 0.08838834764831845f, g1 = *(const f32x4*)(g + cw + 4) * 0.08838834764831845f;
#pragma unroll
        for (int ai = 0; ai < 2; ++ai)
#pragma unroll
            for (int m = 0; m < 4; ++m) { const int row = row0 + ai * HALF + m * 16; const float rstd = row_rstd16(rs1, row);
                bf16_t* rowp = O + (size_t)row * 512 + u.pn * BM + cw;
#pragma unroll
                for (int bj = 0; bj < 2; ++bj) { f32x4 v0 = acc[ai][bj][m][0] * rstd, v1 = acc[ai][bj][m][1] * rstd;
                    const float ss = quad_sum(sq8(v0, v1));
                    if (fq == 0) ssqc[(size_t)row * 16 + (u.pn * 2 + bj) * 4 + wc] = ss;
                    *(u32x4*)(rowp + bj * HALF) = pack8(v0 * g0, v1 * g1); } }
    }
};
struct EpiKv {
    static constexpr bool PERM = true, AFTER_DRAIN = false;
    bf16_t* O; float* ssqm; const float* g;
    __device__ __forceinline__ void operator()(const f32x4 (&acc)[2][2][4][2], const Unit& u, int wr, int wc, int fr, int fq) const {
        const int row0 = u.pm * BM + wr * 64 + fr, cw = wc * 32 + 8 * fq; const bool isk = u.pn < 2;
        f32x4 g0 = {1.f, 1.f, 1.f, 1.f}, g1 = g0;
        if (isk) { g0 = *(const f32x4*)(g + cw); g1 = *(const f32x4*)(g + cw + 4); }
#pragma unroll
        for (int ai = 0; ai < 2; ++ai)
#pragma unroll
            for (int m = 0; m < 4; ++m) { const int row = row0 + ai * HALF + m * 16; bf16_t* rowp = O + (size_t)row * 1024 + u.pn * BM + cw;
#pragma unroll
                for (int bj = 0; bj < 2; ++bj) { const f32x4 v0 = acc[ai][bj][m][0], v1 = acc[ai][bj][m][1];
                    if (isk) { const float ss = quad_sum(sq8(v0, v1)); if (fq == 0) ssqm[(size_t)row * 16 + (u.pn * 2 + bj) * 4 + wc] = ss; }
                    *(u32x4*)(rowp + bj * HALF) = pack8(v0 * g0, v1 * g1); } }
    }
};
struct EpiSwiglu {
    static constexpr bool PERM = true, AFTER_DRAIN = false;
    const float* rs2; bf16_t* act;
    __device__ __forceinline__ void operator()(const f32x4 (&acc)[2][2][4][2], const Unit& u, int wr, int wc, int fr, int fq) const {
        const int row0 = u.pm * BM + wr * 64 + fr, cw = wc * 32 + 8 * fq;
#pragma unroll
        for (int ai = 0; ai < 2; ++ai)
#pragma unroll
            for (int m = 0; m < 4; ++m) { const int row = row0 + ai * HALF + m * 16; const float rstd = row_rstd16(rs2, row);
                f32x4 a[2];
#pragma unroll
                for (int n = 0; n < 2; ++n) { const f32x4 gg = acc[ai][0][m][n] * rstd, uu = acc[ai][1][m][n] * rstd;
#pragma unroll
                    for (int j = 0; j < 4; ++j) a[n][j] = gg[j] * __builtin_amdgcn_rcpf(1.0f + __expf(-gg[j])) * uu[j]; }
                *(u32x4*)(act + (size_t)row * 2816 + u.pn * HALF + cw) = pack8(a[0], a[1]); }
    }
};
}

#define LAS __attribute__((address_space(3)))
typedef unsigned short bf16_t;
typedef short bf16x8 __attribute__((ext_vector_type(8)));
typedef short s16x4 __attribute__((ext_vector_type(4)));
typedef float f32x4 __attribute__((ext_vector_type(4)));
typedef unsigned u32x4 __attribute__((ext_vector_type(4)));
typedef unsigned u32x2 __attribute__((ext_vector_type(2)));
constexpr int M = 16384, SEQ = 8192, DM = 1024, INW = 3072, DFF = 2816, NMEM = 256;
constexpr size_t MiB = 1u << 20;
constexpr size_t WS_WIN = 1 * MiB, WS_WOUT = 7 * MiB, WS_WCQ = 9 * MiB, WS_WCKV = 10 * MiB, WS_WCO = 12 * MiB, WS_WGU = 13 * MiB, WS_WDN = 24 * MiB;
constexpr size_t WS_SSQ = 30 * MiB, WS_COS = 34 * MiB, WS_SIN = 35 * MiB, WS_RS1 = 36 * MiB, WS_RS2 = 37 * MiB, WS_SSQC = 38 * MiB, WS_MEMN = 39 * MiB, WS_MEMKV = 40 * MiB, WS_SSQM = 41 * MiB, WS_ML = 42 * MiB;
constexpr size_t WS_A = 48 * MiB;
constexpr size_t WS_B = 80 * MiB;
constexpr size_t WS_OG = 80 * MiB;
constexpr size_t WS_QC = 112 * MiB, WS_OC = 128 * MiB;
constexpr size_t WS_BIG = 144 * MiB;
constexpr size_t WS_END = 240 * MiB;
constexpr int LDS_BYTES = 149504;
constexpr int KST = 288, A_KOFF = 0, A_VOFF = 256 * KST, A_RKOFF = 2 * 256 * KST;
static_assert(A_RKOFF + 1024 <= LDS_BYTES && pg8::STAGE_BYTES <= LDS_BYTES, "LDS map");

struct Args { const float* in[20]; float* out; unsigned char* ws; float invf[16]; };

__device__ __forceinline__ float wave_sum(float v) {
#pragma unroll
    for (int o = 1; o < 64; o <<= 1) v += __shfl_xor(v, o);
    return v;
}
__device__ __forceinline__ float bf_lo(unsigned w) { return __uint_as_float(w << 16); }
__device__ __forceinline__ float bf_hi(unsigned w) { return __uint_as_float(w & 0xffff0000u); }
__device__ __forceinline__ void unpack8(const u32x4 w, float (&f)[8]) { f[0] = bf_lo(w.x); f[1] = bf_hi(w.x); f[2] = bf_lo(w.y); f[3] = bf_hi(w.y); f[4] = bf_lo(w.z); f[5] = bf_hi(w.z); f[6] = bf_lo(w.w); f[7] = bf_hi(w.w); }

template <int MODE>
__device__ __forceinline__ void tr_item(const float* W, int Nsrc, int Ndst, const float* gain, bf16_t* WT, int ldt, LAS float* scr, int item, int lane) {
    const int nblk = Ndst / 32, kb = item / nblk, nb = item % nblk, k0 = 64 * kb, n0 = 32 * nb;
    const int s0 = MODE == 1 ? (((n0 >> 7) & 1) * DFF + (n0 >> 8) * 128 + (n0 & 127)) : n0;
#pragma unroll 8
    for (int i = 0; i < 32; ++i) { const int kk = 2 * i + (lane >> 5); float w = W[(size_t)(k0 + kk) * Nsrc + s0 + (lane & 31)]; if (gain) w *= gain[k0 + kk]; scr[kk * 33 + (lane & 31)] = w; }
    asm volatile("s_waitcnt lgkmcnt(0)" ::: "memory");
    const int c = lane & 7;
#pragma unroll
    for (int j = 0; j < 4; ++j) { const int n = (lane >> 3) + 8 * j; const LAS float* s = scr + (8 * c) * 33 + n;
        u32x4 o; o.x = pg8::cvt_pk_bf16(s[0 * 33], s[1 * 33]); o.y = pg8::cvt_pk_bf16(s[2 * 33], s[3 * 33]); o.z = pg8::cvt_pk_bf16(s[4 * 33], s[5 * 33]); o.w = pg8::cvt_pk_bf16(s[6 * 33], s[7 * 33]);
        *(u32x4*)(WT + (size_t)(n0 + n) * ldt + k0 + 8 * c) = o; }
    asm volatile("s_waitcnt lgkmcnt(0)" ::: "memory");
}
__device__ __forceinline__ void rms_row(const float* xrow, const float* g, bf16_t* orow, int lane) {
    const f32x4* xr = (const f32x4*)xrow + lane; const f32x4* gr = (const f32x4*)g + lane;
    f32x4 v[4]; float s = 0.f;
#pragma unroll
    for (int j = 0; j < 4; ++j) { v[j] = xr[64 * j]; s += (v[j][0] * v[j][0] + v[j][1] * v[j][1]) + (v[j][2] * v[j][2] + v[j][3] * v[j][3]); }
    const float rstd = rsqrtf(wave_sum(s) * (1.0f / 1024.0f) + 1e-6f);
    u32x2* o8 = (u32x2*)orow + lane;
#pragma unroll
    for (int j = 0; j < 4; ++j) { const f32x4 y = v[j] * rstd * gr[64 * j]; u32x2 w; w.x = pg8::cvt_pk_bf16(y[0], y[1]); w.y = pg8::cvt_pk_bf16(y[2], y[3]); o8[64 * j] = w; }
}
__device__ __forceinline__ void sincos_d(float ang, float& s, float& c) {
    const double x = (double)ang; const double kq = rint(x * 0.63661977236758134308);
    const double r = (x - kq * 1.5707963267948966192) - kq * 6.123233995736766036e-17; const double r2 = r * r;
    double sp = -7.6471637318198164759e-13; sp = sp * r2 + 1.6059043836821614599e-10; sp = sp * r2 - 2.5052108385441718775e-08; sp = sp * r2 + 2.7557319223985890653e-06;
    sp = sp * r2 - 1.9841269841269841270e-04; sp = sp * r2 + 8.3333333333333333333e-03; sp = sp * r2 - 1.6666666666666666667e-01; sp = r + r * r2 * sp;
    double cp = 4.7794773323873852974e-14; cp = cp * r2 - 1.1470745597729724714e-11; cp = cp * r2 + 2.0876756987868098979e-09; cp = cp * r2 - 2.7557319223985890653e-07;
    cp = cp * r2 + 2.4801587301587301587e-05; cp = cp * r2 - 1.3888888888888888889e-03; cp = cp * r2 + 4.1666666666666666667e-02; cp = cp * r2 - 0.5; cp = 1.0 + r2 * cp;
    const int q = (int)((long long)kq & 3);
    const double sv = (q & 1) ? cp : sp, cv = (q & 1) ? sp : cp;
    s = (float)((q & 2) ? -sv : sv); c = (float)(((q + 1) & 2) ? -cv : cv);
}

__device__ __forceinline__ s16x4 vtr(LAS unsigned char* p) { return __builtin_bit_cast(s16x4, __builtin_amdgcn_ds_read_tr16_b64_v4i16((LAS s16x4*)p)); }
template <int NT, bool MASK>
__device__ __forceinline__ void attn_unit(LAS unsigned char* lds, const bf16_t* qb, long qstep, const float* sq, long sqstep,
                                          const bf16_t* kb, const bf16_t* vb, long kstep, int ks0, const float* sk, long skstep,
                                          bf16_t* ob, long ostep, float* ml, long mlstep, bool nb0, int tid, int lane, int wave) {
    {
        const int c = tid & 15, rr = tid >> 4;
        u32x4 kr[8], vr[8];
#pragma unroll
        for (int it = 0; it < 8; ++it) { int sidx = ks0 + rr + 32 * it; sidx = sidx < 0 ? 0 : sidx; const long off = (long)sidx * kstep + 8 * c;
            kr[it] = *(const u32x4*)(kb + off); vr[it] = *(const u32x4*)(vb + off); }
#pragma unroll
        for (int it = 0; it < 8; ++it) { const int row = rr + 32 * it;
            *(LAS u32x4*)(lds + A_KOFF + row * KST + c * 16) = kr[it]; *(LAS u32x4*)(lds + A_VOFF + row * KST + c * 16) = vr[it]; }
        if (tid < 256) { int sidx = ks0 + tid; sidx = sidx < 0 ? 0 : sidx; const f32x4 p = *(const f32x4*)(sk + (long)sidx * skstep);
            ((LAS float*)(lds + A_RKOFF))[tid] = rsqrtf(((p[0] + p[1]) + (p[2] + p[3])) * (1.0f / 128.0f) + 1e-6f); }
    }
    const int fr = lane & 15, fq = lane >> 4, qi = wave * 16 + fr;
    bf16x8 qf[4];
#pragma unroll
    for (int ks = 0; ks < 4; ++ks) qf[ks] = *(const bf16x8*)(qb + (long)qi * qstep + 32 * ks + 8 * fq);
    float rq; { const f32x4 p = *(const f32x4*)(sq + (long)qi * sqstep); rq = rsqrtf(((p[0] + p[1]) + (p[2] + p[3])) * (1.0f / 128.0f) + 1e-6f); }
    __syncthreads();
    const int ts = MASK ? (wave < 6 ? wave : 6) : 0;
    f32x4 s[NT];
#pragma unroll
    for (int tt = 0; tt < NT; ++tt) { s[tt] = (f32x4){0.f, 0.f, 0.f, 0.f};
#pragma unroll
        for (int ks = 0; ks < 4; ++ks) { const bf16x8 kf = *(const LAS bf16x8*)(lds + A_KOFF + (16 * (ts + tt) + fr) * KST + (32 * ks + 8 * fq) * 2);
            s[tt] = __builtin_amdgcn_mfma_f32_16x16x32_bf16(kf, qf[ks], s[tt], 0, 0, 0); } }
    float mx = -3.0e38f;
#pragma unroll
    for (int tt = 0; tt < NT; ++tt) { const f32x4 rk4 = *(const LAS f32x4*)(lds + A_RKOFF + (16 * (ts + tt) + 4 * fq) * 4);
#pragma unroll
        for (int j = 0; j < 4; ++j) { const int kj = 16 * (ts + tt) + 4 * fq + j; float v = s[tt][j] * rq * rk4[j];
            if (MASK) { const bool valid = (kj >= qi) && (kj <= qi + 128) && (!nb0 || kj >= 128); v = valid ? v : -1.0e30f; }
            s[tt][j] = v; mx = fmaxf(mx, v); } }
    mx = fmaxf(mx, __shfl_xor(mx, 16)); mx = fmaxf(mx, __shfl_xor(mx, 32));
    float l = 0.f;
#pragma unroll
    for (int tt = 0; tt < NT; ++tt)
#pragma unroll
        for (int j = 0; j < 4; ++j) { const float p = __expf(s[tt][j] - mx); s[tt][j] = p; l += p; }
    l = pg8::quad_sum(l);
    f32x4 o[8];
#pragma unroll
    for (int dt = 0; dt < 8; ++dt) o[dt] = (f32x4){0.f, 0.f, 0.f, 0.f};
    const int q4 = fr >> 2, p4 = fr & 3;
#pragma unroll
    for (int pr = 0; pr < NT / 2; ++pr) { const bf16x8 pf = __builtin_bit_cast(bf16x8, pg8::pack8(s[2 * pr], s[2 * pr + 1]));
        LAS unsigned char* v0p = lds + A_VOFF + (16 * (ts + 2 * pr) + 4 * fq + q4) * KST + 8 * p4;
#pragma unroll
        for (int dt = 0; dt < 8; ++dt) { const s16x4 a0 = vtr(v0p + 32 * dt), a1 = vtr(v0p + 16 * KST + 32 * dt);
            const bf16x8 vf = __builtin_shufflevector(a0, a1, 0, 1, 2, 3, 4, 5, 6, 7);
            o[dt] = __builtin_amdgcn_mfma_f32_16x16x32_bf16(vf, pf, o[dt], 0, 0, 0); } }
    const float inv = 1.0f / l;
#pragma unroll
    for (int dt = 0; dt < 8; ++dt) { u32x2 w; w.x = pg8::cvt_pk_bf16(o[dt][0] * inv, o[dt][1] * inv); w.y = pg8::cvt_pk_bf16(o[dt][2] * inv, o[dt][3] * inv);
        *(u32x2*)(ob + (long)qi * ostep + 16 * dt + 4 * fq) = w; }
    if (ml && fq == 0) { ml[(long)qi * mlstep] = mx; ml[(long)qi * mlstep + 1] = l; }
    __syncthreads();
}

__global__ void __launch_bounds__(512) fwd(Args a) {
    extern __shared__ __attribute__((aligned(16))) unsigned char lds_raw[];
    LAS unsigned char* lds = (LAS unsigned char*)lds_raw;
    cg::grid_group grid = cg::this_grid();
    const int wave = __builtin_amdgcn_readfirstlane(threadIdx.x >> 6);
    const int G = gridDim.x, bx = blockIdx.x;
    unsigned char* ws = a.ws;
    const float* x = a.in[0]; const float* mem = a.in[1]; const int* pos = (const int*)a.in[2];
    bf16_t* Win = (bf16_t*)(ws + WS_WIN); bf16_t* Wout = (bf16_t*)(ws + WS_WOUT); bf16_t* Wcq = (bf16_t*)(ws + WS_WCQ); bf16_t* Wckv = (bf16_t*)(ws + WS_WCKV);
    bf16_t* Wco = (bf16_t*)(ws + WS_WCO); bf16_t* Wgu = (bf16_t*)(ws + WS_WGU); bf16_t* Wdn = (bf16_t*)(ws + WS_WDN);
    float* SSQ = (float*)(ws + WS_SSQ); float* COS = (float*)(ws + WS_COS); float* SIN = (float*)(ws + WS_SIN); float* RS1 = (float*)(ws + WS_RS1); float* RS2 = (float*)(ws + WS_RS2);
    float* SSQC = (float*)(ws + WS_SSQC); bf16_t* MEMN = (bf16_t*)(ws + WS_MEMN); bf16_t* MEMKV = (bf16_t*)(ws + WS_MEMKV); float* SSQM = (float*)(ws + WS_SSQM); float* ML = (float*)(ws + WS_ML);
    bf16_t* BA = (bf16_t*)(ws + WS_A); bf16_t* BB = (bf16_t*)(ws + WS_B); bf16_t* OG = (bf16_t*)(ws + WS_OG); bf16_t* QC = (bf16_t*)(ws + WS_QC); bf16_t* OC = (bf16_t*)(ws + WS_OC);
    bf16_t* BIG = (bf16_t*)(ws + WS_BIG);

    {
        const int lane = pg8::fresh_lane(), tid = wave * 64 + lane;
        LAS float* scr = (LAS float*)(lds + wave * 16384);
        const int gw = bx * 8 + wave, NGW = G * 8;
        constexpr int I_IN = 16 * 96, I_OUT = 8 * 32, I_CQ = 16 * 16, I_CKV = 16 * 32, I_CO = 8 * 32, I_GU = 16 * 176, I_DN = 44 * 32;
        constexpr int NITEMS = I_IN + I_OUT + I_CQ + I_CKV + I_CO + I_GU + I_DN;
        for (int it = gw; it < NITEMS; it += NGW) {
            int r = it;
            if (r < I_IN) { tr_item<0>(a.in[4], INW, INW, nullptr, Win, 1024, scr, r, lane); continue; } r -= I_IN;
            if (r < I_OUT) { tr_item<0>(a.in[9], 1024, 1024, nullptr, Wout, 1024, scr, r, lane); continue; } r -= I_OUT;
            if (r < I_CQ) { tr_item<0>(a.in[12], 512, 512, a.in[10], Wcq, 1024, scr, r, lane); continue; } r -= I_CQ;
            if (r < I_CKV) { tr_item<0>(a.in[13], 1024, 1024, nullptr, Wckv, 1024, scr, r, lane); continue; } r -= I_CKV;
            if (r < I_CO) { tr_item<0>(a.in[16], 1024, 1024, nullptr, Wco, 512, scr, r, lane); continue; } r -= I_CO;
            if (r < I_GU) { tr_item<1>(a.in[18], 2 * DFF, 2 * DFF, a.in[17], Wgu, 1024, scr, r, lane); continue; } r -= I_GU;
            tr_item<0>(a.in[19], 1024, 1024, nullptr, Wdn, DFF, scr, r, lane);
        }
        {
            const float* pw = a.in[7]; const float* psc = a.in[8]; const float* wo = a.in[9];
            for (int idx = bx * 512 + tid; idx < 512 * 1024; idx += G * 512) { const int n = idx & 1023, kc = idx >> 10, g = kc >> 7;
                const float* pr = pw + (size_t)kc * 128; const float* sc = psc + g * 128; const float* wr_ = wo + (size_t)(512 + g * 128) * 1024 + n; float acc = 0.f;
#pragma unroll 8
                for (int e = 0; e < 128; ++e) acc += pr[e] * sc[e] * wr_[(size_t)e * 1024];
                Wout[(size_t)n * 1024 + 512 + kc] = (bf16_t)(pg8::cvt_pk_bf16(acc, 0.f) & 0xffffu); }
        }
        for (int m = gw; m < M + 512; m += NGW) {
            if (m < M) rms_row(x + (size_t)m * DM, a.in[3], BA + (size_t)m * DM, lane);
            else rms_row(mem + (size_t)(m - M) * DM, a.in[11], MEMN + (size_t)(m - M) * DM, lane);
        }
        for (int idx = bx * 512 + tid; idx < M * 16; idx += G * 512) { const int row = idx >> 4, i = idx & 15;
            const float ang = (float)pos[row] * a.invf[i]; float s, c; sincos_d(ang, s, c); COS[idx] = c; SIN[idx] = s; }
    }
    grid.sync();

    {
        pg8::Gemm g{BA, Win, M, INW, 1024}; pg8::StaticOrder S; S.init(M, INW, G, bx);
        pg8::EpiProj E{BIG, SSQ, COS, SIN, a.in[5], a.in[6]};
        pg8::gemm_phase<pg8::EpiProj, pg8::StaticOrder, true, true>(lds, g, S, E, wave);
    }
    grid.sync();

    { const int lane = pg8::fresh_lane(), tid = wave * 64 + lane;
    for (int u = bx; u < 1536; u += G) {
        const int g = u >> 9, rem = u & 511, b = rem >> 8, rem2 = rem & 255, h = rem2 & 3, blk = rem2 >> 2;
        const int dil = 1 << (2 * g), nbs = 64 >> (2 * g), r = blk / nbs, nb = blk % nbs;
        const long row0 = (long)b * SEQ + r;
        const long qrow = row0 + (long)dil * 128 * nb;
        attn_unit<10, true>(lds, BIG + qrow * INW + (g * 4 + h) * 128, (long)dil * INW, SSQ + qrow * 64 + (g * 4 + h) * 4, (long)dil * 64,
                            BIG + row0 * INW + 1536 + h * 128, BIG + row0 * INW + 2048 + h * 128, (long)dil * INW, 128 * (nb - 1), SSQ + row0 * 64 + (12 + h) * 4, (long)dil * 64,
                            OG + (size_t)g * M * 512 + qrow * 512 + h * 128, (long)dil * 512, ML + (((size_t)g * M + qrow) * 4 + h) * 2, (long)dil * 8, nb == 0, tid, lane, wave);
    } }
    grid.sync();

    { const int lane = pg8::fresh_lane(), tid = wave * 64 + lane;
    for (long idx = (long)bx * 512 + tid; idx < (long)M * 128; idx += (long)G * 512) {
        const int row = (int)(idx >> 7), c = (int)(idx & 127);
        if (c < 64) { const int h = c >> 4; float mm[3], ll[3];
#pragma unroll
            for (int g = 0; g < 3; ++g) { const float* p = ML + (((size_t)g * M + row) * 4 + h) * 2; mm[g] = p[0]; ll[g] = p[1]; }
            const float mmax = fmaxf(mm[0], fmaxf(mm[1], mm[2])); float w[3], den = 0.f;
#pragma unroll
            for (int g = 0; g < 3; ++g) { w[g] = __expf(mm[g] - mmax) * ll[g]; den += w[g]; }
            const float inv = 1.0f / den; float o[8];
#pragma unroll
            for (int j = 0; j < 8; ++j) o[j] = 0.f;
#pragma unroll
            for (int g = 0; g < 3; ++g) { float f[8]; unpack8(*(const u32x4*)(OG + (size_t)g * M * 512 + (size_t)row * 512 + c * 8), f); const float wg = w[g] * inv;
#pragma unroll
                for (int j = 0; j < 8; ++j) o[j] += wg * f[j]; }
            *(u32x4*)(BA + (size_t)row * DM + c * 8) = pg8::pack8((f32x4){o[0], o[1], o[2], o[3]}, (f32x4){o[4], o[5], o[6], o[7]});
        } else { const int cc = c - 64, gp = cc >> 4, w = 2 << gp, t = row & (SEQ - 1); const int cnt = (t + 1) < w ? (t + 1) : w;
            const bf16_t* up = BIG + (size_t)row * INW + 2560 + cc * 8; float f0[8], sum[8]; unpack8(*(const u32x4*)up, f0);
#pragma unroll
            for (int j = 0; j < 8; ++j) sum[j] = f0[j];
            for (int i = 1; i < cnt; ++i) { float f[8]; unpack8(*(const u32x4*)(up - (size_t)i * INW), f);
#pragma unroll
                for (int j = 0; j < 8; ++j) sum[j] += f[j]; }
            const float ic = 1.0f / (float)cnt; float d[8];
#pragma unroll
            for (int j = 0; j < 8; ++j) d[j] = sum[j] * ic - f0[j];
            *(u32x4*)(BA + (size_t)row * DM + 512 + cc * 8) = pg8::pack8((f32x4){d[0], d[1], d[2], d[3]}, (f32x4){d[4], d[5], d[6], d[7]});
        }
    } }
    grid.sync();

    {
        pg8::Gemm g{BA, Wout, M, 1024, 1024}; pg8::StaticOrder S; S.init(M, 1024, G, bx);
        pg8::EpiRes E{x, a.out, BB, RS1};
        pg8::gemm_phase<pg8::EpiRes, pg8::StaticOrder, true, true>(lds, g, S, E, wave);
    }
    grid.sync();

    {
        const bool split = G >= 136;
        if (!split || bx < G - 8) {
            pg8::Gemm g{BB, Wcq, M, 512, 1024}; pg8::StaticOrder S; S.init(M, 512, split ? G - 8 : G, bx);
            pg8::EpiCq E{RS1, QC, SSQC, a.in[14]};
            pg8::gemm_phase<pg8::EpiCq, pg8::StaticOrder, true, true>(lds, g, S, E, wave);
        }
        if (!split || bx >= G - 8) {
            pg8::Gemm g{MEMN, Wckv, 512, 1024, 1024}; pg8::StaticOrder S; S.init(512, 1024, split ? 8 : G, split ? bx - (G - 8) : bx);
            pg8::EpiKv E{MEMKV, SSQM, a.in[15]};
            pg8::gemm_phase<pg8::EpiKv, pg8::StaticOrder, true, true>(lds, g, S, E, wave);
        }
    }
    grid.sync();

    { const int lane = pg8::fresh_lane(), tid = wave * 64 + lane;
    for (int u = bx; u < 512; u += G) {
        const int h = u & 3, qb = u >> 2, b = qb >> 6; const long qrow = (long)qb * 128;
        attn_unit<16, false>(lds, QC + qrow * 512 + h * 128, 512, SSQC + qrow * 16 + h * 4, 16,
                             MEMKV + (size_t)b * NMEM * 1024 + h * 128, MEMKV + (size_t)b * NMEM * 1024 + 512 + h * 128, 1024, 0, SSQM + (size_t)b * NMEM * 16 + h * 4, 16,
                             OC + qrow * 512 + h * 128, 512, nullptr, 0, false, tid, lane, wave);
    } }
    grid.sync();

    {
        pg8::Gemm g{OC, Wco, M, 1024, 512}; pg8::StaticOrder S; S.init(M, 1024, G, bx);
        pg8::EpiRes E{a.out, a.out, BA, RS2};
        pg8::gemm_phase<pg8::EpiRes, pg8::StaticOrder, true, true>(lds, g, S, E, wave);
    }
    grid.sync();

    {
        pg8::Gemm g{BA, Wgu, M, 2 * DFF, 1024}; pg8::StaticOrder S; S.init(M, 2 * DFF, G, bx);
        pg8::EpiSwiglu E{RS2, BIG};
        pg8::gemm_phase<pg8::EpiSwiglu, pg8::StaticOrder, true, true>(lds, g, S, E, wave);
    }
    grid.sync();

    {
        pg8::Gemm g{BIG, Wdn, M, 1024, DFF}; pg8::StaticOrder S; S.init(M, 1024, G, bx);
        pg8::EpiRes E{a.out, a.out, nullptr, nullptr};
        pg8::gemm_phase<pg8::EpiRes, pg8::StaticOrder, true, true>(lds, g, S, E, wave);
    }
}

extern "C" void kernel_launch(void* const* d_in, const int* in_sizes, int n_in, void* d_out, int out_size, void* d_ws, size_t ws_size, hipStream_t stream) {
    static int grid_blocks = 0;
    if (grid_blocks == 0) {
        if (n_in != 20 || ws_size < WS_END) { fprintf(stderr, "kernel_launch: unexpected inputs (n_in %d, ws %zu)\n", n_in, ws_size); grid_blocks = -1; return; }
        int dev = 0, cus = 0, per_cu = 0;
        hipGetDevice(&dev); hipDeviceGetAttribute(&cus, hipDeviceAttributeMultiprocessorCount, dev);
        if (hipFuncSetAttribute((const void*)fwd, hipFuncAttributeMaxDynamicSharedMemorySize, LDS_BYTES) != hipSuccess) { fprintf(stderr, "kernel_launch: hipFuncSetAttribute failed\n"); }
        if (hipOccupancyMaxActiveBlocksPerMultiprocessor(&per_cu, (const void*)fwd, 512, LDS_BYTES) != hipSuccess || per_cu < 1) { fprintf(stderr, "kernel_launch: occupancy query says %d\n", per_cu); per_cu = 1; }
        (void)hipGetLastError();
        grid_blocks = cus * 1;
        if (grid_blocks < 1) grid_blocks = 1;
    }
    if (grid_blocks < 0) return;
    Args a{};
    for (int i = 0; i < 20; ++i) a.in[i] = (const float*)d_in[i];
    a.out = (float*)d_out; a.ws = (unsigned char*)d_ws;
    for (int i = 0; i < 16; ++i) a.invf[i] = (float)std::pow(500000.0, -(double)i / 16.0);
    void* args[] = {&a};
    hipError_t e = hipLaunchCooperativeKernel((const void*)fwd, dim3(grid_blocks), dim3(512), args, LDS_BYTES, stream);
    if (e != hipSuccess) fprintf(stderr, "cooperative launch failed: %s (grid %d)\n", hipGetErrorString(e), grid_blocks);
}
```

```cpp
#include <hip/hip_runtime.h>
#include <hip/hip_cooperative_groups.h>
#include <cstdio>
#include <cstdint>
#include <cmath>
namespace cg = cooperative_groups;
namespace pg8 {
#define PG8_LAS __attribute__((address_space(3)))
typedef unsigned short bf16_t;
typedef short bf16x8 __attribute__((ext_vector_type(8)));
typedef float f32x4 __attribute__((ext_vector_type(4)));
typedef unsigned u32x4 __attribute__((ext_vector_type(4)));
constexpr int BM = 256, BK = 64, HALF = 128, HTB = HALF * BK * 2  , STAGE_BYTES = 8 * HTB, NXCD = 8, WGM = 8;

__host__ __device__ __forceinline__ int lds_byte(int r, int c) { const int st = (r >> 4) * 2 + (c >> 5), rr = r & 15, cc = c & 31, ob = rr * 64 + cc * 2; return st * 1024 + (ob ^ (((ob >> 9) & 1) << 5)); }
__host__ __device__ __forceinline__ void stage_rc(int b, int& R, int& C) { const int st = b / 1024, sb = b % 1024, swz = sb ^ (((sb >> 9) & 1) << 5); R = (st >> 1) * 16 + swz / 64; C = (st & 1) * 32 + (swz % 64) / 2; }
__host__ __device__ __forceinline__ int perm32(int rho) { const int n = rho >> 4, i = rho & 15; return 8 * (i >> 2) + 4 * n + (i & 3); }

struct Unit { int pm, pn; };
struct Gemm { const bf16_t* A; const bf16_t* Bt; int M, N, K; };

struct StaticOrder {
    int nM, nN, nwg, G, c;
    __host__ __device__ void init(int M, int N, int G_, int c_) { nM = M / BM; nN = N / BM; nwg = nM * nN; G = G_; c = c_; }
    __host__ __device__ bool next(int i, Unit& u) const {
        const long L = (long)i * G + c; if (L >= nwg) return false;
        int wgid = (int)L; { const int q = nwg / NXCD, r = nwg % NXCD, xcd = wgid % NXCD, off = wgid / NXCD; wgid = (xcd < r ? xcd * (q + 1) : r * (q + 1) + (xcd - r) * q) + off; }
        const int nig = WGM * nN, gid = wgid / nig, fm = gid * WGM, gsz = (nM - fm) < WGM ? (nM - fm) : WGM;
        u.pm = fm + ((wgid % nig) % gsz); u.pn = (wgid % nig) / gsz; return true;
    }
    __device__ __forceinline__ void a_ready(const Unit&) const {}
    __device__ __forceinline__ void done(const Unit&) const {}
};

__device__ __forceinline__ unsigned cvt_pk_bf16(float lo, float hi) { unsigned r; asm volatile("v_cvt_pk_bf16_f32 %0, %1, %2" : "=v"(r) : "v"(lo), "v"(hi)); return r; }
typedef float f32x2 __attribute__((ext_vector_type(2)));
__device__ __forceinline__ int fresh_lane() { int l; asm volatile("v_mbcnt_lo_u32_b32 %0, -1, 0\n\tv_mbcnt_hi_u32_b32 %0, -1, %0" : "=v"(l)); return l; }
template <class Epi, class Sched, bool ALIGN_EPI = false, bool SP2 = false>
__device__ __forceinline__ void gemm_phase(PG8_LAS unsigned char* lds, const Gemm g, const Sched& S, const Epi& E, const int wid) {
    const int lane = fresh_lane(), tid = wid * 64 + lane, wr = wid >> 2, wc = wid & 3, fr = lane & 15, fq = lane >> 4;
    const int K = g.K, nt = K / BK;
    unsigned voffA[2], voffB[2];
#pragma unroll
    for (int i = 0; i < 2; ++i) { int R, C; stage_rc(tid * 16 + i * 8192, R, C); const int Rb = Epi::PERM ? ((R & ~31) + perm32(R & 31)) : R;
        voffA[i] = (unsigned)(R * K + C) * 2u; voffB[i] = (unsigned)(Rb * K + C) * 2u; }
    const size_t kstep = (size_t)(BK * 2);
    const size_t hstep = (size_t)HALF * K * 2;
    const size_t tstep = 2 * hstep;
    const unsigned ldsw = (unsigned)wid * 1024u;
    const int aoff = lds_byte(wr * 64 + fr, fq * 8), boff = lds_byte(wc * 32 + fr, fq * 8);
#define PG8_SA(b, h) (((b) * 2 + (h)) * HTB)
#define PG8_SB(b, h) ((4 + (b) * 2 + (h)) * HTB)
#define PG8_STAGE(bufoff, gbase, voff) do { _Pragma("unroll") for (int _i = 0; _i < 2; ++_i) \
        __builtin_amdgcn_global_load_lds((const unsigned*)((const char*)(gbase) + (voff)[_i]), (PG8_LAS unsigned*)(lds + (bufoff) + ldsw + _i * 8192), 16, 0, 0); } while (0)
#define PG8_LDA(dst, b, h) do { _Pragma("unroll") for (int m = 0; m < 4; ++m) _Pragma("unroll") for (int k = 0; k < 2; ++k) dst[m][k] = *(const PG8_LAS bf16x8*)(lds + PG8_SA(b, h) + aoff + m * 2048 + k * 1024); } while (0)
#define PG8_LDB(dst, b, h) do { _Pragma("unroll") for (int n = 0; n < 2; ++n) _Pragma("unroll") for (int k = 0; k < 2; ++k) dst[n][k] = *(const PG8_LAS bf16x8*)(lds + PG8_SB(b, h) + boff + n * 2048 + k * 1024); } while (0)
#define PG8_MMA(ai, bj, At, Bt) do { __builtin_amdgcn_s_setprio(1); _Pragma("unroll") for (int m = 0; m < 4; ++m) _Pragma("unroll") for (int n = 0; n < 2; ++n) _Pragma("unroll") for (int k = 0; k < 2; ++k) \
        acc[ai][bj][m][n] = __builtin_amdgcn_mfma_f32_16x16x32_bf16(Bt[n][k], At[m][k], acc[ai][bj][m][n], 0, 0, 0); __builtin_amdgcn_s_setprio(0); } while (0)
#define PG8_WAIT_V(n) asm volatile("s_waitcnt vmcnt(" #n ")" ::: "memory")
#define PG8_WAIT_L(n) asm volatile("s_waitcnt lgkmcnt(" #n ")" ::: "memory")
#define PG8_BAR __builtin_amdgcn_s_barrier()
#define PG8_SCHED __builtin_amdgcn_sched_barrier(0)
    Unit cur, nxt; int ui = 0;
    if (!S.next(0, cur)) return;
    f32x4 acc[2][2][4][2];
#pragma unroll
    for (int a = 0; a < 2; ++a)
#pragma unroll
        for (int b = 0; b < 2; ++b)
#pragma unroll
            for (int m = 0; m < 4; ++m)
#pragma unroll
                for (int n = 0; n < 2; ++n) acc[a][b][m][n] = (f32x4){0.f, 0.f, 0.f, 0.f};
    bf16x8 At[4][2], B0[2][2], B1[2][2];
    const char* cA = (const char*)g.A + (size_t)cur.pm * tstep; const char* cB = (const char*)g.Bt + (size_t)cur.pn * tstep;
    S.a_ready(cur);
    if constexpr (SP2) {
        PG8_STAGE(PG8_SB(0, 0), cB, voffB); PG8_STAGE(PG8_SB(0, 1), cB + hstep, voffB); PG8_STAGE(PG8_SA(0, 0), cA, voffA); PG8_STAGE(PG8_SA(0, 1), cA + hstep, voffA);
        if (wr == 1) PG8_BAR;
        PG8_WAIT_V(2); PG8_BAR;
        PG8_STAGE(PG8_SB(1, 0), cB + kstep, voffB); PG8_STAGE(PG8_SA(1, 0), cA + kstep, voffA); PG8_STAGE(PG8_SB(1, 1), cB + hstep + kstep, voffB);
        PG8_WAIT_V(6); PG8_BAR;
    } else {
        PG8_STAGE(PG8_SB(0, 0), cB, voffB); PG8_STAGE(PG8_SA(0, 0), cA, voffA); PG8_STAGE(PG8_SB(0, 1), cB + hstep, voffB); PG8_STAGE(PG8_SA(0, 1), cA + hstep, voffA);
        if (wr == 1) PG8_BAR;
        PG8_WAIT_V(4); PG8_BAR;
        PG8_STAGE(PG8_SB(1, 0), cB + kstep, voffB); PG8_STAGE(PG8_SA(1, 0), cA + kstep, voffA); PG8_STAGE(PG8_SB(1, 1), cB + hstep + kstep, voffB);
        PG8_WAIT_V(6); PG8_BAR;
    }
    for (;;) {
        const bool has_next = S.next(ui + 1, nxt);
        const char* nA = has_next ? (const char*)g.A + (size_t)nxt.pm * tstep : cA; const char* nB = has_next ? (const char*)g.Bt + (size_t)nxt.pn * tstep : cB;
        for (int t = 0; t < nt; t += 2) {
            const bool last = (t == nt - 2);
            const char* a1 = cA + (size_t)(t + 1) * kstep;
            const char* a2 = last ? nA : cA + (size_t)(t + 2) * kstep; const char* b2 = last ? nB : cB + (size_t)(t + 2) * kstep;
            const char* a3 = a2 + kstep; const char* b3 = b2 + kstep;
            if (last && has_next) S.a_ready(nxt);
            if constexpr (SP2) {
            PG8_LDB(B0, 0, 0); PG8_LDB(B1, 0, 1); PG8_SCHED; PG8_LDA(At, 0, 0); PG8_STAGE(PG8_SA(1, 1), a1 + hstep, voffA);
            PG8_WAIT_V(8); PG8_WAIT_L(0); PG8_BAR; PG8_MMA(0, 0, At, B0); PG8_MMA(0, 1, At, B1); PG8_BAR; PG8_SCHED;
            PG8_LDA(At, 0, 1); PG8_STAGE(PG8_SB(0, 0), b2, voffB); PG8_STAGE(PG8_SB(0, 1), b2 + hstep, voffB); PG8_STAGE(PG8_SA(0, 0), a2, voffA);
            PG8_WAIT_V(8); PG8_WAIT_L(0); PG8_BAR; PG8_MMA(1, 0, At, B0); PG8_MMA(1, 1, At, B1); PG8_BAR; PG8_SCHED;
            PG8_LDB(B0, 1, 0); PG8_LDB(B1, 1, 1); PG8_SCHED; PG8_LDA(At, 1, 0); PG8_STAGE(PG8_SA(0, 1), a2 + hstep, voffA);
            PG8_WAIT_V(8); PG8_WAIT_L(0); PG8_BAR; PG8_MMA(0, 0, At, B0); PG8_MMA(0, 1, At, B1); PG8_BAR; PG8_SCHED;
            PG8_LDA(At, 1, 1); PG8_STAGE(PG8_SB(1, 0), b3, voffB); PG8_STAGE(PG8_SB(1, 1), b3 + hstep, voffB); PG8_STAGE(PG8_SA(1, 0), a3, voffA);
            PG8_WAIT_V(8); PG8_WAIT_L(0); PG8_BAR; PG8_MMA(1, 0, At, B0); PG8_MMA(1, 1, At, B1); PG8_BAR; PG8_SCHED;
            } else {
            PG8_LDB(B0, 0, 0); PG8_SCHED; PG8_LDA(At, 0, 0); PG8_STAGE(PG8_SA(1, 1), a1 + hstep, voffA);
            PG8_WAIT_L(8); PG8_BAR; PG8_WAIT_L(0); PG8_MMA(0, 0, At, B0); PG8_BAR; PG8_SCHED;
            PG8_LDB(B1, 0, 1); PG8_STAGE(PG8_SB(0, 0), b2, voffB);
            PG8_BAR; PG8_WAIT_L(0); PG8_MMA(0, 1, At, B1); PG8_BAR;
            PG8_LDA(At, 0, 1); PG8_STAGE(PG8_SA(0, 0), a2, voffA);
            PG8_BAR; PG8_WAIT_L(0); PG8_MMA(1, 0, At, B0); PG8_BAR; PG8_SCHED;
            PG8_STAGE(PG8_SB(0, 1), b2 + hstep, voffB);
            PG8_WAIT_V(6); PG8_BAR; PG8_MMA(1, 1, At, B1); PG8_BAR;
            PG8_LDB(B0, 1, 0); PG8_SCHED; PG8_LDA(At, 1, 0); PG8_STAGE(PG8_SA(0, 1), a2 + hstep, voffA);
            PG8_WAIT_L(8); PG8_BAR; PG8_WAIT_L(0); PG8_MMA(0, 0, At, B0); PG8_BAR; PG8_SCHED;
            PG8_LDB(B1, 1, 1); PG8_STAGE(PG8_SB(1, 0), b3, voffB);
            PG8_BAR; PG8_WAIT_L(0); PG8_MMA(0, 1, At, B1); PG8_BAR;
            PG8_LDA(At, 1, 1); PG8_STAGE(PG8_SA(1, 0), a3, voffA);
            PG8_BAR; PG8_WAIT_L(0); PG8_MMA(1, 0, At, B0); PG8_BAR; PG8_SCHED;
            PG8_STAGE(PG8_SB(1, 1), b3 + hstep, voffB);
            PG8_WAIT_V(6); PG8_BAR; PG8_MMA(1, 1, At, B1); PG8_BAR;
            }
        }
        if constexpr (ALIGN_EPI) { if (wr == 0) PG8_BAR; }
        if constexpr (!Epi::AFTER_DRAIN) { E(acc, cur, wr, wc, fr, fq); S.done(cur); }
        if (!has_next) break;
#pragma unroll
        for (int a = 0; a < 2; ++a)
#pragma unroll
            for (int b = 0; b < 2; ++b)
#pragma unroll
                for (int m = 0; m < 4; ++m)
#pragma unroll
                    for (int n = 0; n < 2; ++n) acc[a][b][m][n] = (f32x4){0.f, 0.f, 0.f, 0.f};
        cur = nxt; cA = nA; cB = nB; ++ui;
        if constexpr (ALIGN_EPI) { if (wr == 1) PG8_BAR; }
    }
    PG8_WAIT_V(0);
    if constexpr (!ALIGN_EPI) { if (wr == 0) PG8_BAR; }
    PG8_BAR;
    if constexpr (Epi::AFTER_DRAIN) { E.fused(acc, cur, wr, wc, fr, fq, lds, wid, lane); S.done(cur); }
#undef PG8_SA
#undef PG8_SB
#undef PG8_STAGE
#undef PG8_LDA
#undef PG8_LDB
#undef PG8_MMA
#undef PG8_WAIT_V
#undef PG8_WAIT_L
#undef PG8_BAR
#undef PG8_SCHED
}
}

namespace pg8 {
__device__ __forceinline__ u32x4 pack8(const f32x4 v0, const f32x4 v1) {
    u32x4 w; w.x = cvt_pk_bf16(v0[0], v0[1]); w.y = cvt_pk_bf16(v0[2], v0[3]); w.z = cvt_pk_bf16(v1[0], v1[1]); w.w = cvt_pk_bf16(v1[2], v1[3]); return w; }
__device__ __forceinline__ float quad_sum(float s) { s += __shfl_xor(s, 16); s += __shfl_xor(s, 32); return s; }
__device__ __forceinline__ float sq8(const f32x4 a, const f32x4 b) { return (a[0] * a[0] + a[1] * a[1]) + (a[2] * a[2] + a[3] * a[3]) + (b[0] * b[0] + b[1] * b[1]) + (b[2] * b[2] + b[3] * b[3]); }
__device__ __forceinline__ float row_rstd16(const float* rs, int row) {
    const f32x4* p = (const f32x4*)(rs + (size_t)row * 16); const f32x4 a = (p[0] + p[1]) + (p[2] + p[3]);
    return rsqrtf(((a[0] + a[1]) + (a[2] + a[3])) * (1.0f / 1024.0f) + 1e-6f); }

struct EpiProj {
    static constexpr bool PERM = true, AFTER_DRAIN = false;
    bf16_t* O; float* ssq; const float* cosT; const float* sinT; const float* gq; const float* gk;
    __device__ __forceinline__ void operator()(const f32x4 (&acc)[2][2][4][2], const Unit& u, int wr, int wc, int fr, int fq) const {
        const int pn = u.pn, row0 = u.pm * BM + wr * 64 + fr, cw = wc * 32 + 8 * fq;
        if (pn >= 8) {
#pragma unroll
            for (int ai = 0; ai < 2; ++ai)
#pragma unroll
                for (int m = 0; m < 4; ++m) { bf16_t* rowp = O + (size_t)(row0 + ai * HALF + m * 16) * 3072 + pn * BM + cw;
#pragma unroll
                    for (int bj = 0; bj < 2; ++bj) *(u32x4*)(rowp + bj * HALF) = pack8(acc[ai][bj][m][0], acc[ai][bj][m][1]); }
        } else {
            const bool isq = pn < 6; const float* g = isq ? gq : gk;
            const f32x4 g0 = *(const f32x4*)(g + cw), g1 = *(const f32x4*)(g + cw + 4);
            const float sc = isq ? 0.08838834764831845f : 1.0f;
            const float sg = (fq < 2) ? -1.0f : 1.0f;
#pragma unroll
            for (int ai = 0; ai < 2; ++ai)
#pragma unroll
                for (int m = 0; m < 4; ++m) { const int row = row0 + ai * HALF + m * 16;
                    f32x4 c0 = {0.f, 0.f, 0.f, 0.f}, c1 = c0, s0 = c0, s1 = c0;
                    if (wc == 0) { const float* cp = cosT + (size_t)row * 16 + 8 * (fq & 1); const float* sp = sinT + (size_t)row * 16 + 8 * (fq & 1);
                        c0 = *(const f32x4*)cp; c1 = *(const f32x4*)(cp + 4); s0 = *(const f32x4*)sp; s1 = *(const f32x4*)(sp + 4); }
                    bf16_t* rowp = O + (size_t)row * 3072 + pn * BM + cw;
#pragma unroll
                    for (int bj = 0; bj < 2; ++bj) { f32x4 v0 = acc[ai][bj][m][0], v1 = acc[ai][bj][m][1];
                        const float ss = quad_sum(sq8(v0, v1));
                        if (fq == 0) ssq[(size_t)row * 64 + (pn * 2 + bj) * 4 + wc] = ss;
                        v0 = v0 * g0; v1 = v1 * g1;
                        if (wc == 0) { f32x4 p0, p1;
#pragma unroll
                            for (int j = 0; j < 4; ++j) { p0[j] = __shfl_xor(v0[j], 32); p1[j] = __shfl_xor(v1[j], 32); }
                            v0 = v0 * c0 + (p0 * s0) * sg; v1 = v1 * c1 + (p1 * s1) * sg; }
                        v0 = v0 * sc; v1 = v1 * sc;
                        *(u32x4*)(rowp + bj * HALF) = pack8(v0, v1); } }
        }
    }
};
struct EpiRes {
    static constexpr bool PERM = true, AFTER_DRAIN = false;
    const float* base; float* outF; bf16_t* outB; float* rs;
    __device__ __forceinline__ void operator()(const f32x4 (&acc)[2][2][4][2], const Unit& u, int wr, int wc, int fr, int fq) const {
        const int row0 = u.pm * BM + wr * 64 + fr, col0 = u.pn * BM + wc * 32 + 8 * fq;
#pragma unroll
        for (int ai = 0; ai < 2; ++ai)
#pragma unroll
            for (int m = 0; m < 4; ++m) { const int row = row0 + ai * HALF + m * 16; const size_t off = (size_t)row * 1024 + col0; float ss = 0.f;
#pragma unroll
                for (int bj = 0; bj < 2; ++bj) { const float* bp = base + off + bj * HALF;
                    const f32x4 v0 = acc[ai][bj][m][0] + *(const f32x4*)bp, v1 = acc[ai][bj][m][1] + *(const f32x4*)(bp + 4);
                    *(f32x4*)(outF + off + bj * HALF) = v0; *(f32x4*)(outF + off + bj * HALF + 4) = v1;
                    if (outB) *(u32x4*)(outB + off + bj * HALF) = pack8(v0, v1);
                    ss += sq8(v0, v1); }
                if (rs) { ss = quad_sum(ss); if (fq == 0) rs[(size_t)row * 16 + u.pn * 4 + wc] = ss; } }
    }
};
struct EpiCq {
    static constexpr bool PERM = true, AFTER_DRAIN = false;
    const float* rs1; bf16_t* O; float* ssqc; const float* g;
    __device__ __forceinline__ void operator()(const f32x4 (&acc)[2][2][4][2], const Unit& u, int wr, int wc, int fr, int fq) const {
        const int row0 = u.pm * BM + wr * 64 + fr, cw = wc * 32 + 8 * fq;
        const f32x4 g0 = *(const f32x4*)(g + cw) * 0.08838834764831845f, g1 = *(const f32x4*)(g + cw + 4) * 0.08838834764831845f;
#pragma unroll
        for (int ai = 0; ai < 2; ++ai)
#pragma unroll
            for (int m = 0; m < 4; ++m) { const int row = row0 + ai * HALF + m * 16; const float rstd = row_rstd16(rs1, row);
                bf16_t* rowp = O + (size_t)row * 512 + u.pn * BM + cw;
#pragma unroll
                for (int bj = 0; bj < 2; ++bj) { f32x4 v0 = acc[ai][bj][m][0] * rstd, v1 = acc[ai][bj][m][1] * rstd;
                    const float ss = quad_sum(sq8(v0, v1));
                    if (fq == 0) ssqc[(size_t)row * 16 + (u.pn * 2 + bj) * 4 + wc] = ss;
                    *(u32x4*)(rowp + bj * HALF) = pack8(v0 * g0, v1 * g1); } }
    }
};
struct EpiKv {
    static constexpr bool PERM = true, AFTER_DRAIN = false;
    bf16_t* O; float* ssqm; const float* g;
    __device__ __forceinline__ void operator()(const f32x4 (&acc)[2][2][4][2], const Unit& u, int wr, int wc, int fr, int fq) const {
        const int row0 = u.pm * BM + wr * 64 + fr, cw = wc * 32 + 8 * fq; const bool isk = u.pn < 2;
        f32x4 g0 = {1.f, 1.f, 1.f, 1.f}, g1 = g0;
        if (isk) { g0 = *(const f32x4*)(g + cw); g1 = *(const f32x4*)(g + cw + 4); }
#pragma unroll
        for (int ai = 0; ai < 2; ++ai)
#pragma unroll
            for (int m = 0; m < 4; ++m) { const int row = row0 + ai * HALF + m * 16; bf16_t* rowp = O + (size_t)row * 1024 + u.pn * BM + cw;
#pragma unroll
                for (int bj = 0; bj < 2; ++bj) { const f32x4 v0 = acc[ai][bj][m][0], v1 = acc[ai][bj][m][1];
                    if (isk) { const float ss = quad_sum(sq8(v0, v1)); if (fq == 0) ssqm[(size_t)row * 16 + (u.pn * 2 + bj) * 4 + wc] = ss; }
                    *(u32x4*)(rowp + bj * HALF) = pack8(v0 * g0, v1 * g1); } }
    }
};
struct EpiSwiglu {
    static constexpr bool PERM = true, AFTER_DRAIN = false;
    const float* rs2; bf16_t* act;
    __device__ __forceinline__ void operator()(const f32x4 (&acc)[2][2][4][2], const Unit& u, int wr, int wc, int fr, int fq) const {
        const int row0 = u.pm * BM + wr * 64 + fr, cw = wc * 32 + 8 * fq;
#pragma unroll
        for (int ai = 0; ai < 2; ++ai)
#pragma unroll
            for (int m = 0; m < 4; ++m) { const int row = row0 + ai * HALF + m * 16; const float rstd = row_rstd16(rs2, row);
                f32x4 a[2];
#pragma unroll
                for (int n = 0; n < 2; ++n) { const f32x4 gg = acc[ai][0][m][n] * rstd, uu = acc[ai][1][m][n] * rstd;
#pragma unroll
                    for (int j = 0; j < 4; ++j) a[n][j] = gg[j] * __builtin_amdgcn_rcpf(1.0f + __expf(-gg[j])) * uu[j]; }
                *(u32x4*)(act + (size_t)row * 2816 + u.pn * HALF + cw) = pack8(a[0], a[1]); }
    }
};
}

#define LAS __attribute__((address_space(3)))
typedef unsigned short bf16_t;
typedef short bf16x8 __attribute__((ext_vector_type(8)));
typedef short s16x4 __attribute__((ext_vector_type(4)));
typedef float f32x4 __attribute__((ext_vector_type(4)));
typedef unsigned u32x4 __attribute__((ext_vector_type(4)));
typedef unsigned u32x2 __attribute__((ext_vector_type(2)));
constexpr int M = 16384, SEQ = 8192, DM = 1024, INW = 3072, DFF = 2816, NMEM = 256;
constexpr size_t MiB = 1u << 20;
constexpr size_t WS_WIN = 1 * MiB, WS_WOUT = 7 * MiB, WS_WCQ = 9 * MiB, WS_WCKV = 10 * MiB, WS_WCO = 12 * MiB, WS_WGU = 13 * MiB, WS_WDN = 24 * MiB;
constexpr size_t WS_SSQ = 30 * MiB, WS_COS = 34 * MiB, WS_SIN = 35 * MiB, WS_RS1 = 36 * MiB, WS_RS2 = 37 * MiB, WS_SSQC = 38 * MiB, WS_MEMN = 39 * MiB, WS_MEMKV = 40 * MiB, WS_SSQM = 41 * MiB, WS_ML = 42 * MiB;
constexpr size_t WS_A = 48 * MiB;
constexpr size_t WS_B = 80 * MiB;
constexpr size_t WS_OG = 80 * MiB;
constexpr size_t WS_QC = 112 * MiB, WS_OC = 128 * MiB;
constexpr size_t WS_BIG = 144 * MiB;
constexpr size_t WS_END = 240 * MiB;
constexpr int LDS_BYTES = 149504, XB_LDS_OFF = 149000;
constexpr int KST = 288, A_KOFF = 0, A_VOFF = 256 * KST, A_RKOFF = 2 * 256 * KST;
static_assert(A_RKOFF + 1024 <= LDS_BYTES && pg8::STAGE_BYTES <= LDS_BYTES, "LDS map");

struct Args { const float* in[20]; float* out; unsigned char* ws; float invf[16]; };

__device__ __forceinline__ float wave_sum(float v) {
#pragma unroll
    for (int o = 1; o < 64; o <<= 1) v += __shfl_xor(v, o);
    return v;
}
__device__ __forceinline__ float bf_lo(unsigned w) { return __uint_as_float(w << 16); }
__device__ __forceinline__ float bf_hi(unsigned w) { return __uint_as_float(w & 0xffff0000u); }
__device__ __forceinline__ void unpack8(const u32x4 w, float (&f)[8]) { f[0] = bf_lo(w.x); f[1] = bf_hi(w.x); f[2] = bf_lo(w.y); f[3] = bf_hi(w.y); f[4] = bf_lo(w.z); f[5] = bf_hi(w.z); f[6] = bf_lo(w.w); f[7] = bf_hi(w.w); }

template <int MODE>
__device__ __forceinline__ void tr_item(const float* W, int Nsrc, int Ndst, const float* gain, bf16_t* WT, int ldt, LAS float* scr, int item, int lane) {
    const int nblk = Ndst / 32, kb = item / nblk, nb = item % nblk, k0 = 64 * kb, n0 = 32 * nb;
    const int s0 = MODE == 1 ? (((n0 >> 7) & 1) * DFF + (n0 >> 8) * 128 + (n0 & 127)) : n0;
#pragma unroll 8
    for (int i = 0; i < 32; ++i) { const int kk = 2 * i + (lane >> 5); float w = W[(size_t)(k0 + kk) * Nsrc + s0 + (lane & 31)]; if (gain) w *= gain[k0 + kk]; scr[kk * 33 + (lane & 31)] = w; }
    asm volatile("s_waitcnt lgkmcnt(0)" ::: "memory");
    const int c = lane & 7;
#pragma unroll
    for (int j = 0; j < 4; ++j) { const int n = (lane >> 3) + 8 * j; const LAS float* s = scr + (8 * c) * 33 + n;
        u32x4 o; o.x = pg8::cvt_pk_bf16(s[0 * 33], s[1 * 33]); o.y = pg8::cvt_pk_bf16(s[2 * 33], s[3 * 33]); o.z = pg8::cvt_pk_bf16(s[4 * 33], s[5 * 33]); o.w = pg8::cvt_pk_bf16(s[6 * 33], s[7 * 33]);
        *(u32x4*)(WT + (size_t)(n0 + n) * ldt + k0 + 8 * c) = o; }
    asm volatile("s_waitcnt lgkmcnt(0)" ::: "memory");
}
__device__ __forceinline__ void rms_row(const float* xrow, const float* g, bf16_t* orow, int lane) {
    const f32x4* xr = (const f32x4*)xrow + lane; const f32x4* gr = (const f32x4*)g + lane;
    f32x4 v[4]; float s = 0.f;
#pragma unroll
    for (int j = 0; j < 4; ++j) { v[j] = xr[64 * j]; s += (v[j][0] * v[j][0] + v[j][1] * v[j][1]) + (v[j][2] * v[j][2] + v[j][3] * v[j][3]); }
    const float rstd = rsqrtf(wave_sum(s) * (1.0f / 1024.0f) + 1e-6f);
    u32x2* o8 = (u32x2*)orow + lane;
#pragma unroll
    for (int j = 0; j < 4; ++j) { const f32x4 y = v[j] * rstd * gr[64 * j]; u32x2 w; w.x = pg8::cvt_pk_bf16(y[0], y[1]); w.y = pg8::cvt_pk_bf16(y[2], y[3]); o8[64 * j] = w; }
}
__device__ __forceinline__ void sincos_d(float ang, float& s, float& c) {
    const double x = (double)ang; const double kq = rint(x * 0.63661977236758134308);
    const double r = (x - kq * 1.5707963267948966192) - kq * 6.123233995736766036e-17; const double r2 = r * r;
    double sp = -7.6471637318198164759e-13; sp = sp * r2 + 1.6059043836821614599e-10; sp = sp * r2 - 2.5052108385441718775e-08; sp = sp * r2 + 2.7557319223985890653e-06;
    sp = sp * r2 - 1.9841269841269841270e-04; sp = sp * r2 + 8.3333333333333333333e-03; sp = sp * r2 - 1.6666666666666666667e-01; sp = r + r * r2 * sp;
    double cp = 4.7794773323873852974e-14; cp = cp * r2 - 1.1470745597729724714e-11; cp = cp * r2 + 2.0876756987868098979e-09; cp = cp * r2 - 2.7557319223985890653e-07;
    cp = cp * r2 + 2.4801587301587301587e-05; cp = cp * r2 - 1.3888888888888888889e-03; cp = cp * r2 + 4.1666666666666666667e-02; cp = cp * r2 - 0.5; cp = 1.0 + r2 * cp;
    const int q = (int)((long long)kq & 3);
    const double sv = (q & 1) ? cp : sp, cv = (q & 1) ? sp : cp;
    s = (float)((q & 2) ? -sv : sv); c = (float)(((q + 1) & 2) ? -cv : cv);
}

__device__ __forceinline__ s16x4 vtr(LAS unsigned char* p) { return __builtin_bit_cast(s16x4, __builtin_amdgcn_ds_read_tr16_b64_v4i16((LAS s16x4*)p)); }
template <int NT, bool MASK>
__device__ __forceinline__ void attn_unit(LAS unsigned char* lds, const bf16_t* qb, long qstep, const float* sq, long sqstep,
                                          const bf16_t* kb, const bf16_t* vb, long kstep, int ks0, const float* sk, long skstep,
                                          bf16_t* ob, long ostep, float* ml, long mlstep, bool nb0, int tid, int lane, int wave) {
    {
        const int c = tid & 15, rr = tid >> 4;
        u32x4 kr[8], vr[8];
#pragma unroll
        for (int it = 0; it < 8; ++it) { int sidx = ks0 + rr + 32 * it; sidx = sidx < 0 ? 0 : sidx; const long off = (long)sidx * kstep + 8 * c;
            kr[it] = *(const u32x4*)(kb + off); vr[it] = *(const u32x4*)(vb + off); }
#pragma unroll
        for (int it = 0; it < 8; ++it) { const int row = rr + 32 * it;
            *(LAS u32x4*)(lds + A_KOFF + row * KST + c * 16) = kr[it]; *(LAS u32x4*)(lds + A_VOFF + row * KST + c * 16) = vr[it]; }
        if (tid < 256) { int sidx = ks0 + tid; sidx = sidx < 0 ? 0 : sidx; const f32x4 p = *(const f32x4*)(sk + (long)sidx * skstep);
            ((LAS float*)(lds + A_RKOFF))[tid] = rsqrtf(((p[0] + p[1]) + (p[2] + p[3])) * (1.0f / 128.0f) + 1e-6f); }
    }
    const int fr = lane & 15, fq = lane >> 4, qi = wave * 16 + fr;
    bf16x8 qf[4];
#pragma unroll
    for (int ks = 0; ks < 4; ++ks) qf[ks] = *(const bf16x8*)(qb + (long)qi * qstep + 32 * ks + 8 * fq);
    float rq; { const f32x4 p = *(const f32x4*)(sq + (long)qi * sqstep); rq = rsqrtf(((p[0] + p[1]) + (p[2] + p[3])) * (1.0f / 128.0f) + 1e-6f); }
    __syncthreads();
    const int ts = MASK ? (wave < 6 ? wave : 6) : 0;
    f32x4 s[NT];
#pragma unroll
    for (int tt = 0; tt < NT; ++tt) { s[tt] = (f32x4){0.f, 0.f, 0.f, 0.f};
#pragma unroll
        for (int ks = 0; ks < 4; ++ks) { const bf16x8 kf = *(const LAS bf16x8*)(lds + A_KOFF + (16 * (ts + tt) + fr) * KST + (32 * ks + 8 * fq) * 2);
            s[tt] = __builtin_amdgcn_mfma_f32_16x16x32_bf16(kf, qf[ks], s[tt], 0, 0, 0); } }
    float mx = -3.0e38f;
#pragma unroll
    for (int tt = 0; tt < NT; ++tt) { const f32x4 rk4 = *(const LAS f32x4*)(lds + A_RKOFF + (16 * (ts + tt) + 4 * fq) * 4);
#pragma unroll
        for (int j = 0; j < 4; ++j) { const int kj = 16 * (ts + tt) + 4 * fq + j; float v = s[tt][j] * rq * rk4[j];
            if (MASK) { const bool valid = (kj >= qi) && (kj <= qi + 128) && (!nb0 || kj >= 128); v = valid ? v : -1.0e30f; }
            s[tt][j] = v; mx = fmaxf(mx, v); } }
    mx = fmaxf(mx, __shfl_xor(mx, 16)); mx = fmaxf(mx, __shfl_xor(mx, 32));
    float l = 0.f;
#pragma unroll
    for (int tt = 0; tt < NT; ++tt)
#pragma unroll
        for (int j = 0; j < 4; ++j) { const float p = __expf(s[tt][j] - mx); s[tt][j] = p; l += p; }
    l = pg8::quad_sum(l);
    f32x4 o[8];
#pragma unroll
    for (int dt = 0; dt < 8; ++dt) o[dt] = (f32x4){0.f, 0.f, 0.f, 0.f};
    const int q4 = fr >> 2, p4 = fr & 3;
#pragma unroll
    for (int pr = 0; pr < NT / 2; ++pr) { const bf16x8 pf = __builtin_bit_cast(bf16x8, pg8::pack8(s[2 * pr], s[2 * pr + 1]));
        LAS unsigned char* v0p = lds + A_VOFF + (16 * (ts + 2 * pr) + 4 * fq + q4) * KST + 8 * p4;
#pragma unroll
        for (int dt = 0; dt < 8; ++dt) { const s16x4 a0 = vtr(v0p + 32 * dt), a1 = vtr(v0p + 16 * KST + 32 * dt);
            const bf16x8 vf = __builtin_shufflevector(a0, a1, 0, 1, 2, 3, 4, 5, 6, 7);
            o[dt] = __builtin_amdgcn_mfma_f32_16x16x32_bf16(vf, pf, o[dt], 0, 0, 0); } }
    const float inv = 1.0f / l;
#pragma unroll
    for (int dt = 0; dt < 8; ++dt) { u32x2 w; w.x = pg8::cvt_pk_bf16(o[dt][0] * inv, o[dt][1] * inv); w.y = pg8::cvt_pk_bf16(o[dt][2] * inv, o[dt][3] * inv);
        *(u32x2*)(ob + (long)qi * ostep + 16 * dt + 4 * fq) = w; }
    if (ml && fq == 0) { ml[(long)qi * mlstep] = mx; ml[(long)qi * mlstep + 1] = l; }
    __syncthreads();
}

#define XB_TMO      128
#define XB_XCNT(j)  (256  + 64 * (j))
#define XB_XSUB(j)  (1280 + 64 * (j))
#define XB_XGEN(j)  (2304 + 64 * (j))
#define XB_TOP      3328
#define XB_TOPGEN   3392
#define XCD_BAR_WORDS 3456
#define XB_SPIN_CAP (1u << 18)

__device__ __forceinline__ unsigned xb_ld(unsigned* p)              { return __hip_atomic_load(p, __ATOMIC_RELAXED, __HIP_MEMORY_SCOPE_AGENT); }
__device__ __forceinline__ unsigned xb_add(unsigned* p, unsigned v) { return __hip_atomic_fetch_add(p, v, __ATOMIC_RELAXED, __HIP_MEMORY_SCOPE_AGENT); }
__device__ __forceinline__ unsigned xb_xcc_id() { return (unsigned)__builtin_amdgcn_s_getreg((3 << 11) | 20) & 0xFu; }
#define XB_SPIN(cond, bar) do { unsigned _sp = 0; while (cond) { __builtin_amdgcn_s_sleep(1); \
    if ((++_sp & 255u) == 0u) { if (xb_ld(&(bar)[XB_TMO])) break; if (_sp > XB_SPIN_CAP) { atomicAdd(&(bar)[XB_TMO], 1u); break; } } } } while (0)

struct XcdBarrier {
    unsigned* bar; unsigned x;
    volatile LAS unsigned* st;
};

__device__ __forceinline__ XcdBarrier xcd_barrier_post(unsigned* bar, volatile LAS unsigned* st) {
    XcdBarrier b; b.bar = bar; b.x = xb_xcc_id(); b.st = st;
    if (threadIdx.x == 0) (void)xb_add(&bar[XB_XCNT(b.x)], 1u);
    return b;
}
__device__ __forceinline__ void xcd_barrier_complete(unsigned* bar, unsigned x, unsigned& nloc, unsigned& nx) {
    const unsigned G = gridDim.x * gridDim.y * gridDim.z;
    unsigned sum, cnt, mine, sp = 0u;
    for (;;) {
        sum = 0u; cnt = 0u; mine = 0u;
#pragma unroll
        for (unsigned j = 0; j < 16; ++j) { const unsigned c = xb_ld(&bar[XB_XCNT(j)]); sum += c; cnt += (c > 0u) ? 1u : 0u; mine = (j == x) ? c : mine; }
        if (sum == G) break;
        __builtin_amdgcn_s_sleep(1);
        if ((++sp & 255u) == 0u) { if (xb_ld(&bar[XB_TMO])) break; if (sp > XB_SPIN_CAP) { atomicAdd(&bar[XB_TMO], 1u); break; } }
    }
    nloc = mine > 0u ? mine : 1u; nx = cnt > 0u ? cnt : 1u;
}

__device__ __forceinline__ void xcd_barrier(const XcdBarrier& b) {
    asm volatile("s_waitcnt vmcnt(0)" ::: "memory");
    __syncthreads();
    if (threadIdx.x == 0) {
        unsigned* bar = b.bar;
        __builtin_amdgcn_s_waitcnt(0);
        unsigned nloc = b.st[0], nx = b.st[1];
        if (nloc == 0u) { xcd_barrier_complete(bar, b.x, nloc, nx); b.st[0] = nloc; b.st[1] = nx; }
        const unsigned old = xb_add(&bar[XB_XSUB(b.x)], 1u);
        const unsigned gen = old / nloc;
        if (old + 1u == (gen + 1u) * nloc) {
            __builtin_amdgcn_fence(__ATOMIC_RELEASE, "agent");
            asm volatile("s_waitcnt vmcnt(0)" ::: "memory");
            const unsigned og = xb_add(&bar[XB_TOP], 1u);
            const unsigned tg = og / nx;
            if (og + 1u == (tg + 1u) * nx) xb_add(&bar[XB_TOPGEN], 1u);
            else XB_SPIN(xb_ld(&bar[XB_TOPGEN]) == tg, bar);
            __builtin_amdgcn_fence(__ATOMIC_ACQUIRE, "agent");
            xb_add(&bar[XB_XGEN(b.x)], 1u);
            asm volatile("s_waitcnt vmcnt(0)" ::: "memory");
        } else {
            XB_SPIN(xb_ld(&bar[XB_XGEN(b.x)]) == gen, bar);
            __builtin_amdgcn_fence(__ATOMIC_ACQUIRE, "agent");
            asm volatile("s_waitcnt vmcnt(0)" ::: "memory");
        }
    }
    __syncthreads();
}

#define REP_P0 1
#define REP_P1 1
#define REP_P2 1
#define REP_P2B 1
#define REP_P3 1
#define REP_P4 1
#define REP_P5 1
#define REP_P6 1
#define REP_P7 1
#define REP_P8 1
#define REP_SYNC 1
__global__ void __launch_bounds__(512) fwd(Args a) {
    extern __shared__ __attribute__((aligned(16))) unsigned char lds_raw[];
    LAS unsigned char* lds = (LAS unsigned char*)lds_raw;
    cg::grid_group grid = cg::this_grid();
    const int wave = __builtin_amdgcn_readfirstlane(threadIdx.x >> 6);
    const int G = gridDim.x, bx = blockIdx.x;
    unsigned char* ws = a.ws;
    volatile LAS unsigned* xst = (volatile LAS unsigned*)(lds + XB_LDS_OFF);
    if (threadIdx.x < 2) xst[threadIdx.x] = 0u;
    __syncthreads();
    const XcdBarrier xbar = xcd_barrier_post((unsigned*)ws, xst);
    const float* x = a.in[0]; const float* mem = a.in[1]; const int* pos = (const int*)a.in[2];
    bf16_t* Win = (bf16_t*)(ws + WS_WIN); bf16_t* Wout = (bf16_t*)(ws + WS_WOUT); bf16_t* Wcq = (bf16_t*)(ws + WS_WCQ); bf16_t* Wckv = (bf16_t*)(ws + WS_WCKV);
    bf16_t* Wco = (bf16_t*)(ws + WS_WCO); bf16_t* Wgu = (bf16_t*)(ws + WS_WGU); bf16_t* Wdn = (bf16_t*)(ws + WS_WDN);
    float* SSQ = (float*)(ws + WS_SSQ); float* COS = (float*)(ws + WS_COS); float* SIN = (float*)(ws + WS_SIN); float* RS1 = (float*)(ws + WS_RS1); float* RS2 = (float*)(ws + WS_RS2);
    float* SSQC = (float*)(ws + WS_SSQC); bf16_t* MEMN = (bf16_t*)(ws + WS_MEMN); bf16_t* MEMKV = (bf16_t*)(ws + WS_MEMKV); float* SSQM = (float*)(ws + WS_SSQM); float* ML = (float*)(ws + WS_ML);
    bf16_t* BA = (bf16_t*)(ws + WS_A); bf16_t* BB = (bf16_t*)(ws + WS_B); bf16_t* OG = (bf16_t*)(ws + WS_OG); bf16_t* QC = (bf16_t*)(ws + WS_QC); bf16_t* OC = (bf16_t*)(ws + WS_OC);
    bf16_t* BIG = (bf16_t*)(ws + WS_BIG);

    for (int rep = 0; rep < REP_P0; ++rep)
    {
        const int lane = pg8::fresh_lane(), tid = wave * 64 + lane;
        LAS float* scr = (LAS float*)(lds + wave * 16384);
        const int gw = bx * 8 + wave, NGW = G * 8;
        constexpr int I_IN = 16 * 96, I_OUT = 8 * 32, I_CQ = 16 * 16, I_CKV = 16 * 32, I_CO = 8 * 32, I_GU = 16 * 176, I_DN = 44 * 32;
        constexpr int NITEMS = I_IN + I_OUT + I_CQ + I_CKV + I_CO + I_GU + I_DN;
        for (int it = gw; it < NITEMS; it += NGW) {
            int r = it;
            if (r < I_IN) { tr_item<0>(a.in[4], INW, INW, nullptr, Win, 1024, scr, r, lane); continue; } r -= I_IN;
            if (r < I_OUT) { tr_item<0>(a.in[9], 1024, 1024, nullptr, Wout, 1024, scr, r, lane); continue; } r -= I_OUT;
            if (r < I_CQ) { tr_item<0>(a.in[12], 512, 512, a.in[10], Wcq, 1024, scr, r, lane); continue; } r -= I_CQ;
            if (r < I_CKV) { tr_item<0>(a.in[13], 1024, 1024, nullptr, Wckv, 1024, scr, r, lane); continue; } r -= I_CKV;
            if (r < I_CO) { tr_item<0>(a.in[16], 1024, 1024, nullptr, Wco, 512, scr, r, lane); continue; } r -= I_CO;
            if (r < I_GU) { tr_item<1>(a.in[18], 2 * DFF, 2 * DFF, a.in[17], Wgu, 1024, scr, r, lane); continue; } r -= I_GU;
            tr_item<0>(a.in[19], 1024, 1024, nullptr, Wdn, DFF, scr, r, lane);
        }
        {
            const float* pw = a.in[7]; const float* psc = a.in[8]; const float* wo = a.in[9];
            for (int idx = bx * 512 + tid; idx < 512 * 1024; idx += G * 512) { const int n = idx & 1023, kc = idx >> 10, g = kc >> 7;
                const float* pr = pw + (size_t)kc * 128; const float* sc = psc + g * 128; const float* wr_ = wo + (size_t)(512 + g * 128) * 1024 + n; float acc = 0.f;
#pragma unroll 8
                for (int e = 0; e < 128; ++e) acc += pr[e] * sc[e] * wr_[(size_t)e * 1024];
                Wout[(size_t)n * 1024 + 512 + kc] = (bf16_t)(pg8::cvt_pk_bf16(acc, 0.f) & 0xffffu); }
        }
        for (int m = gw; m < M + 512; m += NGW) {
            if (m < M) rms_row(x + (size_t)m * DM, a.in[3], BA + (size_t)m * DM, lane);
            else rms_row(mem + (size_t)(m - M) * DM, a.in[11], MEMN + (size_t)(m - M) * DM, lane);
        }
        for (int idx = bx * 512 + tid; idx < M * 16; idx += G * 512) { const int row = idx >> 4, i = idx & 15;
            const float ang = (float)pos[row] * a.invf[i]; float s, c; sincos_d(ang, s, c); COS[idx] = c; SIN[idx] = s; }
    }
    for (int rep = 0; rep < REP_SYNC; ++rep) grid.sync();

    for (int rep = 0; rep < REP_P1; ++rep)
    {
        pg8::Gemm g{BA, Win, M, INW, 1024}; pg8::StaticOrder S; S.init(M, INW, G, bx);
        pg8::EpiProj E{BIG, SSQ, COS, SIN, a.in[5], a.in[6]};
        pg8::gemm_phase<pg8::EpiProj, pg8::StaticOrder, true, true>(lds, g, S, E, wave);
    }
    for (int rep = 0; rep < REP_SYNC; ++rep) xcd_barrier(xbar);

    for (int rep = 0; rep < REP_P2; ++rep)
    { const int lane = pg8::fresh_lane(), tid = wave * 64 + lane;
    for (int u = bx; u < 1536; u += G) {
        const int g = u >> 9, rem = u & 511, b = rem >> 8, rem2 = rem & 255, h = rem2 & 3, blk = rem2 >> 2;
        const int dil = 1 << (2 * g), nbs = 64 >> (2 * g), r = blk / nbs, nb = blk % nbs;
        const long row0 = (long)b * SEQ + r;
        const long qrow = row0 + (long)dil * 128 * nb;
        attn_unit<10, true>(lds, BIG + qrow * INW + (g * 4 + h) * 128, (long)dil * INW, SSQ + qrow * 64 + (g * 4 + h) * 4, (long)dil * 64,
                            BIG + row0 * INW + 1536 + h * 128, BIG + row0 * INW + 2048 + h * 128, (long)dil * INW, 128 * (nb - 1), SSQ + row0 * 64 + (12 + h) * 4, (long)dil * 64,
                            OG + (size_t)g * M * 512 + qrow * 512 + h * 128, (long)dil * 512, ML + (((size_t)g * M + qrow) * 4 + h) * 2, (long)dil * 8, nb == 0, tid, lane, wave);
    } }
    for (int rep = 0; rep < REP_SYNC; ++rep) xcd_barrier(xbar);

    for (int rep = 0; rep < REP_P2B; ++rep)
    { const int lane = pg8::fresh_lane(), tid = wave * 64 + lane;
    for (long idx = (long)bx * 512 + tid; idx < (long)M * 128; idx += (long)G * 512) {
        const int row = (int)(idx >> 7), c = (int)(idx & 127);
        if (c < 64) { const int h = c >> 4; float mm[3], ll[3];
#pragma unroll
            for (int g = 0; g < 3; ++g) { const float* p = ML + (((size_t)g * M + row) * 4 + h) * 2; mm[g] = p[0]; ll[g] = p[1]; }
            const float mmax = fmaxf(mm[0], fmaxf(mm[1], mm[2])); float w[3], den = 0.f;
#pragma unroll
            for (int g = 0; g < 3; ++g) { w[g] = __expf(mm[g] - mmax) * ll[g]; den += w[g]; }
            const float inv = 1.0f / den; float o[8];
#pragma unroll
            for (int j = 0; j < 8; ++j) o[j] = 0.f;
#pragma unroll
            for (int g = 0; g < 3; ++g) { float f[8]; unpack8(*(const u32x4*)(OG + (size_t)g * M * 512 + (size_t)row * 512 + c * 8), f); const float wg = w[g] * inv;
#pragma unroll
                for (int j = 0; j < 8; ++j) o[j] += wg * f[j]; }
            *(u32x4*)(BA + (size_t)row * DM + c * 8) = pg8::pack8((f32x4){o[0], o[1], o[2], o[3]}, (f32x4){o[4], o[5], o[6], o[7]});
        } else { const int cc = c - 64, gp = cc >> 4, w = 2 << gp, t = row & (SEQ - 1); const int cnt = (t + 1) < w ? (t + 1) : w;
            const bf16_t* up = BIG + (size_t)row * INW + 2560 + cc * 8; float f0[8], sum[8]; unpack8(*(const u32x4*)up, f0);
#pragma unroll
            for (int j = 0; j < 8; ++j) sum[j] = f0[j];
            for (int i = 1; i < cnt; ++i) { float f[8]; unpack8(*(const u32x4*)(up - (size_t)i * INW), f);
#pragma unroll
                for (int j = 0; j < 8; ++j) sum[j] += f[j]; }
            const float ic = 1.0f / (float)cnt; float d[8];
#pragma unroll
            for (int j = 0; j < 8; ++j) d[j] = sum[j] * ic - f0[j];
            *(u32x4*)(BA + (size_t)row * DM + 512 + cc * 8) = pg8::pack8((f32x4){d[0], d[1], d[2], d[3]}, (f32x4){d[4], d[5], d[6], d[7]});
        }
    } }
    for (int rep = 0; rep < REP_SYNC; ++rep) xcd_barrier(xbar);

    for (int rep = 0; rep < REP_P3; ++rep)
    {
        pg8::Gemm g{BA, Wout, M, 1024, 1024}; pg8::StaticOrder S; S.init(M, 1024, G, bx);
        pg8::EpiRes E{x, a.out, BB, RS1};
        pg8::gemm_phase<pg8::EpiRes, pg8::StaticOrder, true, true>(lds, g, S, E, wave);
    }
    for (int rep = 0; rep < REP_SYNC; ++rep) xcd_barrier(xbar);

    for (int rep = 0; rep < REP_P4; ++rep)
    {
        const bool split = G >= 136;
        if (!split || bx < G - 8) {
            pg8::Gemm g{BB, Wcq, M, 512, 1024}; pg8::StaticOrder S; S.init(M, 512, split ? G - 8 : G, bx);
            pg8::EpiCq E{RS1, QC, SSQC, a.in[14]};
            pg8::gemm_phase<pg8::EpiCq, pg8::StaticOrder, true, true>(lds, g, S, E, wave);
        }
        if (!split || bx >= G - 8) {
            pg8::Gemm g{MEMN, Wckv, 512, 1024, 1024}; pg8::StaticOrder S; S.init(512, 1024, split ? 8 : G, split ? bx - (G - 8) : bx);
            pg8::EpiKv E{MEMKV, SSQM, a.in[15]};
            pg8::gemm_phase<pg8::EpiKv, pg8::StaticOrder, true, true>(lds, g, S, E, wave);
        }
    }
    for (int rep = 0; rep < REP_SYNC; ++rep) xcd_barrier(xbar);

    for (int rep = 0; rep < REP_P5; ++rep)
    { const int lane = pg8::fresh_lane(), tid = wave * 64 + lane;
    for (int u = bx; u < 512; u += G) {
        const int h = u & 3, qb = u >> 2, b = qb >> 6; const long qrow = (long)qb * 128;
        attn_unit<16, false>(lds, QC + qrow * 512 + h * 128, 512, SSQC + qrow * 16 + h * 4, 16,
                             MEMKV + (size_t)b * NMEM * 1024 + h * 128, MEMKV + (size_t)b * NMEM * 1024 + 512 + h * 128, 1024, 0, SSQM + (size_t)b * NMEM * 16 + h * 4, 16,
                             OC + qrow * 512 + h * 128, 512, nullptr, 0, false, tid, lane, wave);
    } }
    for (int rep = 0; rep < REP_SYNC; ++rep) xcd_barrier(xbar);

    for (int rep = 0; rep < REP_P6; ++rep)
    {
        pg8::Gemm g{OC, Wco, M, 1024, 512}; pg8::StaticOrder S; S.init(M, 1024, G, bx);
        pg8::EpiRes E{a.out, a.out, BA, RS2};
        pg8::gemm_phase<pg8::EpiRes, pg8::StaticOrder, true, true>(lds, g, S, E, wave);
    }
    for (int rep = 0; rep < REP_SYNC; ++rep) xcd_barrier(xbar);

    for (int rep = 0; rep < REP_P7; ++rep)
    {
        pg8::Gemm g{BA, Wgu, M, 2 * DFF, 1024}; pg8::StaticOrder S; S.init(M, 2 * DFF, G, bx);
        pg8::EpiSwiglu E{RS2, BIG};
        pg8::gemm_phase<pg8::EpiSwiglu, pg8::StaticOrder, true, true>(lds, g, S, E, wave);
    }
    for (int rep = 0; rep < REP_SYNC; ++rep) xcd_barrier(xbar);

    for (int rep = 0; rep < REP_P8; ++rep)
    {
        pg8::Gemm g{BIG, Wdn, M, 1024, DFF}; pg8::StaticOrder S; S.init(M, 1024, G, bx);
        pg8::EpiRes E{a.out, a.out, nullptr, nullptr};
        pg8::gemm_phase<pg8::EpiRes, pg8::StaticOrder, true, true>(lds, g, S, E, wave);
    }
}

extern "C" void kernel_launch(void* const* d_in, const int* in_sizes, int n_in, void* d_out, int out_size, void* d_ws, size_t ws_size, hipStream_t stream) {
    static int grid_blocks = 0;
    if (grid_blocks == 0) {
        if (n_in != 20 || ws_size < WS_END) { fprintf(stderr, "kernel_launch: unexpected inputs (n_in %d, ws %zu)\n", n_in, ws_size); grid_blocks = -1; return; }
        int dev = 0, cus = 0, per_cu = 0;
        hipGetDevice(&dev); hipDeviceGetAttribute(&cus, hipDeviceAttributeMultiprocessorCount, dev);
        if (hipFuncSetAttribute((const void*)fwd, hipFuncAttributeMaxDynamicSharedMemorySize, LDS_BYTES) != hipSuccess) { fprintf(stderr, "kernel_launch: hipFuncSetAttribute failed\n"); }
        if (hipOccupancyMaxActiveBlocksPerMultiprocessor(&per_cu, (const void*)fwd, 512, LDS_BYTES) != hipSuccess || per_cu < 1) { fprintf(stderr, "kernel_launch: occupancy query says %d\n", per_cu); per_cu = 1; }
        (void)hipGetLastError();
        grid_blocks = cus * 1;
        if (grid_blocks < 1) grid_blocks = 1;
    }
    if (grid_blocks < 0) return;
    if (hipMemsetAsync(d_ws, 0, 16384, stream) != hipSuccess) { fprintf(stderr, "kernel_launch: memset failed\n"); return; }
    Args a{};
    for (int i = 0; i < 20; ++i) a.in[i] = (const float*)d_in[i];
    a.out = (float*)d_out; a.ws = (unsigned char*)d_ws;
    for (int i = 0; i < 16; ++i) a.invf[i] = (float)std::pow(500000.0, -(double)i / 16.0);
    void* args[] = {&a};
    hipError_t e = hipLaunchCooperativeKernel((const void*)fwd, dim3(grid_blocks), dim3(512), args, LDS_BYTES, stream);
    if (e != hipSuccess) fprintf(stderr, "cooperative launch failed: %s (grid %d)\n", hipGetErrorString(e), grid_blocks);
}
```

```cpp
#include <hip/hip_runtime.h>
#include <hip/hip_cooperative_groups.h>
#include <cstdio>
#include <cstdint>
#include <cmath>
namespace cg = cooperative_groups;
namespace pg8 {
#define PG8_LAS __attribute__((address_space(3)))
typedef unsigned short bf16_t;
typedef short bf16x8 __attribute__((ext_vector_type(8)));
typedef float f32x4 __attribute__((ext_vector_type(4)));
typedef unsigned u32x4 __attribute__((ext_vector_type(4)));
constexpr int BM = 256, BK = 64, HALF = 128, HTB = HALF * BK * 2  , STAGE_BYTES = 8 * HTB, NXCD = 8, WGM = 8;

__host__ __device__ __forceinline__ int lds_byte(int r, int c) { const int st = (r >> 4) * 2 + (c >> 5), rr = r & 15, cc = c & 31, ob = rr * 64 + cc * 2; return st * 1024 + (ob ^ (((ob >> 9) & 1) << 5)); }
__host__ __device__ __forceinline__ void stage_rc(int b, int& R, int& C) { const int st = b / 1024, sb = b % 1024, swz = sb ^ (((sb >> 9) & 1) << 5); R = (st >> 1) * 16 + swz / 64; C = (st & 1) * 32 + (swz % 64) / 2; }
__host__ __device__ __forceinline__ int perm32(int rho) { const int n = rho >> 4, i = rho & 15; return 8 * (i >> 2) + 4 * n + (i & 3); }

struct Unit { int pm, pn; };
struct Gemm { const bf16_t* A; const bf16_t* Bt; int M, N, K; };

struct StaticOrder {
    int nM, nN, nwg, G, c;
    __host__ __device__ void init(int M, int N, int G_, int c_) { nM = M / BM; nN = N / BM; nwg = nM * nN; G = G_; c = c_; }
    __host__ __device__ bool next(int i, Unit& u) const {
        const long L = (long)i * G + c; if (L >= nwg) return false;
        int wgid = (int)L; { const int q = nwg / NXCD, r = nwg % NXCD, xcd = wgid % NXCD, off = wgid / NXCD; wgid = (xcd < r ? xcd * (q + 1) : r * (q + 1) + (xcd - r) * q) + off; }
        const int nig = WGM * nN, gid = wgid / nig, fm = gid * WGM, gsz = (nM - fm) < WGM ? (nM - fm) : WGM;
        u.pm = fm + ((wgid % nig) % gsz); u.pn = (wgid % nig) / gsz; return true;
    }
    __device__ __forceinline__ void a_ready(const Unit&) const {}
    __device__ __forceinline__ void done(const Unit&) const {}
};

__device__ __forceinline__ unsigned cvt_pk_bf16(float lo, float hi) { unsigned r; asm volatile("v_cvt_pk_bf16_f32 %0, %1, %2" : "=v"(r) : "v"(lo), "v"(hi)); return r; }
typedef float f32x2 __attribute__((ext_vector_type(2)));
__device__ __forceinline__ int fresh_lane() { int l; asm volatile("v_mbcnt_lo_u32_b32 %0, -1, 0\n\tv_mbcnt_hi_u32_b32 %0, -1, %0" : "=v"(l)); return l; }
template <class Epi, class Sched, bool ALIGN_EPI = false, bool SP2 = false>
__device__ __forceinline__ void gemm_phase(PG8_LAS unsigned char* lds, const Gemm g, const Sched& S, const Epi& E, const int wid) {
    const int lane = fresh_lane(), tid = wid * 64 + lane, wr = wid >> 2, wc = wid & 3, fr = lane & 15, fq = lane >> 4;
    const int K = g.K, nt = K / BK;
    unsigned voffA[2], voffB[2];
#pragma unroll
    for (int i = 0; i < 2; ++i) { int R, C; stage_rc(tid * 16 + i * 8192, R, C); const int Rb = Epi::PERM ? ((R & ~31) + perm32(R & 31)) : R;
        voffA[i] = (unsigned)(R * K + C) * 2u; voffB[i] = (unsigned)(Rb * K + C) * 2u; }
    const size_t kstep = (size_t)(BK * 2);
    const size_t hstep = (size_t)HALF * K * 2;
    const size_t tstep = 2 * hstep;
    const unsigned ldsw = (unsigned)wid * 1024u;
    const int aoff = lds_byte(wr * 64 + fr, fq * 8), boff = lds_byte(wc * 32 + fr, fq * 8);
#define PG8_SA(b, h) (((b) * 2 + (h)) * HTB)
#define PG8_SB(b, h) ((4 + (b) * 2 + (h)) * HTB)
#define PG8_STAGE(bufoff, gbase, voff) do { _Pragma("unroll") for (int _i = 0; _i < 2; ++_i) \
        __builtin_amdgcn_global_load_lds((const unsigned*)((const char*)(gbase) + (voff)[_i]), (PG8_LAS unsigned*)(lds + (bufoff) + ldsw + _i * 8192), 16, 0, 0); } while (0)
#define PG8_LDA(dst, b, h) do { _Pragma("unroll") for (int m = 0; m < 4; ++m) _Pragma("unroll") for (int k = 0; k < 2; ++k) dst[m][k] = *(const PG8_LAS bf16x8*)(lds + PG8_SA(b, h) + aoff + m * 2048 + k * 1024); } while (0)
#define PG8_LDB(dst, b, h) do { _Pragma("unroll") for (int n = 0; n < 2; ++n) _Pragma("unroll") for (int k = 0; k < 2; ++k) dst[n][k] = *(const PG8_LAS bf16x8*)(lds + PG8_SB(b, h) + boff + n * 2048 + k * 1024); } while (0)
#define PG8_MMA(ai, bj, At, Bt) do { __builtin_amdgcn_s_setprio(1); _Pragma("unroll") for (int m = 0; m < 4; ++m) _Pragma("unroll") for (int n = 0; n < 2; ++n) _Pragma("unroll") for (int k = 0; k < 2; ++k) \
        acc[ai][bj][m][n] = __builtin_amdgcn_mfma_f32_16x16x32_bf16(Bt[n][k], At[m][k], acc[ai][bj][m][n], 0, 0, 0); __builtin_amdgcn_s_setprio(0); } while (0)
#define PG8_WAIT_V(n) asm volatile("s_waitcnt vmcnt(" #n ")" ::: "memory")
#define PG8_WAIT_L(n) asm volatile("s_waitcnt lgkmcnt(" #n ")" ::: "memory")
#define PG8_BAR __builtin_amdgcn_s_barrier()
#define PG8_SCHED __builtin_amdgcn_sched_barrier(0)
    Unit cur, nxt; int ui = 0;
    if (!S.next(0, cur)) return;
    f32x4 acc[2][2][4][2];
#pragma unroll
    for (int a = 0; a < 2; ++a)
#pragma unroll
        for (int b = 0; b < 2; ++b)
#pragma unroll
            for (int m = 0; m < 4; ++m)
#pragma unroll
                for (int n = 0; n < 2; ++n) acc[a][b][m][n] = (f32x4){0.f, 0.f, 0.f, 0.f};
    bf16x8 At[4][2], B0[2][2], B1[2][2];
    const char* cA = (const char*)g.A + (size_t)cur.pm * tstep; const char* cB = (const char*)g.Bt + (size_t)cur.pn * tstep;
    S.a_ready(cur);
    if constexpr (SP2) {
        PG8_STAGE(PG8_SB(0, 0), cB, voffB); PG8_STAGE(PG8_SB(0, 1), cB + hstep, voffB); PG8_STAGE(PG8_SA(0, 0), cA, voffA); PG8_STAGE(PG8_SA(0, 1), cA + hstep, voffA);
        if (wr == 1) PG8_BAR;
        PG8_WAIT_V(2); PG8_BAR;
        PG8_STAGE(PG8_SB(1, 0), cB + kstep, voffB); PG8_STAGE(PG8_SA(1, 0), cA + kstep, voffA); PG8_STAGE(PG8_SB(1, 1), cB + hstep + kstep, voffB);
        PG8_WAIT_V(6); PG8_BAR;
    } else {
        PG8_STAGE(PG8_SB(0, 0), cB, voffB); PG8_STAGE(PG8_SA(0, 0), cA, voffA); PG8_STAGE(PG8_SB(0, 1), cB + hstep, voffB); PG8_STAGE(PG8_SA(0, 1), cA + hstep, voffA);
        if (wr == 1) PG8_BAR;
        PG8_WAIT_V(4); PG8_BAR;
        PG8_STAGE(PG8_SB(1, 0), cB + kstep, voffB); PG8_STAGE(PG8_SA(1, 0), cA + kstep, voffA); PG8_STAGE(PG8_SB(1, 1), cB + hstep + kstep, voffB);
        PG8_WAIT_V(6); PG8_BAR;
    }
    for (;;) {
        const bool has_next = S.next(ui + 1, nxt);
        const char* nA = has_next ? (const char*)g.A + (size_t)nxt.pm * tstep : cA; const char* nB = has_next ? (const char*)g.Bt + (size_t)nxt.pn * tstep : cB;
        for (int t = 0; t < nt; t += 2) {
            const bool last = (t == nt - 2);
            const char* a1 = cA + (size_t)(t + 1) * kstep;
            const char* a2 = last ? nA : cA + (size_t)(t + 2) * kstep; const char* b2 = last ? nB : cB + (size_t)(t + 2) * kstep;
            const char* a3 = a2 + kstep; const char* b3 = b2 + kstep;
            if (last && has_next) S.a_ready(nxt);
            if constexpr (SP2) {
            PG8_LDB(B0, 0, 0); PG8_LDB(B1, 0, 1); PG8_SCHED; PG8_LDA(At, 0, 0); PG8_STAGE(PG8_SA(1, 1), a1 + hstep, voffA);
            PG8_WAIT_V(8); PG8_WAIT_L(0); PG8_BAR; PG8_MMA(0, 0, At, B0); PG8_MMA(0, 1, At, B1); PG8_BAR; PG8_SCHED;
            PG8_LDA(At, 0, 1); PG8_STAGE(PG8_SB(0, 0), b2, voffB); PG8_STAGE(PG8_SB(0, 1), b2 + hstep, voffB); PG8_STAGE(PG8_SA(0, 0), a2, voffA);
            PG8_WAIT_V(8); PG8_WAIT_L(0); PG8_BAR; PG8_MMA(1, 0, At, B0); PG8_MMA(1, 1, At, B1); PG8_BAR; PG8_SCHED;
            PG8_LDB(B0, 1, 0); PG8_LDB(B1, 1, 1); PG8_SCHED; PG8_LDA(At, 1, 0); PG8_STAGE(PG8_SA(0, 1), a2 + hstep, voffA);
            PG8_WAIT_V(8); PG8_WAIT_L(0); PG8_BAR; PG8_MMA(0, 0, At, B0); PG8_MMA(0, 1, At, B1); PG8_BAR; PG8_SCHED;
            PG8_LDA(At, 1, 1); PG8_STAGE(PG8_SB(1, 0), b3, voffB); PG8_STAGE(PG8_SB(1, 1), b3 + hstep, voffB); PG8_STAGE(PG8_SA(1, 0), a3, voffA);
            PG8_WAIT_V(8); PG8_WAIT_L(0); PG8_BAR; PG8_MMA(1, 0, At, B0); PG8_MMA(1, 1, At, B1); PG8_BAR; PG8_SCHED;
            } else {
            PG8_LDB(B0, 0, 0); PG8_SCHED; PG8_LDA(At, 0, 0); PG8_STAGE(PG8_SA(1, 1), a1 + hstep, voffA);
            PG8_WAIT_L(8); PG8_BAR; PG8_WAIT_L(0); PG8_MMA(0, 0, At, B0); PG8_BAR; PG8_SCHED;
            PG8_LDB(B1, 0, 1); PG8_STAGE(PG8_SB(0, 0), b2, voffB);
            PG8_BAR; PG8_WAIT_L(0); PG8_MMA(0, 1, At, B1); PG8_BAR;
            PG8_LDA(At, 0, 1); PG8_STAGE(PG8_SA(0, 0), a2, voffA);
            PG8_BAR; PG8_WAIT_L(0); PG8_MMA(1, 0, At, B0); PG8_BAR; PG8_SCHED;
            PG8_STAGE(PG8_SB(0, 1), b2 + hstep, voffB);
            PG8_WAIT_V(6); PG8_BAR; PG8_MMA(1, 1, At, B1); PG8_BAR;
            PG8_LDB(B0, 1, 0); PG8_SCHED; PG8_LDA(At, 1, 0); PG8_STAGE(PG8_SA(0, 1), a2 + hstep, voffA);
            PG8_WAIT_L(8); PG8_BAR; PG8_WAIT_L(0); PG8_MMA(0, 0, At, B0); PG8_BAR; PG8_SCHED;
            PG8_LDB(B1, 1, 1); PG8_STAGE(PG8_SB(1, 0), b3, voffB);
            PG8_BAR; PG8_WAIT_L(0); PG8_MMA(0, 1, At, B1); PG8_BAR;
            PG8_LDA(At, 1, 1); PG8_STAGE(PG8_SA(1, 0), a3, voffA);
            PG8_BAR; PG8_WAIT_L(0); PG8_MMA(1, 0, At, B0); PG8_BAR; PG8_SCHED;
            PG8_STAGE(PG8_SB(1, 1), b3 + hstep, voffB);
            PG8_WAIT_V(6); PG8_BAR; PG8_MMA(1, 1, At, B1); PG8_BAR;
            }
        }
        if constexpr (ALIGN_EPI) { if (wr == 0) PG8_BAR; }
        if constexpr (!Epi::AFTER_DRAIN) { E(acc, cur, wr, wc, fr, fq); S.done(cur); }
        if (!has_next) break;
#pragma unroll
        for (int a = 0; a < 2; ++a)
#pragma unroll
            for (int b = 0; b < 2; ++b)
#pragma unroll
                for (int m = 0; m < 4; ++m)
#pragma unroll
                    for (int n = 0; n < 2; ++n) acc[a][b][m][n] = (f32x4){0.f, 0.f, 0.f, 0.f};
        cur = nxt; cA = nA; cB = nB; ++ui;
        if constexpr (ALIGN_EPI) { if (wr == 1) PG8_BAR; }
    }
    PG8_WAIT_V(0);
    if constexpr (!ALIGN_EPI) { if (wr == 0) PG8_BAR; }
    PG8_BAR;
    if constexpr (Epi::AFTER_DRAIN) { E.fused(acc, cur, wr, wc, fr, fq, lds, wid, lane); S.done(cur); }
#undef PG8_SA
#undef PG8_SB
#undef PG8_STAGE
#undef PG8_LDA
#undef PG8_LDB
#undef PG8_MMA
#undef PG8_WAIT_V
#undef PG8_WAIT_L
#undef PG8_BAR
#undef PG8_SCHED
}
}

namespace pg8 {
__device__ __forceinline__ u32x4 pack8(const f32x4 v0, const f32x4 v1) {
    u32x4 w; w.x = cvt_pk_bf16(v0[0], v0[1]); w.y = cvt_pk_bf16(v0[2], v0[3]); w.z = cvt_pk_bf16(v1[0], v1[1]); w.w = cvt_pk_bf16(v1[2], v1[3]); return w; }
__device__ __forceinline__ float quad_sum(float s) { s += __shfl_xor(s, 16); s += __shfl_xor(s, 32); return s; }
__device__ __forceinline__ float sq8(const f32x4 a, const f32x4 b) { return (a[0] * a[0] + a[1] * a[1]) + (a[2] * a[2] + a[3] * a[3]) + (b[0] * b[0] + b[1] * b[1]) + (b[2] * b[2] + b[3] * b[3]); }
__device__ __forceinline__ float row_rstd16(const float* rs, int row) {
    const f32x4* p = (const f32x4*)(rs + (size_t)row * 16); const f32x4 a = (p[0] + p[1]) + (p[2] + p[3]);
    return rsqrtf(((a[0] + a[1]) + (a[2] + a[3])) * (1.0f / 1024.0f) + 1e-6f); }

struct EpiProj {
    static constexpr bool PERM = true, AFTER_DRAIN = false;
    bf16_t* O; float* ssq; const float* cosT; const float* sinT; const float* gq; const float* gk;
    __device__ __forceinline__ void operator()(const f32x4 (&acc)[2][2][4][2], const Unit& u, int wr, int wc, int fr, int fq) const {
        const int pn = u.pn, row0 = u.pm * BM + wr * 64 + fr, cw = wc * 32 + 8 * fq;
        if (pn >= 8) {
#pragma unroll
            for (int ai = 0; ai < 2; ++ai)
#pragma unroll
                for (int m = 0; m < 4; ++m) { bf16_t* rowp = O + (size_t)(row0 + ai * HALF + m * 16) * 3072 + pn * BM + cw;
#pragma unroll
                    for (int bj = 0; bj < 2; ++bj) *(u32x4*)(rowp + bj * HALF) = pack8(acc[ai][bj][m][0], acc[ai][bj][m][1]); }
        } else {
            const bool isq = pn < 6; const float* g = isq ? gq : gk;
            const f32x4 g0 = *(const f32x4*)(g + cw), g1 = *(const f32x4*)(g + cw + 4);
            const float sc = isq ? 0.08838834764831845f : 1.0f;
            const float sg = (fq < 2) ? -1.0f : 1.0f;
#pragma unroll
            for (int ai = 0; ai < 2; ++ai)
#pragma unroll
                for (int m = 0; m < 4; ++m) { const int row = row0 + ai * HALF + m * 16;
                    f32x4 c0 = {0.f, 0.f, 0.f, 0.f}, c1 = c0, s0 = c0, s1 = c0;
                    if (wc == 0) { const float* cp = cosT + (size_t)row * 16 + 8 * (fq & 1); const float* sp = sinT + (size_t)row * 16 + 8 * (fq & 1);
                        c0 = *(const f32x4*)cp; c1 = *(const f32x4*)(cp + 4); s0 = *(const f32x4*)sp; s1 = *(const f32x4*)(sp + 4); }
                    bf16_t* rowp = O + (size_t)row * 3072 + pn * BM + cw;
#pragma unroll
                    for (int bj = 0; bj < 2; ++bj) { f32x4 v0 = acc[ai][bj][m][0], v1 = acc[ai][bj][m][1];
                        const float ss = quad_sum(sq8(v0, v1));
                        if (fq == 0) ssq[(size_t)row * 64 + (pn * 2 + bj) * 4 + wc] = ss;
                        v0 = v0 * g0; v1 = v1 * g1;
                        if (wc == 0) { f32x4 p0, p1;
#pragma unroll
                            for (int j = 0; j < 4; ++j) { p0[j] = __shfl_xor(v0[j], 32); p1[j] = __shfl_xor(v1[j], 32); }
                            v0 = v0 * c0 + (p0 * s0) * sg; v1 = v1 * c1 + (p1 * s1) * sg; }
                        v0 = v0 * sc; v1 = v1 * sc;
                        *(u32x4*)(rowp + bj * HALF) = pack8(v0, v1); } }
        }
    }
};
struct EpiRes {
    static constexpr bool PERM = true, AFTER_DRAIN = false;
    const float* base; float* outF; bf16_t* outB; float* rs;
    __device__ __forceinline__ void operator()(const f32x4 (&acc)[2][2][4][2], const Unit& u, int wr, int wc, int fr, int fq) const {
        const int row0 = u.pm * BM + wr * 64 + fr, col0 = u.pn * BM + wc * 32 + 8 * fq;
#pragma unroll
        for (int ai = 0; ai < 2; ++ai)
#pragma unroll
            for (int m = 0; m < 4; ++m) { const int row = row0 + ai * HALF + m * 16; const size_t off = (size_t)row * 1024 + col0; float ss = 0.f;
#pragma unroll
                for (int bj = 0; bj < 2; ++bj) { const float* bp = base + off + bj * HALF;
                    const f32x4 v0 = acc[ai][bj][m][0] + *(const f32x4*)bp, v1 = acc[ai][bj][m][1] + *(const f32x4*)(bp + 4);
                    *(f32x4*)(outF + off + bj * HALF) = v0; *(f32x4*)(outF + off + bj * HALF + 4) = v1;
                    if (outB) *(u32x4*)(outB + off + bj * HALF) = pack8(v0, v1);
                    ss += sq8(v0, v1); }
                if (rs) { ss = quad_sum(ss); if (fq == 0) rs[(size_t)row * 16 + u.pn * 4 + wc] = ss; } }
    }
};
struct EpiCq {
    static constexpr bool PERM = true, AFTER_DRAIN = false;
    const float* rs1; bf16_t* O; float* ssqc; const float* g;
    __device__ __forceinline__ void operator()(const f32x4 (&acc)[2][2][4][2], const Unit& u, int wr, int wc, int fr, int fq) const {
        const int row0 = u.pm * BM + wr * 64 + fr, cw = wc * 32 + 8 * fq;
        const f32x4 g0 = *(const f32x4*)(g + cw) * 0.08838834764831845f, g1 = *(const f32x4*)(g + cw + 4) * 0.08838834764831845f;
#pragma unroll
        for (int ai = 0; ai < 2; ++ai)
#pragma unroll
            for (int m = 0; m < 4; ++m) { const int row = row0 + ai * HALF + m * 16; const float rstd = row_rstd16(rs1, row);
                bf16_t* rowp = O + (size_t)row * 512 + u.pn * BM + cw;
#pragma unroll
                for (int bj = 0; bj < 2; ++bj) { f32x4 v0 = acc[ai][bj][m][0] * rstd, v1 = acc[ai][bj][m][1] * rstd;
                    const float ss = quad_sum(sq8(v0, v1));
                    if (fq == 0) ssqc[(size_t)row * 16 + (u.pn * 2 + bj) * 4 + wc] = ss;
                    *(u32x4*)(rowp + bj * HALF) = pack8(v0 * g0, v1 * g1); } }
    }
};
struct EpiKv {
    static constexpr bool PERM = true, AFTER_DRAIN = false;
    bf16_t* O; float* ssqm; const float* g;
    __device__ __forceinline__ void operator()(const f32x4 (&acc)[2][2][4][2], const Unit& u, int wr, int wc, int fr, int fq) const {
        const int row0 = u.pm * BM + wr * 64 + fr, cw = wc * 32 + 8 * fq; const bool isk = u.pn < 2;
        f32x4 g0 = {1.f, 1.f, 1.f, 1.f}, g1 = g0;
        if (isk) { g0 = *(const f32x4*)(g + cw); g1 = *(const f32x4*)(g + cw + 4); }
#pragma unroll
        for (int ai = 0; ai < 2; ++ai)
#pragma unroll
            for (int m = 0; m < 4; ++m) { const int row = row0 + ai * HALF + m * 16; bf16_t* rowp = O + (size_t)row * 1024 + u.pn * BM + cw;
#pragma unroll
                for (int bj = 0; bj < 2; ++bj) { const f32x4 v0 = acc[ai][bj][m][0], v1 = acc[ai][bj][m][1];
                    if (isk) { const float ss = quad_sum(sq8(v0, v1)); if (fq == 0) ssqm[(size_t)row * 16 + (u.pn * 2 + bj) * 4 + wc] = ss; }
                    *(u32x4*)(rowp + bj * HALF) = pack8(v0 * g0, v1 * g1); } }
    }
};
struct EpiSwiglu {
    static constexpr bool PERM = true, AFTER_DRAIN = false;
    const float* rs2; bf16_t* act;
    __device__ __forceinline__ void operator()(const f32x4 (&acc)[2][2][4][2], const Unit& u, int wr, int wc, int fr, int fq) const {
        const int row0 = u.pm * BM + wr * 64 + fr, cw = wc * 32 + 8 * fq;
#pragma unroll
        for (int ai = 0; ai < 2; ++ai)
#pragma unroll
            for (int m = 0; m < 4; ++m) { const int row = row0 + ai * HALF + m * 16; const float rstd = row_rstd16(rs2, row);
                f32x4 a[2];
#pragma unroll
                for (int n = 0; n < 2; ++n) { const f32x4 gg = acc[ai][0][m][n] * rstd, uu = acc[ai][1][m][n] * rstd;
#pragma unroll
                    for (int j = 0; j < 4; ++j) a[n][j] = gg[j] * __builtin_amdgcn_rcpf(1.0f + __expf(-gg[j])) * uu[j]; }
                *(u32x4*)(act + (size_t)row * 2816 + u.pn * HALF + cw) = pack8(a[0], a[1]); }
    }
};
}

#define LAS __attribute__((address_space(3)))
typedef unsigned short bf16_t;
typedef short bf16x8 __attribute__((ext_vector_type(8)));
typedef short s16x4 __attribute__((ext_vector_type(4)));
typedef float f32x4 __attribute__((ext_vector_type(4)));
typedef unsigned u32x4 __attribute__((ext_vector_type(4)));
typedef unsigned u32x2 __attribute__((ext_vector_type(2)));
constexpr int M = 16384, SEQ = 8192, DM = 1024, INW = 3072, DFF = 2816, NMEM = 256;
constexpr size_t MiB = 1u << 20;
constexpr size_t WS_WIN = 1 * MiB, WS_WOUT = 7 * MiB, WS_WCQ = 9 * MiB, WS_WCKV = 10 * MiB, WS_WCO = 12 * MiB, WS_WGU = 13 * MiB, WS_WDN = 24 * MiB;
constexpr size_t WS_SSQ = 30 * MiB, WS_COS = 34 * MiB, WS_SIN = 35 * MiB, WS_RS1 = 36 * MiB, WS_RS2 = 37 * MiB, WS_SSQC = 38 * MiB, WS_MEMN = 39 * MiB, WS_MEMKV = 40 * MiB, WS_SSQM = 41 * MiB, WS_ML = 42 * MiB;
constexpr size_t WS_A = 48 * MiB;
constexpr size_t WS_B = 80 * MiB;
constexpr size_t WS_OG = 80 * MiB;
constexpr size_t WS_QC = 112 * MiB, WS_OC = 128 * MiB;
constexpr size_t WS_BIG = 144 * MiB;
constexpr size_t WS_END = 240 * MiB;
constexpr int LDS_BYTES = 149504, XB_LDS_OFF = 149000;
constexpr int KST = 288, A_KOFF = 0, A_VOFF = 256 * KST, A_RKOFF = 2 * 256 * KST;
static_assert(A_RKOFF + 1024 <= LDS_BYTES && pg8::STAGE_BYTES <= LDS_BYTES, "LDS map");

struct Args { const float* in[20]; float* out; unsigned char* ws; float invf[16]; };

__device__ __forceinline__ float wave_sum(float v) {
#pragma unroll
    for (int o = 1; o < 64; o <<= 1) v += __shfl_xor(v, o);
    return v;
}
__device__ __forceinline__ float bf_lo(unsigned w) { return __uint_as_float(w << 16); }
__device__ __forceinline__ float bf_hi(unsigned w) { return __uint_as_float(w & 0xffff0000u); }
__device__ __forceinline__ void unpack8(const u32x4 w, float (&f)[8]) { f[0] = bf_lo(w.x); f[1] = bf_hi(w.x); f[2] = bf_lo(w.y); f[3] = bf_hi(w.y); f[4] = bf_lo(w.z); f[5] = bf_hi(w.z); f[6] = bf_lo(w.w); f[7] = bf_hi(w.w); }

template <int MODE>
__device__ __forceinline__ void tr_item(const float* W, int Nsrc, int Ndst, const float* gain, bf16_t* WT, int ldt, LAS float* scr, int item, int lane) {
    const int nblk = Ndst / 32, kb = item / nblk, nb = item % nblk, k0 = 64 * kb, n0 = 32 * nb;
    const int s0 = MODE == 1 ? (((n0 >> 7) & 1) * DFF + (n0 >> 8) * 128 + (n0 & 127)) : n0;
    const int kr = lane >> 3, ch = lane & 7; f32x4 w[8];
#pragma unroll
    for (int i = 0; i < 8; ++i) w[i] = *(const f32x4*)(W + (size_t)(k0 + kr + 8 * i) * Nsrc + s0 + 4 * ch);
#pragma unroll
    for (int i = 0; i < 8; ++i) { const int kk = kr + 8 * i; const float gm = gain ? gain[k0 + kk] : 1.0f;
#pragma unroll
        for (int j = 0; j < 4; ++j) scr[kk * 33 + 4 * ch + j] = w[i][j] * gm; }
    asm volatile("s_waitcnt lgkmcnt(0)" ::: "memory");
    const int c = lane & 7;
#pragma unroll
    for (int j = 0; j < 4; ++j) { const int n = (lane >> 3) + 8 * j; const LAS float* s = scr + (8 * c) * 33 + n;
        u32x4 o; o.x = pg8::cvt_pk_bf16(s[0 * 33], s[1 * 33]); o.y = pg8::cvt_pk_bf16(s[2 * 33], s[3 * 33]); o.z = pg8::cvt_pk_bf16(s[4 * 33], s[5 * 33]); o.w = pg8::cvt_pk_bf16(s[6 * 33], s[7 * 33]);
        *(u32x4*)(WT + (size_t)(n0 + n) * ldt + k0 + 8 * c) = o; }
    asm volatile("s_waitcnt lgkmcnt(0)" ::: "memory");
}
__device__ __forceinline__ void rms_rows2(const float* x0, const float* g0, bf16_t* o0, const float* x1, const float* g1, bf16_t* o1, bool has1, int lane) {
    const f32x4* xr0 = (const f32x4*)x0 + lane; const f32x4* xr1 = (const f32x4*)x1 + lane;
    f32x4 v0[4], v1[4]; float s0 = 0.f, s1 = 0.f;
#pragma unroll
    for (int j = 0; j < 4; ++j) { v0[j] = xr0[64 * j]; v1[j] = xr1[64 * j]; }
#pragma unroll
    for (int j = 0; j < 4; ++j) { s0 += (v0[j][0] * v0[j][0] + v0[j][1] * v0[j][1]) + (v0[j][2] * v0[j][2] + v0[j][3] * v0[j][3]); s1 += (v1[j][0] * v1[j][0] + v1[j][1] * v1[j][1]) + (v1[j][2] * v1[j][2] + v1[j][3] * v1[j][3]); }
    const float r0 = rsqrtf(wave_sum(s0) * (1.0f / 1024.0f) + 1e-6f), r1 = rsqrtf(wave_sum(s1) * (1.0f / 1024.0f) + 1e-6f);
    const f32x4* gr0 = (const f32x4*)g0 + lane; const f32x4* gr1 = (const f32x4*)g1 + lane;
    u32x2* p0 = (u32x2*)o0 + lane; u32x2* p1 = (u32x2*)o1 + lane;
#pragma unroll
    for (int j = 0; j < 4; ++j) { const f32x4 y = v0[j] * r0 * gr0[64 * j]; u32x2 w; w.x = pg8::cvt_pk_bf16(y[0], y[1]); w.y = pg8::cvt_pk_bf16(y[2], y[3]); p0[64 * j] = w; }
    if (has1) {
#pragma unroll
        for (int j = 0; j < 4; ++j) { const f32x4 y = v1[j] * r1 * gr1[64 * j]; u32x2 w; w.x = pg8::cvt_pk_bf16(y[0], y[1]); w.y = pg8::cvt_pk_bf16(y[2], y[3]); p1[64 * j] = w; } }
}
__device__ __forceinline__ void sincos_d(float ang, float& s, float& c) {
    const double x = (double)ang; const double kq = rint(x * 0.63661977236758134308);
    const double r = (x - kq * 1.5707963267948966192) - kq * 6.123233995736766036e-17; const double r2 = r * r;
    double sp = -7.6471637318198164759e-13; sp = sp * r2 + 1.6059043836821614599e-10; sp = sp * r2 - 2.5052108385441718775e-08; sp = sp * r2 + 2.7557319223985890653e-06;
    sp = sp * r2 - 1.9841269841269841270e-04; sp = sp * r2 + 8.3333333333333333333e-03; sp = sp * r2 - 1.6666666666666666667e-01; sp = r + r * r2 * sp;
    double cp = 4.7794773323873852974e-14; cp = cp * r2 - 1.1470745597729724714e-11; cp = cp * r2 + 2.0876756987868098979e-09; cp = cp * r2 - 2.7557319223985890653e-07;
    cp = cp * r2 + 2.4801587301587301587e-05; cp = cp * r2 - 1.3888888888888888889e-03; cp = cp * r2 + 4.1666666666666666667e-02; cp = cp * r2 - 0.5; cp = 1.0 + r2 * cp;
    const int q = (int)((long long)kq & 3);
    const double sv = (q & 1) ? cp : sp, cv = (q & 1) ? sp : cp;
    s = (float)((q & 2) ? -sv : sv); c = (float)(((q + 1) & 2) ? -cv : cv);
}

__device__ __forceinline__ s16x4 vtr(LAS unsigned char* p) { return __builtin_bit_cast(s16x4, __builtin_amdgcn_ds_read_tr16_b64_v4i16((LAS s16x4*)p)); }
struct AD {
    const bf16_t* qb; long qstep; const float* sq; long sqstep; const bf16_t* kb; const bf16_t* vb; long kstep; int ks0; const float* sk; long skstep;
    bf16_t* ob; long ostep; float* ml; long mlstep; bool nb0; };
struct KVR { u32x4 kr[8], vr[8]; f32x4 sp; };
__device__ __forceinline__ void attn_load(const AD& d, KVR& R, int tid) {
    const int c = tid & 15, rr = tid >> 4;
#pragma unroll
    for (int it = 0; it < 8; ++it) { int sidx = d.ks0 + rr + 32 * it; sidx = sidx < 0 ? 0 : sidx; const long off = (long)sidx * d.kstep + 8 * c;
        R.kr[it] = *(const u32x4*)(d.kb + off); R.vr[it] = *(const u32x4*)(d.vb + off); }
    { int sidx = d.ks0 + (tid & 255); sidx = sidx < 0 ? 0 : sidx; R.sp = *(const f32x4*)(d.sk + (long)sidx * d.skstep); }
}
__device__ __forceinline__ void attn_store(LAS unsigned char* lds, const KVR& R, int tid) {
    const int c = tid & 15, rr = tid >> 4;
#pragma unroll
    for (int it = 0; it < 8; ++it) { const int row = rr + 32 * it;
        *(LAS u32x4*)(lds + A_KOFF + row * KST + c * 16) = R.kr[it]; *(LAS u32x4*)(lds + A_VOFF + row * KST + c * 16) = R.vr[it]; }
    if (tid < 256) ((LAS float*)(lds + A_RKOFF))[tid] = rsqrtf(((R.sp[0] + R.sp[1]) + (R.sp[2] + R.sp[3])) * (1.0f / 128.0f) + 1e-6f);
}
struct QR { bf16x8 qf[4]; f32x4 sp; };
__device__ __forceinline__ void attn_loadq(const AD& d, QR& Q, int lane, int wave) {
    const int fr = lane & 15, fq = lane >> 4, qi = wave * 16 + fr;
#pragma unroll
    for (int ks = 0; ks < 4; ++ks) Q.qf[ks] = *(const bf16x8*)(d.qb + (long)qi * d.qstep + 32 * ks + 8 * fq);
    Q.sp = *(const f32x4*)(d.sq + (long)qi * d.sqstep);
}
template <int NT, bool MASK>
__device__ __forceinline__ void attn_compute(LAS unsigned char* lds, const AD& d, const QR& Q, int lane, int wave) {
    const int fr = lane & 15, fq = lane >> 4, qi = wave * 16 + fr;
    const float rq = rsqrtf(((Q.sp[0] + Q.sp[1]) + (Q.sp[2] + Q.sp[3])) * (1.0f / 128.0f) + 1e-6f);
    const int ts = MASK ? (wave < 6 ? wave : 6) : 0;
    f32x4 s[NT];
#pragma unroll
    for (int tt = 0; tt < NT; ++tt) { s[tt] = (f32x4){0.f, 0.f, 0.f, 0.f};
#pragma unroll
        for (int ks = 0; ks < 4; ++ks) { const bf16x8 kf = *(const LAS bf16x8*)(lds + A_KOFF + (16 * (ts + tt) + fr) * KST + (32 * ks + 8 * fq) * 2);
            s[tt] = __builtin_amdgcn_mfma_f32_16x16x32_bf16(kf, Q.qf[ks], s[tt], 0, 0, 0); } }
    float mx = -3.0e38f;
#pragma unroll
    for (int tt = 0; tt < NT; ++tt) { const f32x4 rk4 = *(const LAS f32x4*)(lds + A_RKOFF + (16 * (ts + tt) + 4 * fq) * 4);
#pragma unroll
        for (int j = 0; j < 4; ++j) { const int kj = 16 * (ts + tt) + 4 * fq + j; float v = s[tt][j] * rq * rk4[j];
            if (MASK) { const bool valid = (kj >= qi) && (kj <= qi + 128) && (!d.nb0 || kj >= 128); v = valid ? v : -1.0e30f; }
            s[tt][j] = v; mx = fmaxf(mx, v); } }
    mx = fmaxf(mx, __shfl_xor(mx, 16)); mx = fmaxf(mx, __shfl_xor(mx, 32));
    float l = 0.f;
#pragma unroll
    for (int tt = 0; tt < NT; ++tt)
#pragma unroll
        for (int j = 0; j < 4; ++j) { const float p = __expf(s[tt][j] - mx); s[tt][j] = p; l += p; }
    l = pg8::quad_sum(l);
    f32x4 o[8];
#pragma unroll
    for (int dt = 0; dt < 8; ++dt) o[dt] = (f32x4){0.f, 0.f, 0.f, 0.f};
    const int q4 = fr >> 2, p4 = fr & 3;
#pragma unroll
    for (int pr = 0; pr < NT / 2; ++pr) { const bf16x8 pf = __builtin_bit_cast(bf16x8, pg8::pack8(s[2 * pr], s[2 * pr + 1]));
        LAS unsigned char* v0p = lds + A_VOFF + (16 * (ts + 2 * pr) + 4 * fq + q4) * KST + 8 * p4;
#pragma unroll
        for (int dt = 0; dt < 8; ++dt) { const s16x4 a0 = vtr(v0p + 32 * dt), a1 = vtr(v0p + 16 * KST + 32 * dt);
            const bf16x8 vf = __builtin_shufflevector(a0, a1, 0, 1, 2, 3, 4, 5, 6, 7);
            o[dt] = __builtin_amdgcn_mfma_f32_16x16x32_bf16(vf, pf, o[dt], 0, 0, 0); } }
    const float inv = 1.0f / l;
#pragma unroll
    for (int dt = 0; dt < 8; ++dt) { u32x2 w; w.x = pg8::cvt_pk_bf16(o[dt][0] * inv, o[dt][1] * inv); w.y = pg8::cvt_pk_bf16(o[dt][2] * inv, o[dt][3] * inv);
        *(u32x2*)(d.ob + (long)qi * d.ostep + 16 * dt + 4 * fq) = w; }
    if (d.ml && fq == 0) { d.ml[(long)qi * d.mlstep] = mx; d.ml[(long)qi * d.mlstep + 1] = l; }
}
__device__ __forceinline__ AD dil_desc(int u, bf16_t* BIG, float* SSQ, bf16_t* OG, float* ML) {
    const int g = u >> 9, rem = u & 511, b = rem >> 8, rem2 = rem & 255, h = rem2 & 3, blk = rem2 >> 2;
    const int dil = 1 << (2 * g), nbs = 64 >> (2 * g), r = blk / nbs, nb = blk % nbs;
    const long row0 = (long)b * SEQ + r, qrow = row0 + (long)dil * 128 * nb;
    AD d; d.qb = BIG + qrow * INW + (g * 4 + h) * 128; d.qstep = (long)dil * INW; d.sq = SSQ + qrow * 64 + (g * 4 + h) * 4; d.sqstep = (long)dil * 64;
    d.kb = BIG + row0 * INW + 1536 + h * 128; d.vb = BIG + row0 * INW + 2048 + h * 128; d.kstep = (long)dil * INW; d.ks0 = 128 * (nb - 1); d.sk = SSQ + row0 * 64 + (12 + h) * 4; d.skstep = (long)dil * 64;
    d.ob = OG + (size_t)g * M * 512 + qrow * 512 + h * 128; d.ostep = (long)dil * 512; d.ml = ML + (((size_t)g * M + qrow) * 4 + h) * 2; d.mlstep = (long)dil * 8; d.nb0 = nb == 0; return d;
}
__device__ __forceinline__ AD cross_desc(int u, bf16_t* QC, float* SSQC, bf16_t* MEMKV, float* SSQM, bf16_t* OC) {
    const int h = u & 3, qb = u >> 2, b = qb >> 6; const long qrow = (long)qb * 128;
    AD d; d.qb = QC + qrow * 512 + h * 128; d.qstep = 512; d.sq = SSQC + qrow * 16 + h * 4; d.sqstep = 16;
    d.kb = MEMKV + (size_t)b * NMEM * 1024 + h * 128; d.vb = d.kb + 512; d.kstep = 1024; d.ks0 = 0; d.sk = SSQM + (size_t)b * NMEM * 16 + h * 4; d.skstep = 16;
    d.ob = OC + qrow * 512 + h * 128; d.ostep = 512; d.ml = nullptr; d.mlstep = 0; d.nb0 = false; return d;
}

#define XB_TMO      128
#define XB_XCNT(j)  (256  + 64 * (j))
#define XB_XSUB(j)  (1280 + 64 * (j))
#define XB_XGEN(j)  (2304 + 64 * (j))
#define XB_TOP      3328
#define XB_TOPGEN   3392
#define XCD_BAR_WORDS 3456
#define XB_SPIN_CAP (1u << 18)

__device__ __forceinline__ unsigned xb_ld(unsigned* p)              { return __hip_atomic_load(p, __ATOMIC_RELAXED, __HIP_MEMORY_SCOPE_AGENT); }
__device__ __forceinline__ unsigned xb_add(unsigned* p, unsigned v) { return __hip_atomic_fetch_add(p, v, __ATOMIC_RELAXED, __HIP_MEMORY_SCOPE_AGENT); }
__device__ __forceinline__ unsigned xb_xcc_id() { return (unsigned)__builtin_amdgcn_s_getreg((3 << 11) | 20) & 0xFu; }
#define XB_SPIN(cond, bar) do { unsigned _sp = 0; while (cond) { __builtin_amdgcn_s_sleep(1); \
    if ((++_sp & 255u) == 0u) { if (xb_ld(&(bar)[XB_TMO])) break; if (_sp > XB_SPIN_CAP) { atomicAdd(&(bar)[XB_TMO], 1u); break; } } } } while (0)

struct XcdBarrier {
    unsigned* bar; unsigned x;
    volatile LAS unsigned* st;
};

__device__ __forceinline__ XcdBarrier xcd_barrier_post(unsigned* bar, volatile LAS unsigned* st) {
    XcdBarrier b; b.bar = bar; b.x = xb_xcc_id(); b.st = st;
    if (threadIdx.x == 0) (void)xb_add(&bar[XB_XCNT(b.x)], 1u);
    return b;
}
__device__ __forceinline__ void xcd_barrier_complete(unsigned* bar, unsigned x, unsigned& nloc, unsigned& nx) {
    const unsigned G = gridDim.x * gridDim.y * gridDim.z;
    unsigned sum, cnt, mine, sp = 0u;
    for (;;) {
        sum = 0u; cnt = 0u; mine = 0u;
#pragma unroll
        for (unsigned j = 0; j < 16; ++j) { const unsigned c = xb_ld(&bar[XB_XCNT(j)]); sum += c; cnt += (c > 0u) ? 1u : 0u; mine = (j == x) ? c : mine; }
        if (sum == G) break;
        __builtin_amdgcn_s_sleep(1);
        if ((++sp & 255u) == 0u) { if (xb_ld(&bar[XB_TMO])) break; if (sp > XB_SPIN_CAP) { atomicAdd(&bar[XB_TMO], 1u); break; } }
    }
    nloc = mine > 0u ? mine : 1u; nx = cnt > 0u ? cnt : 1u;
}

__device__ __forceinline__ void xcd_barrier(const XcdBarrier& b) {
    asm volatile("s_waitcnt vmcnt(0)" ::: "memory");
    __syncthreads();
    if (threadIdx.x == 0) {
        unsigned* bar = b.bar;
        __builtin_amdgcn_s_waitcnt(0);
        unsigned nloc = b.st[0], nx = b.st[1];
        if (nloc == 0u) { xcd_barrier_complete(bar, b.x, nloc, nx); b.st[0] = nloc; b.st[1] = nx; }
        const unsigned old = xb_add(&bar[XB_XSUB(b.x)], 1u);
        const unsigned gen = old / nloc;
        if (old + 1u == (gen + 1u) * nloc) {
            __builtin_amdgcn_fence(__ATOMIC_RELEASE, "agent");
            asm volatile("s_waitcnt vmcnt(0)" ::: "memory");
            const unsigned og = xb_add(&bar[XB_TOP], 1u);
            const unsigned tg = og / nx;
            if (og + 1u == (tg + 1u) * nx) xb_add(&bar[XB_TOPGEN], 1u);
            else XB_SPIN(xb_ld(&bar[XB_TOPGEN]) == tg, bar);
            __builtin_amdgcn_fence(__ATOMIC_ACQUIRE, "agent");
            xb_add(&bar[XB_XGEN(b.x)], 1u);
            asm volatile("s_waitcnt vmcnt(0)" ::: "memory");
        } else {
            XB_SPIN(xb_ld(&bar[XB_XGEN(b.x)]) == gen, bar);
            __builtin_amdgcn_fence(__ATOMIC_ACQUIRE, "agent");
            asm volatile("s_waitcnt vmcnt(0)" ::: "memory");
        }
    }
    __syncthreads();
}

#define REP_P0 1
#define REP_P1 1
#define REP_P2 1
#define REP_P2B 1
#define REP_P3 1
#define REP_P4 1
#define REP_P5 1
#define REP_P6 1
#define REP_P7 1
#define REP_P8 1
#define REP_SYNC 1
__global__ void __launch_bounds__(512) fwd(Args a) {
    extern __shared__ __attribute__((aligned(16))) unsigned char lds_raw[];
    LAS unsigned char* lds = (LAS unsigned char*)lds_raw;
    cg::grid_group grid = cg::this_grid();
    const int wave = __builtin_amdgcn_readfirstlane(threadIdx.x >> 6);
    const int G = gridDim.x, bx = blockIdx.x;
    unsigned char* ws = a.ws;
    volatile LAS unsigned* xst = (volatile LAS unsigned*)(lds + XB_LDS_OFF);
    if (threadIdx.x < 2) xst[threadIdx.x] = 0u;
    __syncthreads();
    const XcdBarrier xbar = xcd_barrier_post((unsigned*)ws, xst);
    if (ws == nullptr) grid.sync();
    const float* x = a.in[0]; const float* mem = a.in[1]; const int* pos = (const int*)a.in[2];
    bf16_t* Win = (bf16_t*)(ws + WS_WIN); bf16_t* Wout = (bf16_t*)(ws + WS_WOUT); bf16_t* Wcq = (bf16_t*)(ws + WS_WCQ); bf16_t* Wckv = (bf16_t*)(ws + WS_WCKV);
    bf16_t* Wco = (bf16_t*)(ws + WS_WCO); bf16_t* Wgu = (bf16_t*)(ws + WS_WGU); bf16_t* Wdn = (bf16_t*)(ws + WS_WDN);
    float* SSQ = (float*)(ws + WS_SSQ); float* COS = (float*)(ws + WS_COS); float* SIN = (float*)(ws + WS_SIN); float* RS1 = (float*)(ws + WS_RS1); float* RS2 = (float*)(ws + WS_RS2);
    float* SSQC = (float*)(ws + WS_SSQC); bf16_t* MEMN = (bf16_t*)(ws + WS_MEMN); bf16_t* MEMKV = (bf16_t*)(ws + WS_MEMKV); float* SSQM = (float*)(ws + WS_SSQM); float* ML = (float*)(ws + WS_ML);
    bf16_t* BA = (bf16_t*)(ws + WS_A); bf16_t* BB = (bf16_t*)(ws + WS_B); bf16_t* OG = (bf16_t*)(ws + WS_OG); bf16_t* QC = (bf16_t*)(ws + WS_QC); bf16_t* OC = (bf16_t*)(ws + WS_OC);
    bf16_t* BIG = (bf16_t*)(ws + WS_BIG);

    for (int rep = 0; rep < REP_P0; ++rep)
    {
        const int lane = pg8::fresh_lane(), tid = wave * 64 + lane;
        LAS float* scr = (LAS float*)(lds + wave * 16384);
        const int gw = bx * 8 + wave, NGW = G * 8;
        constexpr int I_IN = 16 * 96, I_OUT = 8 * 32, I_CQ = 16 * 16, I_CKV = 16 * 32, I_CO = 8 * 32, I_GU = 16 * 176, I_DN = 44 * 32;
        constexpr int NITEMS = I_IN + I_OUT + I_CQ + I_CKV + I_CO + I_GU + I_DN;
        for (int it = gw; it < NITEMS; it += NGW) {
            int r = it;
            if (r < I_IN) { tr_item<0>(a.in[4], INW, INW, nullptr, Win, 1024, scr, r, lane); continue; } r -= I_IN;
            if (r < I_OUT) { tr_item<0>(a.in[9], 1024, 1024, nullptr, Wout, 1024, scr, r, lane); continue; } r -= I_OUT;
            if (r < I_CQ) { tr_item<0>(a.in[12], 512, 512, a.in[10], Wcq, 1024, scr, r, lane); continue; } r -= I_CQ;
            if (r < I_CKV) { tr_item<0>(a.in[13], 1024, 1024, nullptr, Wckv, 1024, scr, r, lane); continue; } r -= I_CKV;
            if (r < I_CO) { tr_item<0>(a.in[16], 1024, 1024, nullptr, Wco, 512, scr, r, lane); continue; } r -= I_CO;
            if (r < I_GU) { tr_item<1>(a.in[18], 2 * DFF, 2 * DFF, a.in[17], Wgu, 1024, scr, r, lane); continue; } r -= I_GU;
            tr_item<0>(a.in[19], 1024, 1024, nullptr, Wdn, DFF, scr, r, lane);
        }
        {
            const float* pw = a.in[7]; const float* psc = a.in[8]; const float* wo = a.in[9];
            for (int idx = bx * 512 + tid; idx < 512 * 1024; idx += G * 512) { const int n = idx & 1023, kc = idx >> 10, g = kc >> 7;
                const float* pr = pw + (size_t)kc * 128; const float* sc = psc + g * 128; const float* wr_ = wo + (size_t)(512 + g * 128) * 1024 + n; float acc = 0.f;
#pragma unroll 8
                for (int e = 0; e < 128; ++e) acc += pr[e] * sc[e] * wr_[(size_t)e * 1024];
                Wout[(size_t)n * 1024 + 512 + kc] = (bf16_t)(pg8::cvt_pk_bf16(acc, 0.f) & 0xffffu); }
        }
        for (int m = gw; m < M + 512; m += 2 * NGW) { const int m1 = m + NGW; const bool has1 = m1 < M + 512; const int mb = has1 ? m1 : m;
            const float* xa = m < M ? x + (size_t)m * DM : mem + (size_t)(m - M) * DM; const float* ga = m < M ? a.in[3] : a.in[11]; bf16_t* oa = m < M ? BA + (size_t)m * DM : MEMN + (size_t)(m - M) * DM;
            const float* xb = mb < M ? x + (size_t)mb * DM : mem + (size_t)(mb - M) * DM; const float* gb = mb < M ? a.in[3] : a.in[11]; bf16_t* ob = mb < M ? BA + (size_t)mb * DM : MEMN + (size_t)(mb - M) * DM;
            rms_rows2(xa, ga, oa, xb, gb, ob, has1, lane);
        }
        for (int idx = bx * 512 + tid; idx < M * 16; idx += G * 512) { const int row = idx >> 4, i = idx & 15;
            const float ang = (float)pos[row] * a.invf[i]; float s, c; sincos_d(ang, s, c); COS[idx] = c; SIN[idx] = s; }
    }
    for (int rep = 0; rep < REP_SYNC; ++rep) xcd_barrier(xbar);

    for (int rep = 0; rep < REP_P1; ++rep)
    {
        pg8::Gemm g{BA, Win, M, INW, 1024}; pg8::StaticOrder S; S.init(M, INW, G, bx);
        pg8::EpiProj E{BIG, SSQ, COS, SIN, a.in[5], a.in[6]};
        pg8::gemm_phase<pg8::EpiProj, pg8::StaticOrder, true, true>(lds, g, S, E, wave);
    }
    for (int rep = 0; rep < REP_SYNC; ++rep) xcd_barrier(xbar);

    for (int rep = 0; rep < REP_P2; ++rep)
    { const int lane = pg8::fresh_lane(), tid = wave * 64 + lane;
      KVR R; int u = bx;
      if (u < 1536) { const AD d = dil_desc(u, BIG, SSQ, OG, ML); attn_load(d, R, tid); }
      for (; u < 1536; u += G) {
        const AD d = dil_desc(u, BIG, SSQ, OG, ML);
        attn_store(lds, R, tid); QR Q; attn_loadq(d, Q, lane, wave);
        __syncthreads();
        if (u + G < 1536) { const AD dn = dil_desc(u + G, BIG, SSQ, OG, ML); attn_load(dn, R, tid); }
        attn_compute<10, true>(lds, d, Q, lane, wave);
        __syncthreads();
      } }
    for (int rep = 0; rep < REP_SYNC; ++rep) xcd_barrier(xbar);

    for (int rep = 0; rep < REP_P2B; ++rep)
    { const int lane = pg8::fresh_lane(), tid = wave * 64 + lane; const long gt = (long)bx * 512 + tid, NTH = (long)G * 512;
      for (long i0 = gt; i0 < (long)M * 64; i0 += 2 * NTH) {
          const long i1 = i0 + NTH; const bool has1 = i1 < (long)M * 64; const long ii[2] = {i0, has1 ? i1 : i0};
          float mm[2][3], ll[2][3]; u32x4 og[2][3];
#pragma unroll
          for (int q = 0; q < 2; ++q) { const int row = (int)(ii[q] >> 6), c = (int)(ii[q] & 63), h = c >> 4;
#pragma unroll
              for (int g = 0; g < 3; ++g) { const float* p = ML + (((size_t)g * M + row) * 4 + h) * 2; mm[q][g] = p[0]; ll[q][g] = p[1]; og[q][g] = *(const u32x4*)(OG + (size_t)g * M * 512 + (size_t)row * 512 + c * 8); } }
#pragma unroll
          for (int q = 0; q < 2; ++q) { const int row = (int)(ii[q] >> 6), c = (int)(ii[q] & 63);
              const float mmax = fmaxf(mm[q][0], fmaxf(mm[q][1], mm[q][2])); float w[3], den = 0.f;
#pragma unroll
              for (int g = 0; g < 3; ++g) { w[g] = __expf(mm[q][g] - mmax) * ll[q][g]; den += w[g]; }
              const float inv = 1.0f / den; float o[8];
#pragma unroll
              for (int j = 0; j < 8; ++j) o[j] = 0.f;
#pragma unroll
              for (int g = 0; g < 3; ++g) { float f[8]; unpack8(og[q][g], f); const float wg = w[g] * inv;
#pragma unroll
                  for (int j = 0; j < 8; ++j) o[j] += wg * f[j]; }
              if (q == 0 || has1) *(u32x4*)(BA + (size_t)row * DM + c * 8) = pg8::pack8((f32x4){o[0], o[1], o[2], o[3]}, (f32x4){o[4], o[5], o[6], o[7]}); }
      }
#define POOL_GROUP(GP, W) \
      for (long i = gt; i < (long)M * 16; i += NTH) { const int row = (int)(i >> 4), ch = (int)(i & 15), t = row & (SEQ - 1); \
          const bf16_t* up = BIG + (size_t)row * INW + 2560 + (GP) * 128 + ch * 8; u32x4 ld[W]; \
          _Pragma("unroll") for (int k = 0; k < (W); ++k) ld[k] = *(const u32x4*)(up - (size_t)(k <= t ? k : 0) * INW); \
          float f0[8], sum[8]; unpack8(ld[0], f0); \
          _Pragma("unroll") for (int j = 0; j < 8; ++j) sum[j] = f0[j]; \
          _Pragma("unroll") for (int k = 1; k < (W); ++k) { float f[8]; unpack8(ld[k], f); const float v = k <= t ? 1.f : 0.f; \
              _Pragma("unroll") for (int j = 0; j < 8; ++j) sum[j] += v * f[j]; } \
          const int cnt = (t + 1) < (W) ? (t + 1) : (W); const float ic = 1.0f / (float)cnt; float d[8]; \
          _Pragma("unroll") for (int j = 0; j < 8; ++j) d[j] = sum[j] * ic - f0[j]; \
          *(u32x4*)(BA + (size_t)row * DM + 512 + (GP) * 128 + ch * 8) = pg8::pack8((f32x4){d[0], d[1], d[2], d[3]}, (f32x4){d[4], d[5], d[6], d[7]}); }
      POOL_GROUP(0, 2) POOL_GROUP(1, 4) POOL_GROUP(2, 8) POOL_GROUP(3, 16)
#undef POOL_GROUP
    }
    for (int rep = 0; rep < REP_SYNC; ++rep) xcd_barrier(xbar);

    for (int rep = 0; rep < REP_P3; ++rep)
    {
        pg8::Gemm g{BA, Wout, M, 1024, 1024}; pg8::StaticOrder S; S.init(M, 1024, G, bx);
        pg8::EpiRes E{x, a.out, BB, RS1};
        pg8::gemm_phase<pg8::EpiRes, pg8::StaticOrder, true, true>(lds, g, S, E, wave);
    }
    for (int rep = 0; rep < REP_SYNC; ++rep) xcd_barrier(xbar);

    for (int rep = 0; rep < REP_P4; ++rep)
    {
        const bool split = G >= 136;
        if (!split || bx < G - 8) {
            pg8::Gemm g{BB, Wcq, M, 512, 1024}; pg8::StaticOrder S; S.init(M, 512, split ? G - 8 : G, bx);
            pg8::EpiCq E{RS1, QC, SSQC, a.in[14]};
            pg8::gemm_phase<pg8::EpiCq, pg8::StaticOrder, true, true>(lds, g, S, E, wave);
        }
        if (!split || bx >= G - 8) {
            pg8::Gemm g{MEMN, Wckv, 512, 1024, 1024}; pg8::StaticOrder S; S.init(512, 1024, split ? 8 : G, split ? bx - (G - 8) : bx);
            pg8::EpiKv E{MEMKV, SSQM, a.in[15]};
            pg8::gemm_phase<pg8::EpiKv, pg8::StaticOrder, true, true>(lds, g, S, E, wave);
        }
    }
    for (int rep = 0; rep < REP_SYNC; ++rep) xcd_barrier(xbar);

    for (int rep = 0; rep < REP_P5; ++rep)
    { const int lane = pg8::fresh_lane(), tid = wave * 64 + lane;
      KVR R; int u = bx;
      if (u < 512) { const AD d = cross_desc(u, QC, SSQC, MEMKV, SSQM, OC); attn_load(d, R, tid); }
      for (; u < 512; u += G) {
        const AD d = cross_desc(u, QC, SSQC, MEMKV, SSQM, OC);
        attn_store(lds, R, tid); QR Q; attn_loadq(d, Q, lane, wave);
        __syncthreads();
        if (u + G < 512) { const AD dn = cross_desc(u + G, QC, SSQC, MEMKV, SSQM, OC); attn_load(dn, R, tid); }
        attn_compute<16, false>(lds, d, Q, lane, wave);
        __syncthreads();
      } }
    for (int rep = 0; rep < REP_SYNC; ++rep) xcd_barrier(xbar);

    for (int rep = 0; rep < REP_P6; ++rep)
    {
        pg8::Gemm g{OC, Wco, M, 1024, 512}; pg8::StaticOrder S; S.init(M, 1024, G, bx);
        pg8::EpiRes E{a.out, a.out, BA, RS2};
        pg8::gemm_phase<pg8::EpiRes, pg8::StaticOrder, true, true>(lds, g, S, E, wave);
    }
    for (int rep = 0; rep < REP_SYNC; ++rep) xcd_barrier(xbar);

    for (int rep = 0; rep < REP_P7; ++rep)
    {
        pg8::Gemm g{BA, Wgu, M, 2 * DFF, 1024}; pg8::StaticOrder S; S.init(M, 2 * DFF, G, bx);
        pg8::EpiSwiglu E{RS2, BIG};
        pg8::gemm_phase<pg8::EpiSwiglu, pg8::StaticOrder, true, true>(lds, g, S, E, wave);
    }
    for (int rep = 0; rep < REP_SYNC; ++rep) xcd_barrier(xbar);

    for (int rep = 0; rep < REP_P8; ++rep)
    {
        pg8::Gemm g{BIG, Wdn, M, 1024, DFF}; pg8::StaticOrder S; S.init(M, 1024, G, bx);
        pg8::EpiRes E{a.out, a.out, nullptr, nullptr};
        pg8::gemm_phase<pg8::EpiRes, pg8::StaticOrder, true, true>(lds, g, S, E, wave);
    }
}

extern "C" void kernel_launch(void* const* d_in, const int* in_sizes, int n_in, void* d_out, int out_size, void* d_ws, size_t ws_size, hipStream_t stream) {
    static int grid_blocks = 0;
    if (grid_blocks == 0) {
        if (n_in != 20 || ws_size < WS_END) { fprintf(stderr, "kernel_launch: unexpected inputs (n_in %d, ws %zu)\n", n_in, ws_size); grid_blocks = -1; return; }
        int dev = 0, cus = 0, per_cu = 0;
        hipGetDevice(&dev); hipDeviceGetAttribute(&cus, hipDeviceAttributeMultiprocessorCount, dev);
        if (hipFuncSetAttribute((const void*)fwd, hipFuncAttributeMaxDynamicSharedMemorySize, LDS_BYTES) != hipSuccess) { fprintf(stderr, "kernel_launch: hipFuncSetAttribute failed\n"); }
        if (hipOccupancyMaxActiveBlocksPerMultiprocessor(&per_cu, (const void*)fwd, 512, LDS_BYTES) != hipSuccess || per_cu < 1) { fprintf(stderr, "kernel_launch: occupancy query says %d\n", per_cu); per_cu = 1; }
        (void)hipGetLastError();
        grid_blocks = cus * 1;
        if (grid_blocks < 1) grid_blocks = 1;
    }
    if (grid_blocks < 0) return;
    if (hipMemsetAsync(d_ws, 0, 16384, stream) != hipSuccess) { fprintf(stderr, "kernel_launch: memset failed\n"); return; }
    Args a{};
    for (int i = 0; i < 20; ++i) a.in[i] = (const float*)d_in[i];
    a.out = (float*)d_out; a.ws = (unsigned char*)d_ws;
    for (int i = 0; i < 16; ++i) a.invf[i] = (float)std::pow(500000.0, -(double)i / 16.0);
    void* args[] = {&a};
    hipError_t e = hipLaunchCooperativeKernel((const void*)fwd, dim3(grid_blocks), dim3(512), args, LDS_BYTES, stream);
    if (e != hipSuccess) fprintf(stderr, "cooperative launch failed: %s (grid %d)\n", hipGetErrorString(e), grid_blocks);
}
```

```cpp
#include <hip/hip_runtime.h>
#include <hip/hip_cooperative_groups.h>
#include <cstdio>
#include <cstdint>
#include <cmath>
namespace cg = cooperative_groups;
namespace pg8 {
#define PG8_LAS __attribute__((address_space(3)))
typedef unsigned short bf16_t;
typedef short bf16x8 __attribute__((ext_vector_type(8)));
typedef float f32x4 __attribute__((ext_vector_type(4)));
typedef unsigned u32x4 __attribute__((ext_vector_type(4)));
constexpr int BM = 256, BK = 64, HALF = 128, HTB = HALF * BK * 2  , STAGE_BYTES = 8 * HTB, NXCD = 8, WGM = 8;

__host__ __device__ __forceinline__ int lds_byte(int r, int c) { const int st = (r >> 4) * 2 + (c >> 5), rr = r & 15, cc = c & 31, ob = rr * 64 + cc * 2; return st * 1024 + (ob ^ (((ob >> 9) & 1) << 5)); }
__host__ __device__ __forceinline__ void stage_rc(int b, int& R, int& C) { const int st = b / 1024, sb = b % 1024, swz = sb ^ (((sb >> 9) & 1) << 5); R = (st >> 1) * 16 + swz / 64; C = (st & 1) * 32 + (swz % 64) / 2; }
__host__ __device__ __forceinline__ int perm32(int rho) { const int n = rho >> 4, i = rho & 15; return 8 * (i >> 2) + 4 * n + (i & 3); }

struct Unit { int pm, pn; };
struct Gemm { const bf16_t* A; const bf16_t* Bt; int M, N, K; };

struct StaticOrder {
    int nM, nN, nwg, G, c;
    __host__ __device__ void init(int M, int N, int G_, int c_) { nM = M / BM; nN = N / BM; nwg = nM * nN; G = G_; c = c_; }
    __host__ __device__ bool next(int i, Unit& u) const {
        const long L = (long)i * G + c; if (L >= nwg) return false;
        int wgid = (int)L; { const int q = nwg / NXCD, r = nwg % NXCD, xcd = wgid % NXCD, off = wgid / NXCD; wgid = (xcd < r ? xcd * (q + 1) : r * (q + 1) + (xcd - r) * q) + off; }
        const int nig = WGM * nN, gid = wgid / nig, fm = gid * WGM, gsz = (nM - fm) < WGM ? (nM - fm) : WGM;
        u.pm = fm + ((wgid % nig) % gsz); u.pn = (wgid % nig) / gsz; return true;
    }
    __device__ __forceinline__ void a_ready(const Unit&) const {}
    __device__ __forceinline__ void done(const Unit&) const {}
};

__device__ __forceinline__ unsigned cvt_pk_bf16(float lo, float hi) { unsigned r; asm volatile("v_cvt_pk_bf16_f32 %0, %1, %2" : "=v"(r) : "v"(lo), "v"(hi)); return r; }
typedef float f32x2 __attribute__((ext_vector_type(2)));
__device__ __forceinline__ int fresh_lane() { int l; asm volatile("v_mbcnt_lo_u32_b32 %0, -1, 0\n\tv_mbcnt_hi_u32_b32 %0, -1, %0" : "=v"(l)); return l; }
template <class Epi, class Sched, bool ALIGN_EPI = false, bool SP2 = false>
__device__ __forceinline__ void gemm_phase(PG8_LAS unsigned char* lds, const Gemm g, const Sched& S, const Epi& E, const int wid) {
    const int lane = fresh_lane(), tid = wid * 64 + lane, wr = wid >> 2, wc = wid & 3, fr = lane & 15, fq = lane >> 4;
    const int K = g.K, nt = K / BK;
    unsigned voffA[2], voffB[2];
#pragma unroll
    for (int i = 0; i < 2; ++i) { int R, C; stage_rc(tid * 16 + i * 8192, R, C); const int Rb = Epi::PERM ? ((R & ~31) + perm32(R & 31)) : R;
        voffA[i] = (unsigned)(R * K + C) * 2u; voffB[i] = (unsigned)(Rb * K + C) * 2u; }
    const size_t kstep = (size_t)(BK * 2);
    const size_t hstep = (size_t)HALF * K * 2;
    const size_t tstep = 2 * hstep;
    const unsigned ldsw = (unsigned)wid * 1024u;
    const int aoff = lds_byte(wr * 64 + fr, fq * 8), boff = lds_byte(wc * 32 + fr, fq * 8);
#define PG8_SA(b, h) (((b) * 2 + (h)) * HTB)
#define PG8_SB(b, h) ((4 + (b) * 2 + (h)) * HTB)
#define PG8_STAGE(bufoff, gbase, voff) do { _Pragma("unroll") for (int _i = 0; _i < 2; ++_i) \
        __builtin_amdgcn_global_load_lds((const unsigned*)((const char*)(gbase) + (voff)[_i]), (PG8_LAS unsigned*)(lds + (bufoff) + ldsw + _i * 8192), 16, 0, 0); } while (0)
#define PG8_LDA(dst, b, h) do { _Pragma("unroll") for (int m = 0; m < 4; ++m) _Pragma("unroll") for (int k = 0; k < 2; ++k) dst[m][k] = *(const PG8_LAS bf16x8*)(lds + PG8_SA(b, h) + aoff + m * 2048 + k * 1024); } while (0)
#define PG8_LDB(dst, b, h) do { _Pragma("unroll") for (int n = 0; n < 2; ++n) _Pragma("unroll") for (int k = 0; k < 2; ++k) dst[n][k] = *(const PG8_LAS bf16x8*)(lds + PG8_SB(b, h) + boff + n * 2048 + k * 1024); } while (0)
#define PG8_MMA(ai, bj, At, Bt) do { __builtin_amdgcn_s_setprio(1); _Pragma("unroll") for (int m = 0; m < 4; ++m) _Pragma("unroll") for (int n = 0; n < 2; ++n) _Pragma("unroll") for (int k = 0; k < 2; ++k) \
        acc[ai][bj][m][n] = __builtin_amdgcn_mfma_f32_16x16x32_bf16(Bt[n][k], At[m][k], acc[ai][bj][m][n], 0, 0, 0); __builtin_amdgcn_s_setprio(0); } while (0)
#define PG8_WAIT_V(n) asm volatile("s_waitcnt vmcnt(" #n ")" ::: "memory")
#define PG8_WAIT_L(n) asm volatile("s_waitcnt lgkmcnt(" #n ")" ::: "memory")
#define PG8_BAR __builtin_amdgcn_s_barrier()
#define PG8_SCHED __builtin_amdgcn_sched_barrier(0)
    Unit cur, nxt; int ui = 0;
    if (!S.next(0, cur)) return;
    f32x4 acc[2][2][4][2];
#pragma unroll
    for (int a = 0; a < 2; ++a)
#pragma unroll
        for (int b = 0; b < 2; ++b)
#pragma unroll
            for (int m = 0; m < 4; ++m)
#pragma unroll
                for (int n = 0; n < 2; ++n) acc[a][b][m][n] = (f32x4){0.f, 0.f, 0.f, 0.f};
    bf16x8 At[4][2], B0[2][2], B1[2][2];
    const char* cA = (const char*)g.A + (size_t)cur.pm * tstep; const char* cB = (const char*)g.Bt + (size_t)cur.pn * tstep;
    S.a_ready(cur);
    if constexpr (SP2) {
        PG8_STAGE(PG8_SB(0, 0), cB, voffB); PG8_STAGE(PG8_SB(0, 1), cB + hstep, voffB); PG8_STAGE(PG8_SA(0, 0), cA, voffA); PG8_STAGE(PG8_SA(0, 1), cA + hstep, voffA);
        if (wr == 1) PG8_BAR;
        PG8_WAIT_V(2); PG8_BAR;
        PG8_STAGE(PG8_SB(1, 0), cB + kstep, voffB); PG8_STAGE(PG8_SA(1, 0), cA + kstep, voffA); PG8_STAGE(PG8_SB(1, 1), cB + hstep + kstep, voffB);
        PG8_WAIT_V(6); PG8_BAR;
    } else {
        PG8_STAGE(PG8_SB(0, 0), cB, voffB); PG8_STAGE(PG8_SA(0, 0), cA, voffA); PG8_STAGE(PG8_SB(0, 1), cB + hstep, voffB); PG8_STAGE(PG8_SA(0, 1), cA + hstep, voffA);
        if (wr == 1) PG8_BAR;
        PG8_WAIT_V(4); PG8_BAR;
        PG8_STAGE(PG8_SB(1, 0), cB + kstep, voffB); PG8_STAGE(PG8_SA(1, 0), cA + kstep, voffA); PG8_STAGE(PG8_SB(1, 1), cB + hstep + kstep, voffB);
        PG8_WAIT_V(6); PG8_BAR;
    }
    for (;;) {
        const bool has_next = S.next(ui + 1, nxt);
        const char* nA = has_next ? (const char*)g.A + (size_t)nxt.pm * tstep : cA; const char* nB = has_next ? (const char*)g.Bt + (size_t)nxt.pn * tstep : cB;
        for (int t = 0; t < nt; t += 2) {
            const bool last = (t == nt - 2);
            const char* a1 = cA + (size_t)(t + 1) * kstep;
            const char* a2 = last ? nA : cA + (size_t)(t + 2) * kstep; const char* b2 = last ? nB : cB + (size_t)(t + 2) * kstep;
            const char* a3 = a2 + kstep; const char* b3 = b2 + kstep;
            if (last && has_next) S.a_ready(nxt);
            if constexpr (SP2) {
            PG8_LDB(B0, 0, 0); PG8_LDB(B1, 0, 1); PG8_SCHED; PG8_LDA(At, 0, 0); PG8_STAGE(PG8_SA(1, 1), a1 + hstep, voffA);
            PG8_WAIT_V(8); PG8_WAIT_L(0); PG8_BAR; PG8_MMA(0, 0, At, B0); PG8_MMA(0, 1, At, B1); PG8_BAR; PG8_SCHED;
            PG8_LDA(At, 0, 1); PG8_STAGE(PG8_SB(0, 0), b2, voffB); PG8_STAGE(PG8_SB(0, 1), b2 + hstep, voffB); PG8_STAGE(PG8_SA(0, 0), a2, voffA);
            PG8_WAIT_V(8); PG8_WAIT_L(0); PG8_BAR; PG8_MMA(1, 0, At, B0); PG8_MMA(1, 1, At, B1); PG8_BAR; PG8_SCHED;
            PG8_LDB(B0, 1, 0); PG8_LDB(B1, 1, 1); PG8_SCHED; PG8_LDA(At, 1, 0); PG8_STAGE(PG8_SA(0, 1), a2 + hstep, voffA);
            PG8_WAIT_V(8); PG8_WAIT_L(0); PG8_BAR; PG8_MMA(0, 0, At, B0); PG8_MMA(0, 1, At, B1); PG8_BAR; PG8_SCHED;
            PG8_LDA(At, 1, 1); PG8_STAGE(PG8_SB(1, 0), b3, voffB); PG8_STAGE(PG8_SB(1, 1), b3 + hstep, voffB); PG8_STAGE(PG8_SA(1, 0), a3, voffA);
            PG8_WAIT_V(8); PG8_WAIT_L(0); PG8_BAR; PG8_MMA(1, 0, At, B0); PG8_MMA(1, 1, At, B1); PG8_BAR; PG8_SCHED;
            } else {
            PG8_LDB(B0, 0, 0); PG8_SCHED; PG8_LDA(At, 0, 0); PG8_STAGE(PG8_SA(1, 1), a1 + hstep, voffA);
            PG8_WAIT_L(8); PG8_BAR; PG8_WAIT_L(0); PG8_MMA(0, 0, At, B0); PG8_BAR; PG8_SCHED;
            PG8_LDB(B1, 0, 1); PG8_STAGE(PG8_SB(0, 0), b2, voffB);
            PG8_BAR; PG8_WAIT_L(0); PG8_MMA(0, 1, At, B1); PG8_BAR;
            PG8_LDA(At, 0, 1); PG8_STAGE(PG8_SA(0, 0), a2, voffA);
            PG8_BAR; PG8_WAIT_L(0); PG8_MMA(1, 0, At, B0); PG8_BAR; PG8_SCHED;
            PG8_STAGE(PG8_SB(0, 1), b2 + hstep, voffB);
            PG8_WAIT_V(6); PG8_BAR; PG8_MMA(1, 1, At, B1); PG8_BAR;
            PG8_LDB(B0, 1, 0); PG8_SCHED; PG8_LDA(At, 1, 0); PG8_STAGE(PG8_SA(0, 1), a2 + hstep, voffA);
            PG8_WAIT_L(8); PG8_BAR; PG8_WAIT_L(0); PG8_MMA(0, 0, At, B0); PG8_BAR; PG8_SCHED;
            PG8_LDB(B1, 1, 1); PG8_STAGE(PG8_SB(1, 0), b3, voffB);
            PG8_BAR; PG8_WAIT_L(0); PG8_MMA(0, 1, At, B1); PG8_BAR;
            PG8_LDA(At, 1, 1); PG8_STAGE(PG8_SA(1, 0), a3, voffA);
            PG8_BAR; PG8_WAIT_L(0); PG8_MMA(1, 0, At, B0); PG8_BAR; PG8_SCHED;
            PG8_STAGE(PG8_SB(1, 1), b3 + hstep, voffB);
            PG8_WAIT_V(6); PG8_BAR; PG8_MMA(1, 1, At, B1); PG8_BAR;
            }
        }
        if constexpr (ALIGN_EPI) { if (wr == 0) PG8_BAR; }
        if constexpr (!Epi::AFTER_DRAIN) { E(acc, cur, wr, wc, fr, fq); S.done(cur); }
        if (!has_next) break;
#pragma unroll
        for (int a = 0; a < 2; ++a)
#pragma unroll
            for (int b = 0; b < 2; ++b)
#pragma unroll
                for (int m = 0; m < 4; ++m)
#pragma unroll
                    for (int n = 0; n < 2; ++n) acc[a][b][m][n] = (f32x4){0.f, 0.f, 0.f, 0.f};
        cur = nxt; cA = nA; cB = nB; ++ui;
        if constexpr (ALIGN_EPI) { if (wr == 1) PG8_BAR; }
    }
    PG8_WAIT_V(0);
    if constexpr (!ALIGN_EPI) { if (wr == 0) PG8_BAR; }
    PG8_BAR;
    if constexpr (Epi::AFTER_DRAIN) { E.fused(acc, cur, wr, wc, fr, fq, lds, wid, lane); S.done(cur); }
#undef PG8_SA
#undef PG8_SB
#undef PG8_STAGE
#undef PG8_LDA
#undef PG8_LDB
#undef PG8_MMA
#undef PG8_WAIT_V
#undef PG8_WAIT_L
#undef PG8_BAR
#undef PG8_SCHED
}
}

namespace pg8 {
__device__ __forceinline__ u32x4 pack8(const f32x4 v0, const f32x4 v1) {
    u32x4 w; w.x = cvt_pk_bf16(v0[0], v0[1]); w.y = cvt_pk_bf16(v0[2], v0[3]); w.z = cvt_pk_bf16(v1[0], v1[1]); w.w = cvt_pk_bf16(v1[2], v1[3]); return w; }
__device__ __forceinline__ float quad_sum(float s) { s += __shfl_xor(s, 16); s += __shfl_xor(s, 32); return s; }
__device__ __forceinline__ float sq8(const f32x4 a, const f32x4 b) { return (a[0] * a[0] + a[1] * a[1]) + (a[2] * a[2] + a[3] * a[3]) + (b[0] * b[0] + b[1] * b[1]) + (b[2] * b[2] + b[3] * b[3]); }
__device__ __forceinline__ float row_rstd16(const float* rs, int row) {
    const f32x4* p = (const f32x4*)(rs + (size_t)row * 16); const f32x4 a = (p[0] + p[1]) + (p[2] + p[3]);
    return rsqrtf(((a[0] + a[1]) + (a[2] + a[3])) * (1.0f / 1024.0f) + 1e-6f); }

struct EpiProj {
    static constexpr bool PERM = true, AFTER_DRAIN = false;
    bf16_t* O; float* ssq; const float* cosT; const float* sinT; const float* gq; const float* gk;
    __device__ __forceinline__ void operator()(const f32x4 (&acc)[2][2][4][2], const Unit& u, int wr, int wc, int fr, int fq) const {
        const int pn = u.pn, row0 = u.pm * BM + wr * 64 + fr, cw = wc * 32 + 8 * fq;
        if (pn >= 8) {
#pragma unroll
            for (int ai = 0; ai < 2; ++ai)
#pragma unroll
                for (int m = 0; m < 4; ++m) { bf16_t* rowp = O + (size_t)(row0 + ai * HALF + m * 16) * 3072 + pn * BM + cw;
#pragma unroll
                    for (int bj = 0; bj < 2; ++bj) *(u32x4*)(rowp + bj * HALF) = pack8(acc[ai][bj][m][0], acc[ai][bj][m][1]); }
        } else {
            const bool isq = pn < 6; const float* g = isq ? gq : gk;
            const f32x4 g0 = *(const f32x4*)(g + cw), g1 = *(const f32x4*)(g + cw + 4);
            const float sc = isq ? 0.08838834764831845f : 1.0f;
            const float sg = (fq < 2) ? -1.0f : 1.0f;
#pragma unroll
            for (int ai = 0; ai < 2; ++ai)
#pragma unroll
                for (int m = 0; m < 4; ++m) { const int row = row0 + ai * HALF + m * 16;
                    f32x4 c0 = {0.f, 0.f, 0.f, 0.f}, c1 = c0, s0 = c0, s1 = c0;
                    if (wc == 0) { const float* cp = cosT + (size_t)row * 16 + 8 * (fq & 1); const float* sp = sinT + (size_t)row * 16 + 8 * (fq & 1);
                        c0 = *(const f32x4*)cp; c1 = *(const f32x4*)(cp + 4); s0 = *(const f32x4*)sp; s1 = *(const f32x4*)(sp + 4); }
                    bf16_t* rowp = O + (size_t)row * 3072 + pn * BM + cw;
#pragma unroll
                    for (int bj = 0; bj < 2; ++bj) { f32x4 v0 = acc[ai][bj][m][0], v1 = acc[ai][bj][m][1];
                        const float ss = quad_sum(sq8(v0, v1));
                        if (fq == 0) ssq[(size_t)row * 64 + (pn * 2 + bj) * 4 + wc] = ss;
                        v0 = v0 * g0; v1 = v1 * g1;
                        if (wc == 0) { f32x4 p0, p1;
#pragma unroll
                            for (int j = 0; j < 4; ++j) { p0[j] = __shfl_xor(v0[j], 32); p1[j] = __shfl_xor(v1[j], 32); }
                            v0 = v0 * c0 + (p0 * s0) * sg; v1 = v1 * c1 + (p1 * s1) * sg; }
                        v0 = v0 * sc; v1 = v1 * sc;
                        *(u32x4*)(rowp + bj * HALF) = pack8(v0, v1); } }
        }
    }
};
struct EpiRes {
    static constexpr bool PERM = true, AFTER_DRAIN = false;
    const float* baseF; const bf16_t* baseB; float* outF; bf16_t* outB; float* rs;
    __device__ __forceinline__ void operator()(const f32x4 (&acc)[2][2][4][2], const Unit& u, int wr, int wc, int fr, int fq) const {
        const int row0 = u.pm * BM + wr * 64 + fr, col0 = u.pn * BM + wc * 32 + 8 * fq;
#pragma unroll
        for (int ai = 0; ai < 2; ++ai)
#pragma unroll
            for (int m = 0; m < 4; ++m) { const int row = row0 + ai * HALF + m * 16; const size_t off = (size_t)row * 1024 + col0; float ss = 0.f;
#pragma unroll
                for (int bj = 0; bj < 2; ++bj) { f32x4 b0, b1;
                    if (baseF) { const float* bp = baseF + off + bj * HALF; b0 = *(const f32x4*)bp; b1 = *(const f32x4*)(bp + 4); }
                    else { const u32x4 w = *(const u32x4*)(baseB + off + bj * HALF);
                        b0 = (f32x4){__uint_as_float(w.x << 16), __uint_as_float(w.x & 0xffff0000u), __uint_as_float(w.y << 16), __uint_as_float(w.y & 0xffff0000u)};
                        b1 = (f32x4){__uint_as_float(w.z << 16), __uint_as_float(w.z & 0xffff0000u), __uint_as_float(w.w << 16), __uint_as_float(w.w & 0xffff0000u)}; }
                    const f32x4 v0 = acc[ai][bj][m][0] + b0, v1 = acc[ai][bj][m][1] + b1;
                    if (outF) { *(f32x4*)(outF + off + bj * HALF) = v0; *(f32x4*)(outF + off + bj * HALF + 4) = v1; }
                    if (outB) *(u32x4*)(outB + off + bj * HALF) = pack8(v0, v1);
                    ss += sq8(v0, v1); }
                if (rs) { ss = quad_sum(ss); if (fq == 0) rs[(size_t)row * 16 + u.pn * 4 + wc] = ss; } }
    }
};
struct EpiCq {
    static constexpr bool PERM = true, AFTER_DRAIN = false;
    const float* rs1; bf16_t* O; float* ssqc; const float* g;
    __device__ __forceinline__ void operator()(const f32x4 (&acc)[2][2][4][2], const Unit& u, int wr, int wc, int fr, int fq) const {
        const int row0 = u.pm * BM + wr * 64 + fr, cw = wc * 32 + 8 * fq;
        const f32x4 g0 = *(const f32x4*)(g + cw) * 0.08838834764831845f, g1 = *(const f32x4*)(g + cw + 4) * 0.08838834764831845f;
#pragma unroll
        for (int ai = 0; ai < 2; ++ai)
#pragma unroll
            for (int m = 0; m < 4; ++m) { const int row = row0 + ai * HALF + m * 16; const float rstd = row_rstd16(rs1, row);
                bf16_t* rowp = O + (size_t)row * 512 + u.pn * BM + cw;
#pragma unroll
                for (int bj = 0; bj < 2; ++bj) { f32x4 v0 = acc[ai][bj][m][0] * rstd, v1 = acc[ai][bj][m][1] * rstd;
                    const float ss = quad_sum(sq8(v0, v1));
                    if (fq == 0) ssqc[(size_t)row * 16 + (u.pn * 2 + bj) * 4 + wc] = ss;
                    *(u32x4*)(rowp + bj * HALF) = pack8(v0 * g0, v1 * g1); } }
    }
};
struct EpiKv {
    static constexpr bool PERM = true, AFTER_DRAIN = false;
    bf16_t* O; float* ssqm; const float* g;
    __device__ __forceinline__ void operator()(const f32x4 (&acc)[2][2][4][2], const Unit& u, int wr, int wc, int fr, int fq) const {
        const int row0 = u.pm * BM + wr * 64 + fr, cw = wc * 32 + 8 * fq; const bool isk = u.pn < 2;
        f32x4 g0 = {1.f, 1.f, 1.f, 1.f}, g1 = g0;
        if (isk) { g0 = *(const f32x4*)(g + cw); g1 = *(const f32x4*)(g + cw + 4); }
#pragma unroll
        for (int ai = 0; ai < 2; ++ai)
#pragma unroll
            for (int m = 0; m < 4; ++m) { const int row = row0 + ai * HALF + m * 16; bf16_t* rowp = O + (size_t)row * 1024 + u.pn * BM + cw;
#pragma unroll
                for (int bj = 0; bj < 2; ++bj) { const f32x4 v0 = acc[ai][bj][m][0], v1 = acc[ai][bj][m][1];
                    if (isk) { const float ss = quad_sum(sq8(v0, v1)); if (fq == 0) ssqm[(size_t)row * 16 + (u.pn * 2 + bj) * 4 + wc] = ss; }
                    *(u32x4*)(rowp + bj * HALF) = pack8(v0 * g0, v1 * g1); } }
    }
};
struct EpiSwiglu {
    static constexpr bool PERM = true, AFTER_DRAIN = false;
    const float* rs2; bf16_t* act;
    __device__ __forceinline__ void operator()(const f32x4 (&acc)[2][2][4][2], const Unit& u, int wr, int wc, int fr, int fq) const {
        const int row0 = u.pm * BM + wr * 64 + fr, cw = wc * 32 + 8 * fq;
#pragma unroll
        for (int ai = 0; ai < 2; ++ai)
#pragma unroll
            for (int m = 0; m < 4; ++m) { const int row = row0 + ai * HALF + m * 16; const float rstd = row_rstd16(rs2, row);
                f32x4 a[2];
#pragma unroll
                for (int n = 0; n < 2; ++n) { const f32x4 gg = acc[ai][0][m][n] * rstd, uu = acc[ai][1][m][n] * rstd;
#pragma unroll
                    for (int j = 0; j < 4; ++j) a[n][j] = gg[j] * __builtin_amdgcn_rcpf(1.0f + __expf(-gg[j])) * uu[j]; }
                *(u32x4*)(act + (size_t)row * 2816 + u.pn * HALF + cw) = pack8(a[0], a[1]); }
    }
};
}

#define LAS __attribute__((address_space(3)))
typedef unsigned short bf16_t;
typedef short bf16x8 __attribute__((ext_vector_type(8)));
typedef short s16x4 __attribute__((ext_vector_type(4)));
typedef float f32x4 __attribute__((ext_vector_type(4)));
typedef unsigned u32x4 __attribute__((ext_vector_type(4)));
typedef unsigned u32x2 __attribute__((ext_vector_type(2)));
constexpr int M = 16384, SEQ = 8192, DM = 1024, INW = 3072, DFF = 2816, NMEM = 256;
constexpr size_t MiB = 1u << 20;
constexpr size_t WS_WIN = 1 * MiB, WS_WOUT = 7 * MiB, WS_WCQ = 9 * MiB, WS_WCKV = 10 * MiB, WS_WCO = 12 * MiB, WS_WGU = 13 * MiB, WS_WDN = 24 * MiB;
constexpr size_t WS_SSQ = 30 * MiB, WS_COS = 34 * MiB, WS_SIN = 35 * MiB, WS_RS1 = 36 * MiB, WS_RS2 = 37 * MiB, WS_SSQC = 38 * MiB, WS_MEMN = 39 * MiB, WS_MEMKV = 40 * MiB, WS_SSQM = 41 * MiB, WS_ML = 42 * MiB;
constexpr size_t WS_A = 48 * MiB;
constexpr size_t WS_B = 80 * MiB;
constexpr size_t WS_OG = 80 * MiB;
constexpr size_t WS_QC = 112 * MiB, WS_OC = 128 * MiB;
constexpr size_t WS_BIG = 144 * MiB;
constexpr size_t WS_END = 240 * MiB;
constexpr int LDS_BYTES = 149504, XB_LDS_OFF = 149000;
constexpr int KST = 288, A_KOFF = 0, A_VOFF = 256 * KST, A_RKOFF = 2 * 256 * KST;
static_assert(A_RKOFF + 1024 <= LDS_BYTES && pg8::STAGE_BYTES <= LDS_BYTES, "LDS map");

struct Args { const float* in[20]; float* out; unsigned char* ws; float invf[16]; };

__device__ __forceinline__ float wave_sum(float v) {
#pragma unroll
    for (int o = 1; o < 64; o <<= 1) v += __shfl_xor(v, o);
    return v;
}
__device__ __forceinline__ float bf_lo(unsigned w) { return __uint_as_float(w << 16); }
__device__ __forceinline__ float bf_hi(unsigned w) { return __uint_as_float(w & 0xffff0000u); }
__device__ __forceinline__ void unpack8(const u32x4 w, float (&f)[8]) { f[0] = bf_lo(w.x); f[1] = bf_hi(w.x); f[2] = bf_lo(w.y); f[3] = bf_hi(w.y); f[4] = bf_lo(w.z); f[5] = bf_hi(w.z); f[6] = bf_lo(w.w); f[7] = bf_hi(w.w); }

template <int MODE>
__device__ __forceinline__ void tr_item(const float* W, int Nsrc, int Ndst, const float* gain, bf16_t* WT, int ldt, LAS float* scr, int item, int lane) {
    const int nblk = Ndst / 32, kb = item / nblk, nb = item % nblk, k0 = 64 * kb, n0 = 32 * nb;
    const int s0 = MODE == 1 ? (((n0 >> 7) & 1) * DFF + (n0 >> 8) * 128 + (n0 & 127)) : n0;
    const int kr = lane >> 3, ch = lane & 7; f32x4 w[8];
#pragma unroll
    for (int i = 0; i < 8; ++i) w[i] = *(const f32x4*)(W + (size_t)(k0 + kr + 8 * i) * Nsrc + s0 + 4 * ch);
#pragma unroll
    for (int i = 0; i < 8; ++i) { const int kk = kr + 8 * i; const float gm = gain ? gain[k0 + kk] : 1.0f;
#pragma unroll
        for (int j = 0; j < 4; ++j) scr[kk * 33 + 4 * ch + j] = w[i][j] * gm; }
    asm volatile("s_waitcnt lgkmcnt(0)" ::: "memory");
    const int c = lane & 7;
#pragma unroll
    for (int j = 0; j < 4; ++j) { const int n = (lane >> 3) + 8 * j; const LAS float* s = scr + (8 * c) * 33 + n;
        u32x4 o; o.x = pg8::cvt_pk_bf16(s[0 * 33], s[1 * 33]); o.y = pg8::cvt_pk_bf16(s[2 * 33], s[3 * 33]); o.z = pg8::cvt_pk_bf16(s[4 * 33], s[5 * 33]); o.w = pg8::cvt_pk_bf16(s[6 * 33], s[7 * 33]);
        *(u32x4*)(WT + (size_t)(n0 + n) * ldt + k0 + 8 * c) = o; }
    asm volatile("s_waitcnt lgkmcnt(0)" ::: "memory");
}
__device__ __forceinline__ void rms_rows2(const float* x0, const float* g0, bf16_t* o0, const float* x1, const float* g1, bf16_t* o1, bool has1, int lane) {
    const f32x4* xr0 = (const f32x4*)x0 + lane; const f32x4* xr1 = (const f32x4*)x1 + lane;
    f32x4 v0[4], v1[4]; float s0 = 0.f, s1 = 0.f;
#pragma unroll
    for (int j = 0; j < 4; ++j) { v0[j] = xr0[64 * j]; v1[j] = xr1[64 * j]; }
#pragma unroll
    for (int j = 0; j < 4; ++j) { s0 += (v0[j][0] * v0[j][0] + v0[j][1] * v0[j][1]) + (v0[j][2] * v0[j][2] + v0[j][3] * v0[j][3]); s1 += (v1[j][0] * v1[j][0] + v1[j][1] * v1[j][1]) + (v1[j][2] * v1[j][2] + v1[j][3] * v1[j][3]); }
    const float r0 = rsqrtf(wave_sum(s0) * (1.0f / 1024.0f) + 1e-6f), r1 = rsqrtf(wave_sum(s1) * (1.0f / 1024.0f) + 1e-6f);
    const f32x4* gr0 = (const f32x4*)g0 + lane; const f32x4* gr1 = (const f32x4*)g1 + lane;
    u32x2* p0 = (u32x2*)o0 + lane; u32x2* p1 = (u32x2*)o1 + lane;
#pragma unroll
    for (int j = 0; j < 4; ++j) { const f32x4 y = v0[j] * r0 * gr0[64 * j]; u32x2 w; w.x = pg8::cvt_pk_bf16(y[0], y[1]); w.y = pg8::cvt_pk_bf16(y[2], y[3]); p0[64 * j] = w; }
    if (has1) {
#pragma unroll
        for (int j = 0; j < 4; ++j) { const f32x4 y = v1[j] * r1 * gr1[64 * j]; u32x2 w; w.x = pg8::cvt_pk_bf16(y[0], y[1]); w.y = pg8::cvt_pk_bf16(y[2], y[3]); p1[64 * j] = w; } }
}
__device__ __forceinline__ void sincos_d(float ang, float& s, float& c) {
    const double x = (double)ang; const double kq = rint(x * 0.63661977236758134308);
    const double r = (x - kq * 1.5707963267948966192) - kq * 6.123233995736766036e-17; const double r2 = r * r;
    double sp = -7.6471637318198164759e-13; sp = sp * r2 + 1.6059043836821614599e-10; sp = sp * r2 - 2.5052108385441718775e-08; sp = sp * r2 + 2.7557319223985890653e-06;
    sp = sp * r2 - 1.9841269841269841270e-04; sp = sp * r2 + 8.3333333333333333333e-03; sp = sp * r2 - 1.6666666666666666667e-01; sp = r + r * r2 * sp;
    double cp = 4.7794773323873852974e-14; cp = cp * r2 - 1.1470745597729724714e-11; cp = cp * r2 + 2.0876756987868098979e-09; cp = cp * r2 - 2.7557319223985890653e-07;
    cp = cp * r2 + 2.4801587301587301587e-05; cp = cp * r2 - 1.3888888888888888889e-03; cp = cp * r2 + 4.1666666666666666667e-02; cp = cp * r2 - 0.5; cp = 1.0 + r2 * cp;
    const int q = (int)((long long)kq & 3);
    const double sv = (q & 1) ? cp : sp, cv = (q & 1) ? sp : cp;
    s = (float)((q & 2) ? -sv : sv); c = (float)(((q + 1) & 2) ? -cv : cv);
}

__device__ __forceinline__ s16x4 vtr(LAS unsigned char* p) { return __builtin_bit_cast(s16x4, __builtin_amdgcn_ds_read_tr16_b64_v4i16((LAS s16x4*)p)); }
struct AD {
    const bf16_t* qb; long qstep; const float* sq; long sqstep; const bf16_t* kb; const bf16_t* vb; long kstep; int ks0; const float* sk; long skstep;
    bf16_t* ob; long ostep; float* ml; long mlstep; bool nb0; };
struct KVR { u32x4 kr[8], vr[8]; f32x4 sp; };
__device__ __forceinline__ void attn_load(const AD& d, KVR& R, int tid, bool first) {
    const int c = tid & 15, rr = tid >> 4;
#pragma unroll
    for (int it = 0; it < 4; ++it) { const int sidx = d.ks0 + 128 + rr + 32 * it; const long off = (long)sidx * d.kstep + 8 * c;
        R.kr[it] = *(const u32x4*)(d.kb + off); R.vr[it] = *(const u32x4*)(d.vb + off); }
    if (first) {
#pragma unroll
        for (int it = 4; it < 8; ++it) { int sidx = d.ks0 + rr + 32 * (it - 4); sidx = sidx < 0 ? 0 : sidx; const long off = (long)sidx * d.kstep + 8 * c;
            R.kr[it] = *(const u32x4*)(d.kb + off); R.vr[it] = *(const u32x4*)(d.vb + off); } }
    { int sidx = d.ks0 + ((tid + 128) & 255); sidx = sidx < 0 ? 0 : sidx; R.sp = *(const f32x4*)(d.sk + (long)sidx * d.skstep); }
}
__device__ __forceinline__ void attn_store(LAS unsigned char* lds, const KVR& R, int tid, bool first, int par) {
    const int c = tid & 15, rr = tid >> 4;
#pragma unroll
    for (int it = 0; it < 4; ++it) { const int row = (128 + rr + 32 * it) ^ (128 * par);
        *(LAS u32x4*)(lds + A_KOFF + row * KST + c * 16) = R.kr[it]; *(LAS u32x4*)(lds + A_VOFF + row * KST + c * 16) = R.vr[it]; }
    if (first) {
#pragma unroll
        for (int it = 4; it < 8; ++it) { const int row = (rr + 32 * (it - 4)) ^ (128 * par);
            *(LAS u32x4*)(lds + A_KOFF + row * KST + c * 16) = R.kr[it]; *(LAS u32x4*)(lds + A_VOFF + row * KST + c * 16) = R.vr[it]; } }
    if (tid < 128 || (first && tid < 256)) ((LAS float*)(lds + A_RKOFF))[((tid + 128) & 255) ^ (128 * par)] = rsqrtf(((R.sp[0] + R.sp[1]) + (R.sp[2] + R.sp[3])) * (1.0f / 128.0f) + 1e-6f);
}
struct QR { bf16x8 qf[4]; f32x4 sp; };
__device__ __forceinline__ void attn_loadq(const AD& d, QR& Q, int lane, int wave) {
    const int fr = lane & 15, fq = lane >> 4, qi = wave * 16 + fr;
#pragma unroll
    for (int ks = 0; ks < 4; ++ks) Q.qf[ks] = *(const bf16x8*)(d.qb + (long)qi * d.qstep + 32 * ks + 8 * fq);
    Q.sp = *(const f32x4*)(d.sq + (long)qi * d.sqstep);
}
template <int NT, bool MASK>
__device__ __forceinline__ void attn_compute(LAS unsigned char* lds, const AD& d, const QR& Q, int lane, int wave, int par) {
    const int fr = lane & 15, fq = lane >> 4, qi = wave * 16 + fr;
    const float rq = rsqrtf(((Q.sp[0] + Q.sp[1]) + (Q.sp[2] + Q.sp[3])) * (1.0f / 128.0f) + 1e-6f);
    const int ts = MASK ? (wave < 6 ? wave : 6) : 0;
    f32x4 s[NT];
#pragma unroll
    for (int tt = 0; tt < NT; ++tt) { s[tt] = (f32x4){0.f, 0.f, 0.f, 0.f};
#pragma unroll
        for (int ks = 0; ks < 4; ++ks) { const bf16x8 kf = *(const LAS bf16x8*)(lds + A_KOFF + (((16 * (ts + tt)) ^ (128 * par)) + fr) * KST + (32 * ks + 8 * fq) * 2);
            s[tt] = __builtin_amdgcn_mfma_f32_16x16x32_bf16(kf, Q.qf[ks], s[tt], 0, 0, 0); } }
    float mx = -3.0e38f;
#pragma unroll
    for (int tt = 0; tt < NT; ++tt) { const f32x4 rk4 = *(const LAS f32x4*)(lds + A_RKOFF + (((16 * (ts + tt)) ^ (128 * par)) + 4 * fq) * 4);
#pragma unroll
        for (int j = 0; j < 4; ++j) { const int kj = 16 * (ts + tt) + 4 * fq + j; float v = s[tt][j] * rq * rk4[j];
            if (MASK) { const bool valid = (kj >= qi) && (kj <= qi + 128) && (!d.nb0 || kj >= 128); v = valid ? v : -1.0e30f; }
            s[tt][j] = v; mx = fmaxf(mx, v); } }
    mx = fmaxf(mx, __shfl_xor(mx, 16)); mx = fmaxf(mx, __shfl_xor(mx, 32));
    float l = 0.f;
#pragma unroll
    for (int tt = 0; tt < NT; ++tt)
#pragma unroll
        for (int j = 0; j < 4; ++j) { const float p = __expf(s[tt][j] - mx); s[tt][j] = p; l += p; }
    l = pg8::quad_sum(l);
    f32x4 o[8];
#pragma unroll
    for (int dt = 0; dt < 8; ++dt) o[dt] = (f32x4){0.f, 0.f, 0.f, 0.f};
    const int q4 = fr >> 2, p4 = fr & 3;
#pragma unroll
    for (int pr = 0; pr < NT / 2; ++pr) { const bf16x8 pf = __builtin_bit_cast(bf16x8, pg8::pack8(s[2 * pr], s[2 * pr + 1]));
        LAS unsigned char* v0p = lds + A_VOFF + (((16 * (ts + 2 * pr)) ^ (128 * par)) + 4 * fq + q4) * KST + 8 * p4;
        LAS unsigned char* v1p = lds + A_VOFF + (((16 * (ts + 2 * pr + 1)) ^ (128 * par)) + 4 * fq + q4) * KST + 8 * p4;
#pragma unroll
        for (int dt = 0; dt < 8; ++dt) { const s16x4 a0 = vtr(v0p + 32 * dt), a1 = vtr(v1p + 32 * dt);
            const bf16x8 vf = __builtin_shufflevector(a0, a1, 0, 1, 2, 3, 4, 5, 6, 7);
            o[dt] = __builtin_amdgcn_mfma_f32_16x16x32_bf16(vf, pf, o[dt], 0, 0, 0); } }
    const float inv = 1.0f / l;
#pragma unroll
    for (int dt = 0; dt < 8; ++dt) { u32x2 w; w.x = pg8::cvt_pk_bf16(o[dt][0] * inv, o[dt][1] * inv); w.y = pg8::cvt_pk_bf16(o[dt][2] * inv, o[dt][3] * inv);
        *(u32x2*)(d.ob + (long)qi * d.ostep + 16 * dt + 4 * fq) = w; }
    if (d.ml && fq == 0) { d.ml[(long)qi * d.mlstep] = mx; d.ml[(long)qi * d.mlstep + 1] = l; }
}
__device__ __forceinline__ int chain_len(int ch) { return ch < 256 ? 4 : 2; }
__device__ __forceinline__ AD dil_desc(int ch, int i, bf16_t* BIG, float* SSQ, bf16_t* OG, float* ML) {
    int g, b, h, r, nb;
    if (ch < 256) { g = ch >> 7; const int c = ch & 127;
        if (g == 0) { const int combo = c >> 4; b = combo >> 2; h = combo & 3; r = 0; nb = (c & 15) * 4 + i; }
        else { const int combo = c >> 2; b = combo >> 4; h = (combo >> 2) & 3; r = combo & 3; nb = (c & 3) * 4 + i; } }
    else { g = 2; const int c = ch - 256, seq = c >> 1; b = seq >> 6; h = (seq >> 4) & 3; r = seq & 15; nb = (c & 1) * 2 + i; }
    const int dil = 1 << (2 * g);
    const long row0 = (long)b * SEQ + r, qrow = row0 + (long)dil * 128 * nb;
    AD d; d.qb = BIG + qrow * INW + (g * 4 + h) * 128; d.qstep = (long)dil * INW; d.sq = SSQ + qrow * 64 + (g * 4 + h) * 4; d.sqstep = (long)dil * 64;
    d.kb = BIG + row0 * INW + 1536 + h * 128; d.vb = BIG + row0 * INW + 2048 + h * 128; d.kstep = (long)dil * INW; d.ks0 = 128 * (nb - 1); d.sk = SSQ + row0 * 64 + (12 + h) * 4; d.skstep = (long)dil * 64;
    d.ob = OG + (size_t)g * M * 512 + qrow * 512 + h * 128; d.ostep = (long)dil * 512; d.ml = ML + (((size_t)g * M + qrow) * 4 + h) * 2; d.mlstep = (long)dil * 8; d.nb0 = nb == 0; return d;
}
__device__ __forceinline__ AD cross_desc(int u, bf16_t* QC, float* SSQC, bf16_t* MEMKV, float* SSQM, bf16_t* OC) {
    const int h = u & 3, qb = u >> 2, b = qb >> 6; const long qrow = (long)qb * 128;
    AD d; d.qb = QC + qrow * 512 + h * 128; d.qstep = 512; d.sq = SSQC + qrow * 16 + h * 4; d.sqstep = 16;
    d.kb = MEMKV + (size_t)b * NMEM * 1024 + h * 128; d.vb = d.kb + 512; d.kstep = 1024; d.ks0 = 0; d.sk = SSQM + (size_t)b * NMEM * 16 + h * 4; d.skstep = 16;
    d.ob = OC + qrow * 512 + h * 128; d.ostep = 512; d.ml = nullptr; d.mlstep = 0; d.nb0 = false; return d;
}

#define XB_TMO      128
#define XB_XCNT(j)  (256  + 64 * (j))
#define XB_XSUB(j)  (1280 + 64 * (j))
#define XB_XGEN(j)  (2304 + 64 * (j))
#define XB_TOP      3328
#define XB_TOPGEN   3392
#define XCD_BAR_WORDS 3456
#define XB_SPIN_CAP (1u << 18)

__device__ __forceinline__ unsigned xb_ld(unsigned* p)              { return __hip_atomic_load(p, __ATOMIC_RELAXED, __HIP_MEMORY_SCOPE_AGENT); }
__device__ __forceinline__ unsigned xb_add(unsigned* p, unsigned v) { return __hip_atomic_fetch_add(p, v, __ATOMIC_RELAXED, __HIP_MEMORY_SCOPE_AGENT); }
__device__ __forceinline__ unsigned xb_xcc_id() { return (unsigned)__builtin_amdgcn_s_getreg((3 << 11) | 20) & 0xFu; }
#define XB_SPIN(cond, bar) do { unsigned _sp = 0; while (cond) { __builtin_amdgcn_s_sleep(1); \
    if ((++_sp & 255u) == 0u) { if (xb_ld(&(bar)[XB_TMO])) break; if (_sp > XB_SPIN_CAP) { atomicAdd(&(bar)[XB_TMO], 1u); break; } } } } while (0)

struct XcdBarrier {
    unsigned* bar; unsigned x;
    volatile LAS unsigned* st;
};

__device__ __forceinline__ XcdBarrier xcd_barrier_post(unsigned* bar, volatile LAS unsigned* st) {
    XcdBarrier b; b.bar = bar; b.x = xb_xcc_id(); b.st = st;
    if (threadIdx.x == 0) (void)xb_add(&bar[XB_XCNT(b.x)], 1u);
    return b;
}
__device__ __forceinline__ void xcd_barrier_complete(unsigned* bar, unsigned x, unsigned& nloc, unsigned& nx) {
    const unsigned G = gridDim.x * gridDim.y * gridDim.z;
    unsigned sum, cnt, mine, sp = 0u;
    for (;;) {
        sum = 0u; cnt = 0u; mine = 0u;
#pragma unroll
        for (unsigned j = 0; j < 16; ++j) { const unsigned c = xb_ld(&bar[XB_XCNT(j)]); sum += c; cnt += (c > 0u) ? 1u : 0u; mine = (j == x) ? c : mine; }
        if (sum == G) break;
        __builtin_amdgcn_s_sleep(1);
        if ((++sp & 255u) == 0u) { if (xb_ld(&bar[XB_TMO])) break; if (sp > XB_SPIN_CAP) { atomicAdd(&bar[XB_TMO], 1u); break; } }
    }
    nloc = mine > 0u ? mine : 1u; nx = cnt > 0u ? cnt : 1u;
}

__device__ __forceinline__ void xcd_barrier(const XcdBarrier& b) {
    asm volatile("s_waitcnt vmcnt(0)" ::: "memory");
    __syncthreads();
    if (threadIdx.x == 0) {
        unsigned* bar = b.bar;
        __builtin_amdgcn_s_waitcnt(0);
        unsigned nloc = b.st[0], nx = b.st[1];
        if (nloc == 0u) { xcd_barrier_complete(bar, b.x, nloc, nx); b.st[0] = nloc; b.st[1] = nx; }
        const unsigned old = xb_add(&bar[XB_XSUB(b.x)], 1u);
        const unsigned gen = old / nloc;
        if (old + 1u == (gen + 1u) * nloc) {
            __builtin_amdgcn_fence(__ATOMIC_RELEASE, "agent");
            asm volatile("s_waitcnt vmcnt(0)" ::: "memory");
            const unsigned og = xb_add(&bar[XB_TOP], 1u);
            const unsigned tg = og / nx;
            if (og + 1u == (tg + 1u) * nx) xb_add(&bar[XB_TOPGEN], 1u);
            else XB_SPIN(xb_ld(&bar[XB_TOPGEN]) == tg, bar);
            __builtin_amdgcn_fence(__ATOMIC_ACQUIRE, "agent");
            xb_add(&bar[XB_XGEN(b.x)], 1u);
            asm volatile("s_waitcnt vmcnt(0)" ::: "memory");
        } else {
            XB_SPIN(xb_ld(&bar[XB_XGEN(b.x)]) == gen, bar);
            __builtin_amdgcn_fence(__ATOMIC_ACQUIRE, "agent");
            asm volatile("s_waitcnt vmcnt(0)" ::: "memory");
        }
    }
    __syncthreads();
}

#define REP_P0 1
#define REP_P1 1
#define REP_P2 1
#define REP_P2B 1
#define REP_P3 1
#define REP_P4 1
#define REP_P5 1
#define REP_P6 1
#define REP_P7 1
#define REP_P8 1
#define REP_SYNC 1
__global__ void __launch_bounds__(512) fwd(Args a) {
    extern __shared__ __attribute__((aligned(16))) unsigned char lds_raw[];
    LAS unsigned char* lds = (LAS unsigned char*)lds_raw;
    cg::grid_group grid = cg::this_grid();
    const int wave = __builtin_amdgcn_readfirstlane(threadIdx.x >> 6);
    const int G = gridDim.x, bx = blockIdx.x;
    unsigned char* ws = a.ws;
    volatile LAS unsigned* xst = (volatile LAS unsigned*)(lds + XB_LDS_OFF);
    if (threadIdx.x < 2) xst[threadIdx.x] = 0u;
    __syncthreads();
    const XcdBarrier xbar = xcd_barrier_post((unsigned*)ws, xst);
    if (ws == nullptr) grid.sync();
    const float* x = a.in[0]; const float* mem = a.in[1]; const int* pos = (const int*)a.in[2];
    bf16_t* Win = (bf16_t*)(ws + WS_WIN); bf16_t* Wout = (bf16_t*)(ws + WS_WOUT); bf16_t* Wcq = (bf16_t*)(ws + WS_WCQ); bf16_t* Wckv = (bf16_t*)(ws + WS_WCKV);
    bf16_t* Wco = (bf16_t*)(ws + WS_WCO); bf16_t* Wgu = (bf16_t*)(ws + WS_WGU); bf16_t* Wdn = (bf16_t*)(ws + WS_WDN);
    float* SSQ = (float*)(ws + WS_SSQ); float* COS = (float*)(ws + WS_COS); float* SIN = (float*)(ws + WS_SIN); float* RS1 = (float*)(ws + WS_RS1); float* RS2 = (float*)(ws + WS_RS2);
    float* SSQC = (float*)(ws + WS_SSQC); bf16_t* MEMN = (bf16_t*)(ws + WS_MEMN); bf16_t* MEMKV = (bf16_t*)(ws + WS_MEMKV); float* SSQM = (float*)(ws + WS_SSQM); float* ML = (float*)(ws + WS_ML);
    bf16_t* BA = (bf16_t*)(ws + WS_A); bf16_t* BB = (bf16_t*)(ws + WS_B); bf16_t* OG = (bf16_t*)(ws + WS_OG); bf16_t* QC = (bf16_t*)(ws + WS_QC); bf16_t* OC = (bf16_t*)(ws + WS_OC);
    bf16_t* BIG = (bf16_t*)(ws + WS_BIG);

    for (int rep = 0; rep < REP_P0; ++rep)
    {
        const int lane = pg8::fresh_lane(), tid = wave * 64 + lane;
        LAS float* scr = (LAS float*)(lds + wave * 16384);
        const int gw = bx * 8 + wave, NGW = G * 8;
        constexpr int I_IN = 16 * 96, I_OUT = 8 * 32, I_CQ = 16 * 16, I_CKV = 16 * 32, I_CO = 8 * 32, I_GU = 16 * 176, I_DN = 44 * 32;
        constexpr int NITEMS = I_IN + I_OUT + I_CQ + I_CKV + I_CO + I_GU + I_DN;
        for (int it = gw; it < NITEMS; it += NGW) {
            int r = it;
            if (r < I_IN) { tr_item<0>(a.in[4], INW, INW, nullptr, Win, 1024, scr, r, lane); continue; } r -= I_IN;
            if (r < I_OUT) { tr_item<0>(a.in[9], 1024, 1024, nullptr, Wout, 1024, scr, r, lane); continue; } r -= I_OUT;
            if (r < I_CQ) { tr_item<0>(a.in[12], 512, 512, a.in[10], Wcq, 1024, scr, r, lane); continue; } r -= I_CQ;
            if (r < I_CKV) { tr_item<0>(a.in[13], 1024, 1024, nullptr, Wckv, 1024, scr, r, lane); continue; } r -= I_CKV;
            if (r < I_CO) { tr_item<0>(a.in[16], 1024, 1024, nullptr, Wco, 512, scr, r, lane); continue; } r -= I_CO;
            if (r < I_GU) { tr_item<1>(a.in[18], 2 * DFF, 2 * DFF, a.in[17], Wgu, 1024, scr, r, lane); continue; } r -= I_GU;
            tr_item<0>(a.in[19], 1024, 1024, nullptr, Wdn, DFF, scr, r, lane);
        }
        {
            const float* pw = a.in[7]; const float* psc = a.in[8]; const float* wo = a.in[9];
            for (int idx = bx * 512 + tid; idx < 512 * 256; idx += G * 512) { const int n4 = (idx & 255) * 4, kc = idx >> 8, g = kc >> 7;
                const float* pr = pw + (size_t)kc * 128; const float* sc = psc + g * 128; const float* wr_ = wo + (size_t)(512 + g * 128) * 1024 + n4; f32x4 acc = {0.f, 0.f, 0.f, 0.f};
#pragma unroll 16
                for (int e = 0; e < 128; ++e) acc += *(const f32x4*)(wr_ + (size_t)e * 1024) * (pr[e] * sc[e]);
#pragma unroll
                for (int j = 0; j < 4; ++j) Wout[(size_t)(n4 + j) * 1024 + 512 + kc] = (bf16_t)(pg8::cvt_pk_bf16(acc[j], 0.f) & 0xffffu); }
        }
        for (int m = gw; m < M + 512; m += 2 * NGW) { const int m1 = m + NGW; const bool has1 = m1 < M + 512; const int mb = has1 ? m1 : m;
            const float* xa = m < M ? x + (size_t)m * DM : mem + (size_t)(m - M) * DM; const float* ga = m < M ? a.in[3] : a.in[11]; bf16_t* oa = m < M ? BA + (size_t)m * DM : MEMN + (size_t)(m - M) * DM;
            const float* xb = mb < M ? x + (size_t)mb * DM : mem + (size_t)(mb - M) * DM; const float* gb = mb < M ? a.in[3] : a.in[11]; bf16_t* ob = mb < M ? BA + (size_t)mb * DM : MEMN + (size_t)(mb - M) * DM;
            rms_rows2(xa, ga, oa, xb, gb, ob, has1, lane);
        }
        for (int idx = bx * 512 + tid; idx < M * 16; idx += G * 512) { const int row = idx >> 4, i = idx & 15;
            const float ang = (float)pos[row] * a.invf[i]; float s, c; sincos_d(ang, s, c); COS[idx] = c; SIN[idx] = s; }
    }
    for (int rep = 0; rep < REP_SYNC; ++rep) xcd_barrier(xbar);

    for (int rep = 0; rep < REP_P1; ++rep)
    {
        pg8::Gemm g{BA, Win, M, INW, 1024}; pg8::StaticOrder S; S.init(M, INW, G, bx);
        pg8::EpiProj E{BIG, SSQ, COS, SIN, a.in[5], a.in[6]};
        pg8::gemm_phase<pg8::EpiProj, pg8::StaticOrder, true, true>(lds, g, S, E, wave);
    }
    for (int rep = 0; rep < REP_SYNC; ++rep) xcd_barrier(xbar);

    for (int rep = 0; rep < REP_P2; ++rep)
    { const int lane = pg8::fresh_lane(), tid = wave * 64 + lane;
      KVR R; int ch = bx, i = 0;
      if (ch < 512) { const AD d = dil_desc(ch, 0, BIG, SSQ, OG, ML); attn_load(d, R, tid, true); }
      while (ch < 512) {
        const AD d = dil_desc(ch, i, BIG, SSQ, OG, ML); const int par = i & 1;
        attn_store(lds, R, tid, i == 0, par); QR Q; attn_loadq(d, Q, lane, wave);
        __syncthreads();
        int ni = i + 1, nch = ch; if (ni == chain_len(ch)) { ni = 0; nch = ch + G; }
        if (nch < 512) { const AD dn = dil_desc(nch, ni, BIG, SSQ, OG, ML); attn_load(dn, R, tid, ni == 0); }
        attn_compute<10, true>(lds, d, Q, lane, wave, par);
        __syncthreads();
        ch = nch; i = ni;
      } }
    for (int rep = 0; rep < REP_SYNC; ++rep) xcd_barrier(xbar);

    for (int rep = 0; rep < REP_P2B; ++rep)
    { const int lane = pg8::fresh_lane(), tid = wave * 64 + lane; const long gt = (long)bx * 512 + tid, NTH = (long)G * 512;
      for (long i0 = gt; i0 < (long)M * 64; i0 += 2 * NTH) {
          const long i1 = i0 + NTH; const bool has1 = i1 < (long)M * 64; const long ii[2] = {i0, has1 ? i1 : i0};
          float mm[2][3], ll[2][3]; u32x4 og[2][3];
#pragma unroll
          for (int q = 0; q < 2; ++q) { const int row = (int)(ii[q] >> 6), c = (int)(ii[q] & 63), h = c >> 4;
#pragma unroll
              for (int g = 0; g < 3; ++g) { const float* p = ML + (((size_t)g * M + row) * 4 + h) * 2; mm[q][g] = p[0]; ll[q][g] = p[1]; og[q][g] = *(const u32x4*)(OG + (size_t)g * M * 512 + (size_t)row * 512 + c * 8); } }
#pragma unroll
          for (int q = 0; q < 2; ++q) { const int row = (int)(ii[q] >> 6), c = (int)(ii[q] & 63);
              const float mmax = fmaxf(mm[q][0], fmaxf(mm[q][1], mm[q][2])); float w[3], den = 0.f;
#pragma unroll
              for (int g = 0; g < 3; ++g) { w[g] = __expf(mm[q][g] - mmax) * ll[q][g]; den += w[g]; }
              const float inv = 1.0f / den; float o[8];
#pragma unroll
              for (int j = 0; j < 8; ++j) o[j] = 0.f;
#pragma unroll
              for (int g = 0; g < 3; ++g) { float f[8]; unpack8(og[q][g], f); const float wg = w[g] * inv;
#pragma unroll
                  for (int j = 0; j < 8; ++j) o[j] += wg * f[j]; }
              if (q == 0 || has1) *(u32x4*)(BA + (size_t)row * DM + c * 8) = pg8::pack8((f32x4){o[0], o[1], o[2], o[3]}, (f32x4){o[4], o[5], o[6], o[7]}); }
      }
#define POOL_GROUP(GP, W) \
      for (long i = gt; i < (long)M * 16; i += NTH) { const int row = (int)(i >> 4), ch = (int)(i & 15), t = row & (SEQ - 1); \
          const bf16_t* up = BIG + (size_t)row * INW + 2560 + (GP) * 128 + ch * 8; u32x4 ld[W]; \
          _Pragma("unroll") for (int k = 0; k < (W); ++k) ld[k] = *(const u32x4*)(up - (size_t)(k <= t ? k : 0) * INW); \
          float f0[8], sum[8]; unpack8(ld[0], f0); \
          _Pragma("unroll") for (int j = 0; j < 8; ++j) sum[j] = f0[j]; \
          _Pragma("unroll") for (int k = 1; k < (W); ++k) { float f[8]; unpack8(ld[k], f); const float v = k <= t ? 1.f : 0.f; \
              _Pragma("unroll") for (int j = 0; j < 8; ++j) sum[j] += v * f[j]; } \
          const int cnt = (t + 1) < (W) ? (t + 1) : (W); const float ic = 1.0f / (float)cnt; float d[8]; \
          _Pragma("unroll") for (int j = 0; j < 8; ++j) d[j] = sum[j] * ic - f0[j]; \
          *(u32x4*)(BA + (size_t)row * DM + 512 + (GP) * 128 + ch * 8) = pg8::pack8((f32x4){d[0], d[1], d[2], d[3]}, (f32x4){d[4], d[5], d[6], d[7]}); }
      POOL_GROUP(0, 2) POOL_GROUP(1, 4) POOL_GROUP(2, 8) POOL_GROUP(3, 16)
#undef POOL_GROUP
    }
    for (int rep = 0; rep < REP_SYNC; ++rep) xcd_barrier(xbar);

    for (int rep = 0; rep < REP_P3; ++rep)
    {
        pg8::Gemm g{BA, Wout, M, 1024, 1024}; pg8::StaticOrder S; S.init(M, 1024, G, bx);
        pg8::EpiRes E{x, nullptr, nullptr, BB, RS1};
        pg8::gemm_phase<pg8::EpiRes, pg8::StaticOrder, true, true>(lds, g, S, E, wave);
    }
    for (int rep = 0; rep < REP_SYNC; ++rep) xcd_barrier(xbar);

    for (int rep = 0; rep < REP_P4; ++rep)
    {
        const bool split = G >= 136;
        if (!split || bx < G - 8) {
            pg8::Gemm g{BB, Wcq, M, 512, 1024}; pg8::StaticOrder S; S.init(M, 512, split ? G - 8 : G, bx);
            pg8::EpiCq E{RS1, QC, SSQC, a.in[14]};
            pg8::gemm_phase<pg8::EpiCq, pg8::StaticOrder, true, true>(lds, g, S, E, wave);
        }
        if (!split || bx >= G - 8) {
            pg8::Gemm g{MEMN, Wckv, 512, 1024, 1024}; pg8::StaticOrder S; S.init(512, 1024, split ? 8 : G, split ? bx - (G - 8) : bx);
            pg8::EpiKv E{MEMKV, SSQM, a.in[15]};
            pg8::gemm_phase<pg8::EpiKv, pg8::StaticOrder, true, true>(lds, g, S, E, wave);
        }
    }
    for (int rep = 0; rep < REP_SYNC; ++rep) xcd_barrier(xbar);

    for (int rep = 0; rep < REP_P5; ++rep)
    { const int lane = pg8::fresh_lane(), tid = wave * 64 + lane;
      for (int u = bx; u < 512; u += G) {
        const AD d = cross_desc(u, QC, SSQC, MEMKV, SSQM, OC);
        { KVR R; attn_load(d, R, tid, true); attn_store(lds, R, tid, true, 0); }
        QR Q; attn_loadq(d, Q, lane, wave);
        __syncthreads();
        attn_compute<16, false>(lds, d, Q, lane, wave, 0);
        __syncthreads();
      } }
    for (int rep = 0; rep < REP_SYNC; ++rep) xcd_barrier(xbar);

    for (int rep = 0; rep < REP_P6; ++rep)
    {
        pg8::Gemm g{OC, Wco, M, 1024, 512}; pg8::StaticOrder S; S.init(M, 1024, G, bx);
        pg8::EpiRes E{nullptr, BB, nullptr, BA, RS2};
        pg8::gemm_phase<pg8::EpiRes, pg8::StaticOrder, true, true>(lds, g, S, E, wave);
    }
    for (int rep = 0; rep < REP_SYNC; ++rep) xcd_barrier(xbar);

    for (int rep = 0; rep < REP_P7; ++rep)
    {
        pg8::Gemm g{BA, Wgu, M, 2 * DFF, 1024}; pg8::StaticOrder S; S.init(M, 2 * DFF, G, bx);
        pg8::EpiSwiglu E{RS2, BIG};
        pg8::gemm_phase<pg8::EpiSwiglu, pg8::StaticOrder, true, true>(lds, g, S, E, wave);
    }
    for (int rep = 0; rep < REP_SYNC; ++rep) xcd_barrier(xbar);

    for (int rep = 0; rep < REP_P8; ++rep)
    {
        pg8::Gemm g{BIG, Wdn, M, 1024, DFF}; pg8::StaticOrder S; S.init(M, 1024, G, bx);
        pg8::EpiRes E{nullptr, BA, a.out, nullptr, nullptr};
        pg8::gemm_phase<pg8::EpiRes, pg8::StaticOrder, true, true>(lds, g, S, E, wave);
    }
}

extern "C" void kernel_launch(void* const* d_in, const int* in_sizes, int n_in, void* d_out, int out_size, void* d_ws, size_t ws_size, hipStream_t stream) {
    static int grid_blocks = 0;
    if (grid_blocks == 0) {
        if (n_in != 20 || ws_size < WS_END) { fprintf(stderr, "kernel_launch: unexpected inputs (n_in %d, ws %zu)\n", n_in, ws_size); grid_blocks = -1; return; }
        int dev = 0, cus = 0, per_cu = 0;
        hipGetDevice(&dev); hipDeviceGetAttribute(&cus, hipDeviceAttributeMultiprocessorCount, dev);
        if (hipFuncSetAttribute((const void*)fwd, hipFuncAttributeMaxDynamicSharedMemorySize, LDS_BYTES) != hipSuccess) { fprintf(stderr, "kernel_launch: hipFuncSetAttribute failed\n"); }
        if (hipOccupancyMaxActiveBlocksPerMultiprocessor(&per_cu, (const void*)fwd, 512, LDS_BYTES) != hipSuccess || per_cu < 1) { fprintf(stderr, "kernel_launch: occupancy query says %d\n", per_cu); per_cu = 1; }
        (void)hipGetLastError();
        grid_blocks = cus * 1;
        if (grid_blocks < 1) grid_blocks = 1;
    }
    if (grid_blocks < 0) return;
    if (hipMemsetAsync(d_ws, 0, 16384, stream) != hipSuccess) { fprintf(stderr, "kernel_launch: memset failed\n"); return; }
    Args a{};
    for (int i = 0; i < 20; ++i) a.in[i] = (const float*)d_in[i];
    a.out = (float*)d_out; a.ws = (unsigned char*)d_ws;
    for (int i = 0; i < 16; ++i) a.invf[i] = (float)std::pow(500000.0, -(double)i / 16.0);
    void* args[] = {&a};
    hipError_t e = hipLaunchCooperativeKernel((const void*)fwd, dim3(grid_blocks), dim3(512), args, LDS_BYTES, stream);
    if (e != hipSuccess) fprintf(stderr, "cooperative launch failed: %s (grid %d)\n", hipGetErrorString(e), grid_blocks);
}
```

```cpp
#include <hip/hip_runtime.h>
#include <hip/hip_cooperative_groups.h>
#include <cstdio>
#include <cstdint>
#include <cmath>
namespace cg = cooperative_groups;
namespace pg8 {
#define PG8_LAS __attribute__((address_space(3)))
typedef unsigned short bf16_t;
typedef short bf16x8 __attribute__((ext_vector_type(8)));
typedef float f32x4 __attribute__((ext_vector_type(4)));
typedef unsigned u32x4 __attribute__((ext_vector_type(4)));
constexpr int BM = 256, BK = 64, HALF = 128, HTB = HALF * BK * 2  , STAGE_BYTES = 8 * HTB, NXCD = 8, WGM = 8;

__host__ __device__ __forceinline__ int lds_byte(int r, int c) { const int st = (r >> 4) * 2 + (c >> 5), rr = r & 15, cc = c & 31, ob = rr * 64 + cc * 2; return st * 1024 + (ob ^ (((ob >> 9) & 1) << 5)); }
__host__ __device__ __forceinline__ void stage_rc(int b, int& R, int& C) { const int st = b / 1024, sb = b % 1024, swz = sb ^ (((sb >> 9) & 1) << 5); R = (st >> 1) * 16 + swz / 64; C = (st & 1) * 32 + (swz % 64) / 2; }
__host__ __device__ __forceinline__ int perm32(int rho) { const int n = rho >> 4, i = rho & 15; return 8 * (i >> 2) + 4 * n + (i & 3); }

struct Unit { int pm, pn; };
struct Gemm { const bf16_t* A; const bf16_t* Bt; int M, N, K; };

struct StaticOrder {
    int nM, nN, nwg, G, c;
    __host__ __device__ void init(int M, int N, int G_, int c_) { nM = M / BM; nN = N / BM; nwg = nM * nN; G = G_; c = c_; }
    __host__ __device__ bool next(int i, Unit& u) const {
        const long L = (long)i * G + c; if (L >= nwg) return false;
        int wgid = (int)L; { const int q = nwg / NXCD, r = nwg % NXCD, xcd = wgid % NXCD, off = wgid / NXCD; wgid = (xcd < r ? xcd * (q + 1) : r * (q + 1) + (xcd - r) * q) + off; }
        const int nig = WGM * nN, gid = wgid / nig, fm = gid * WGM, gsz = (nM - fm) < WGM ? (nM - fm) : WGM;
        u.pm = fm + ((wgid % nig) % gsz); u.pn = (wgid % nig) / gsz; return true;
    }
    __device__ __forceinline__ void a_ready(const Unit&) const {}
    __device__ __forceinline__ void done(const Unit&) const {}
};

__device__ __forceinline__ unsigned cvt_pk_bf16(float lo, float hi) { unsigned r; asm volatile("v_cvt_pk_bf16_f32 %0, %1, %2" : "=v"(r) : "v"(lo), "v"(hi)); return r; }
typedef float f32x2 __attribute__((ext_vector_type(2)));
__device__ __forceinline__ int fresh_lane() { int l; asm volatile("v_mbcnt_lo_u32_b32 %0, -1, 0\n\tv_mbcnt_hi_u32_b32 %0, -1, %0" : "=v"(l)); return l; }
template <class Epi, class Sched, bool ALIGN_EPI = false, bool SP2 = false>
__device__ __forceinline__ void gemm_phase(PG8_LAS unsigned char* lds, const Gemm g, const Sched& S, const Epi& E, const int wid) {
    const int lane = fresh_lane(), tid = wid * 64 + lane, wr = wid >> 2, wc = wid & 3, fr = lane & 15, fq = lane >> 4;
    const int K = g.K, nt = K / BK;
    unsigned voffA[2], voffB[2];
#pragma unroll
    for (int i = 0; i < 2; ++i) { int R, C; stage_rc(tid * 16 + i * 8192, R, C); const int Rb = Epi::PERM ? ((R & ~31) + perm32(R & 31)) : R;
        voffA[i] = (unsigned)(R * K + C) * 2u; voffB[i] = (unsigned)(Rb * K + C) * 2u; }
    const size_t kstep = (size_t)(BK * 2);
    const size_t hstep = (size_t)HALF * K * 2;
    const size_t tstep = 2 * hstep;
    const unsigned ldsw = (unsigned)wid * 1024u;
    const int aoff = lds_byte(wr * 64 + fr, fq * 8), boff = lds_byte(wc * 32 + fr, fq * 8);
#define PG8_SA(b, h) (((b) * 2 + (h)) * HTB)
#define PG8_SB(b, h) ((4 + (b) * 2 + (h)) * HTB)
#define PG8_STAGE(bufoff, gbase, voff) do { _Pragma("unroll") for (int _i = 0; _i < 2; ++_i) \
        __builtin_amdgcn_global_load_lds((const unsigned*)((const char*)(gbase) + (voff)[_i]), (PG8_LAS unsigned*)(lds + (bufoff) + ldsw + _i * 8192), 16, 0, 0); } while (0)
#define PG8_LDA(dst, b, h) do { _Pragma("unroll") for (int m = 0; m < 4; ++m) _Pragma("unroll") for (int k = 0; k < 2; ++k) dst[m][k] = *(const PG8_LAS bf16x8*)(lds + PG8_SA(b, h) + aoff + m * 2048 + k * 1024); } while (0)
#define PG8_LDB(dst, b, h) do { _Pragma("unroll") for (int n = 0; n < 2; ++n) _Pragma("unroll") for (int k = 0; k < 2; ++k) dst[n][k] = *(const PG8_LAS bf16x8*)(lds + PG8_SB(b, h) + boff + n * 2048 + k * 1024); } while (0)
#define PG8_MMA(ai, bj, At, Bt) do { __builtin_amdgcn_s_setprio(1); _Pragma("unroll") for (int m = 0; m < 4; ++m) _Pragma("unroll") for (int n = 0; n < 2; ++n) _Pragma("unroll") for (int k = 0; k < 2; ++k) \
        acc[ai][bj][m][n] = __builtin_amdgcn_mfma_f32_16x16x32_bf16(Bt[n][k], At[m][k], acc[ai][bj][m][n], 0, 0, 0); __builtin_amdgcn_s_setprio(0); } while (0)
#define PG8_WAIT_V(n) asm volatile("s_waitcnt vmcnt(" #n ")" ::: "memory")
#define PG8_WAIT_L(n) asm volatile("s_waitcnt lgkmcnt(" #n ")" ::: "memory")
#define PG8_BAR __builtin_amdgcn_s_barrier()
#define PG8_SCHED __builtin_amdgcn_sched_barrier(0)
    Unit cur, nxt; int ui = 0;
    if (!S.next(0, cur)) return;
    f32x4 acc[2][2][4][2];
#pragma unroll
    for (int a = 0; a < 2; ++a)
#pragma unroll
        for (int b = 0; b < 2; ++b)
#pragma unroll
            for (int m = 0; m < 4; ++m)
#pragma unroll
                for (int n = 0; n < 2; ++n) acc[a][b][m][n] = (f32x4){0.f, 0.f, 0.f, 0.f};
    bf16x8 At[4][2], B0[2][2], B1[2][2];
    const char* cA = (const char*)g.A + (size_t)cur.pm * tstep; const char* cB = (const char*)g.Bt + (size_t)cur.pn * tstep;
    S.a_ready(cur);
    if constexpr (SP2) {
        PG8_STAGE(PG8_SB(0, 0), cB, voffB); PG8_STAGE(PG8_SB(0, 1), cB + hstep, voffB); PG8_STAGE(PG8_SA(0, 0), cA, voffA); PG8_STAGE(PG8_SA(0, 1), cA + hstep, voffA);
        if (wr == 1) PG8_BAR;
        PG8_WAIT_V(2); PG8_BAR;
        PG8_STAGE(PG8_SB(1, 0), cB + kstep, voffB); PG8_STAGE(PG8_SA(1, 0), cA + kstep, voffA); PG8_STAGE(PG8_SB(1, 1), cB + hstep + kstep, voffB);
        PG8_WAIT_V(6); PG8_BAR;
    } else {
        PG8_STAGE(PG8_SB(0, 0), cB, voffB); PG8_STAGE(PG8_SA(0, 0), cA, voffA); PG8_STAGE(PG8_SB(0, 1), cB + hstep, voffB); PG8_STAGE(PG8_SA(0, 1), cA + hstep, voffA);
        if (wr == 1) PG8_BAR;
        PG8_WAIT_V(4); PG8_BAR;
        PG8_STAGE(PG8_SB(1, 0), cB + kstep, voffB); PG8_STAGE(PG8_SA(1, 0), cA + kstep, voffA); PG8_STAGE(PG8_SB(1, 1), cB + hstep + kstep, voffB);
        PG8_WAIT_V(6); PG8_BAR;
    }
    for (;;) {
        const bool has_next = S.next(ui + 1, nxt);
        const char* nA = has_next ? (const char*)g.A + (size_t)nxt.pm * tstep : cA; const char* nB = has_next ? (const char*)g.Bt + (size_t)nxt.pn * tstep : cB;
        for (int t = 0; t < nt; t += 2) {
            const bool last = (t == nt - 2);
            const char* a1 = cA + (size_t)(t + 1) * kstep;
            const char* a2 = last ? nA : cA + (size_t)(t + 2) * kstep; const char* b2 = last ? nB : cB + (size_t)(t + 2) * kstep;
            const char* a3 = a2 + kstep; const char* b3 = b2 + kstep;
            if (last && has_next) S.a_ready(nxt);
            if constexpr (SP2) {
            PG8_LDB(B0, 0, 0); PG8_LDB(B1, 0, 1); PG8_SCHED; PG8_LDA(At, 0, 0); PG8_STAGE(PG8_SA(1, 1), a1 + hstep, voffA);
            PG8_WAIT_V(8); PG8_WAIT_L(0); PG8_BAR; PG8_MMA(0, 0, At, B0); PG8_MMA(0, 1, At, B1); PG8_BAR; PG8_SCHED;
            PG8_LDA(At, 0, 1); PG8_STAGE(PG8_SB(0, 0), b2, voffB); PG8_STAGE(PG8_SB(0, 1), b2 + hstep, voffB); PG8_STAGE(PG8_SA(0, 0), a2, voffA);
            PG8_WAIT_V(8); PG8_WAIT_L(0); PG8_BAR; PG8_MMA(1, 0, At, B0); PG8_MMA(1, 1, At, B1); PG8_BAR; PG8_SCHED;
            PG8_LDB(B0, 1, 0); PG8_LDB(B1, 1, 1); PG8_SCHED; PG8_LDA(At, 1, 0); PG8_STAGE(PG8_SA(0, 1), a2 + hstep, voffA);
            PG8_WAIT_V(8); PG8_WAIT_L(0); PG8_BAR; PG8_MMA(0, 0, At, B0); PG8_MMA(0, 1, At, B1); PG8_BAR; PG8_SCHED;
            PG8_LDA(At, 1, 1); PG8_STAGE(PG8_SB(1, 0), b3, voffB); PG8_STAGE(PG8_SB(1, 1), b3 + hstep, voffB); PG8_STAGE(PG8_SA(1, 0), a3, voffA);
            PG8_WAIT_V(8); PG8_WAIT_L(0); PG8_BAR; PG8_MMA(1, 0, At, B0); PG8_MMA(1, 1, At, B1); PG8_BAR; PG8_SCHED;
            } else {
            PG8_LDB(B0, 0, 0); PG8_SCHED; PG8_LDA(At, 0, 0); PG8_STAGE(PG8_SA(1, 1), a1 + hstep, voffA);
            PG8_WAIT_L(8); PG8_BAR; PG8_WAIT_L(0); PG8_MMA(0, 0, At, B0); PG8_BAR; PG8_SCHED;
            PG8_LDB(B1, 0, 1); PG8_STAGE(PG8_SB(0, 0), b2, voffB);
            PG8_BAR; PG8_WAIT_L(0); PG8_MMA(0, 1, At, B1); PG8_BAR;
            PG8_LDA(At, 0, 1); PG8_STAGE(PG8_SA(0, 0), a2, voffA);
            PG8_BAR; PG8_WAIT_L(0); PG8_MMA(1, 0, At, B0); PG8_BAR; PG8_SCHED;
            PG8_STAGE(PG8_SB(0, 1), b2 + hstep, voffB);
            PG8_WAIT_V(6); PG8_BAR; PG8_MMA(1, 1, At, B1); PG8_BAR;
            PG8_LDB(B0, 1, 0); PG8_SCHED; PG8_LDA(At, 1, 0); PG8_STAGE(PG8_SA(0, 1), a2 + hstep, voffA);
            PG8_WAIT_L(8); PG8_BAR; PG8_WAIT_L(0); PG8_MMA(0, 0, At, B0); PG8_BAR; PG8_SCHED;
            PG8_LDB(B1, 1, 1); PG8_STAGE(PG8_SB(1, 0), b3, voffB);
            PG8_BAR; PG8_WAIT_L(0); PG8_MMA(0, 1, At, B1); PG8_BAR;
            PG8_LDA(At, 1, 1); PG8_STAGE(PG8_SA(1, 0), a3, voffA);
            PG8_BAR; PG8_WAIT_L(0); PG8_MMA(1, 0, At, B0); PG8_BAR; PG8_SCHED;
            PG8_STAGE(PG8_SB(1, 1), b3 + hstep, voffB);
            PG8_WAIT_V(6); PG8_BAR; PG8_MMA(1, 1, At, B1); PG8_BAR;
            }
        }
        if constexpr (ALIGN_EPI) { if (wr == 0) PG8_BAR; }
        if constexpr (!Epi::AFTER_DRAIN) { E(acc, cur, wr, wc, fr, fq); S.done(cur); }
        if (!has_next) break;
#pragma unroll
        for (int a = 0; a < 2; ++a)
#pragma unroll
            for (int b = 0; b < 2; ++b)
#pragma unroll
                for (int m = 0; m < 4; ++m)
#pragma unroll
                    for (int n = 0; n < 2; ++n) acc[a][b][m][n] = (f32x4){0.f, 0.f, 0.f, 0.f};
        cur = nxt; cA = nA; cB = nB; ++ui;
        if constexpr (ALIGN_EPI) { if (wr == 1) PG8_BAR; }
    }
    PG8_WAIT_V(0);
    if constexpr (!ALIGN_EPI) { if (wr == 0) PG8_BAR; }
    PG8_BAR;
    if constexpr (Epi::AFTER_DRAIN) { E.fused(acc, cur, wr, wc, fr, fq, lds, wid, lane); S.done(cur); }
#undef PG8_SA
#undef PG8_SB
#undef PG8_STAGE
#undef PG8_LDA
#undef PG8_LDB
#undef PG8_MMA
#undef PG8_WAIT_V
#undef PG8_WAIT_L
#undef PG8_BAR
#undef PG8_SCHED
}
}

namespace pg8 {
__device__ __forceinline__ u32x4 pack8(const f32x4 v0, const f32x4 v1) {
    u32x4 w; w.x = cvt_pk_bf16(v0[0], v0[1]); w.y = cvt_pk_bf16(v0[2], v0[3]); w.z = cvt_pk_bf16(v1[0], v1[1]); w.w = cvt_pk_bf16(v1[2], v1[3]); return w; }
__device__ __forceinline__ float quad_sum(float s) { s += __shfl_xor(s, 16); s += __shfl_xor(s, 32); return s; }
__device__ __forceinline__ float sq8(const f32x4 a, const f32x4 b) { return (a[0] * a[0] + a[1] * a[1]) + (a[2] * a[2] + a[3] * a[3]) + (b[0] * b[0] + b[1] * b[1]) + (b[2] * b[2] + b[3] * b[3]); }
__device__ __forceinline__ f32x4 rs_quarter(const float* rs, int row, int fq) { return *(const f32x4*)(rs + (size_t)row * 16 + 4 * fq); }
__device__ __forceinline__ float rstd_from_quarter(const f32x4 a) { return rsqrtf(quad_sum((a[0] + a[1]) + (a[2] + a[3])) * (1.0f / 1024.0f) + 1e-6f); }

struct EpiProj {
    static constexpr bool PERM = true, AFTER_DRAIN = false;
    bf16_t* O; float* ssq; const float* cosT; const float* sinT; const float* gq; const float* gk;
    __device__ __forceinline__ void operator()(const f32x4 (&acc)[2][2][4][2], const Unit& u, int wr, int wc, int fr, int fq) const {
        const int pn = u.pn, row0 = u.pm * BM + wr * 64 + fr, cw = wc * 32 + 8 * fq;
        if (pn >= 8) {
#pragma unroll
            for (int ai = 0; ai < 2; ++ai)
#pragma unroll
                for (int m = 0; m < 4; ++m) { bf16_t* rowp = O + (size_t)(row0 + ai * HALF + m * 16) * 3072 + pn * BM + cw;
#pragma unroll
                    for (int bj = 0; bj < 2; ++bj) *(u32x4*)(rowp + bj * HALF) = pack8(acc[ai][bj][m][0], acc[ai][bj][m][1]); }
        } else {
            const bool isq = pn < 6; const float* g = isq ? gq : gk;
            const f32x4 g0 = *(const f32x4*)(g + cw), g1 = *(const f32x4*)(g + cw + 4);
            const float sc = isq ? 0.08838834764831845f : 1.0f;
            const float sg = (fq < 2) ? -1.0f : 1.0f;
#pragma unroll
            for (int ai = 0; ai < 2; ++ai)
#pragma unroll
                for (int m = 0; m < 4; ++m) { const int row = row0 + ai * HALF + m * 16;
                    f32x4 c0 = {0.f, 0.f, 0.f, 0.f}, c1 = c0, s0 = c0, s1 = c0;
                    if (wc == 0) { const float* cp = cosT + (size_t)row * 16 + 8 * (fq & 1); const float* sp = sinT + (size_t)row * 16 + 8 * (fq & 1);
                        c0 = *(const f32x4*)cp; c1 = *(const f32x4*)(cp + 4); s0 = *(const f32x4*)sp; s1 = *(const f32x4*)(sp + 4); }
                    bf16_t* rowp = O + (size_t)row * 3072 + pn * BM + cw;
#pragma unroll
                    for (int bj = 0; bj < 2; ++bj) { f32x4 v0 = acc[ai][bj][m][0], v1 = acc[ai][bj][m][1];
                        const float ss = quad_sum(sq8(v0, v1));
                        if (fq == 0) ssq[(size_t)row * 64 + (pn * 2 + bj) * 4 + wc] = ss;
                        v0 = v0 * g0; v1 = v1 * g1;
                        if (wc == 0) { f32x4 p0, p1;
#pragma unroll
                            for (int j = 0; j < 4; ++j) { p0[j] = __shfl_xor(v0[j], 32); p1[j] = __shfl_xor(v1[j], 32); }
                            v0 = v0 * c0 + (p0 * s0) * sg; v1 = v1 * c1 + (p1 * s1) * sg; }
                        v0 = v0 * sc; v1 = v1 * sc;
                        *(u32x4*)(rowp + bj * HALF) = pack8(v0, v1); } }
        }
    }
};
__device__ __forceinline__ void bf8_to_f32(const u32x4 w, f32x4& b0, f32x4& b1) {
    b0 = (f32x4){__uint_as_float(w.x << 16), __uint_as_float(w.x & 0xffff0000u), __uint_as_float(w.y << 16), __uint_as_float(w.y & 0xffff0000u)};
    b1 = (f32x4){__uint_as_float(w.z << 16), __uint_as_float(w.z & 0xffff0000u), __uint_as_float(w.w << 16), __uint_as_float(w.w & 0xffff0000u)}; }
struct EpiRes {
    static constexpr bool PERM = true, AFTER_DRAIN = false;
    const float* baseF; const bf16_t* baseB; float* outF; bf16_t* outB; float* rs;
    __device__ __forceinline__ void operator()(const f32x4 (&acc)[2][2][4][2], const Unit& u, int wr, int wc, int fr, int fq) const {
        const int row0 = u.pm * BM + wr * 64 + fr, col0 = u.pn * BM + wc * 32 + 8 * fq;
#pragma unroll
        for (int ai = 0; ai < 2; ++ai) {
            f32x4 b[4][2][2];
            if (baseF) {
#pragma unroll
                for (int m = 0; m < 4; ++m)
#pragma unroll
                    for (int bj = 0; bj < 2; ++bj) { const float* bp = baseF + (size_t)(row0 + ai * HALF + m * 16) * 1024 + col0 + bj * HALF; b[m][bj][0] = *(const f32x4*)bp; b[m][bj][1] = *(const f32x4*)(bp + 4); }
            } else { u32x4 w[4][2];
#pragma unroll
                for (int m = 0; m < 4; ++m)
#pragma unroll
                    for (int bj = 0; bj < 2; ++bj) w[m][bj] = *(const u32x4*)(baseB + (size_t)(row0 + ai * HALF + m * 16) * 1024 + col0 + bj * HALF);
#pragma unroll
                for (int m = 0; m < 4; ++m)
#pragma unroll
                    for (int bj = 0; bj < 2; ++bj) bf8_to_f32(w[m][bj], b[m][bj][0], b[m][bj][1]); }
#pragma unroll
            for (int m = 0; m < 4; ++m) { const int row = row0 + ai * HALF + m * 16; const size_t off = (size_t)row * 1024 + col0; float ss = 0.f;
#pragma unroll
                for (int bj = 0; bj < 2; ++bj) { const f32x4 v0 = acc[ai][bj][m][0] + b[m][bj][0], v1 = acc[ai][bj][m][1] + b[m][bj][1];
                    if (outF) { *(f32x4*)(outF + off + bj * HALF) = v0; *(f32x4*)(outF + off + bj * HALF + 4) = v1; }
                    if (outB) *(u32x4*)(outB + off + bj * HALF) = pack8(v0, v1);
                    ss += sq8(v0, v1); }
                if (rs) { ss = quad_sum(ss); if (fq == 0) rs[(size_t)row * 16 + u.pn * 4 + wc] = ss; } }
        }
    }
};
struct EpiCq {
    static constexpr bool PERM = true, AFTER_DRAIN = false;
    const float* rs1; bf16_t* O; float* ssqc; const float* g;
    __device__ __forceinline__ void operator()(const f32x4 (&acc)[2][2][4][2], const Unit& u, int wr, int wc, int fr, int fq) const {
        const int row0 = u.pm * BM + wr * 64 + fr, cw = wc * 32 + 8 * fq;
        const f32x4 g0 = *(const f32x4*)(g + cw) * 0.08838834764831845f, g1 = *(const f32x4*)(g + cw + 4) * 0.08838834764831845f;
        f32x4 rq[2][4];
#pragma unroll
        for (int ai = 0; ai < 2; ++ai)
#pragma unroll
            for (int m = 0; m < 4; ++m) rq[ai][m] = rs_quarter(rs1, row0 + ai * HALF + m * 16, fq);
#pragma unroll
        for (int ai = 0; ai < 2; ++ai)
#pragma unroll
            for (int m = 0; m < 4; ++m) { const int row = row0 + ai * HALF + m * 16; const float rstd = rstd_from_quarter(rq[ai][m]);
                bf16_t* rowp = O + (size_t)row * 512 + u.pn * BM + cw;
#pragma unroll
                for (int bj = 0; bj < 2; ++bj) { f32x4 v0 = acc[ai][bj][m][0] * rstd, v1 = acc[ai][bj][m][1] * rstd;
                    const float ss = quad_sum(sq8(v0, v1));
                    if (fq == 0) ssqc[(size_t)row * 16 + (u.pn * 2 + bj) * 4 + wc] = ss;
                    *(u32x4*)(rowp + bj * HALF) = pack8(v0 * g0, v1 * g1); } }
    }
};
struct EpiKv {
    static constexpr bool PERM = true, AFTER_DRAIN = false;
    bf16_t* O; float* ssqm; const float* g;
    __device__ __forceinline__ void operator()(const f32x4 (&acc)[2][2][4][2], const Unit& u, int wr, int wc, int fr, int fq) const {
        const int row0 = u.pm * BM + wr * 64 + fr, cw = wc * 32 + 8 * fq; const bool isk = u.pn < 2;
        f32x4 g0 = {1.f, 1.f, 1.f, 1.f}, g1 = g0;
        if (isk) { g0 = *(const f32x4*)(g + cw); g1 = *(const f32x4*)(g + cw + 4); }
#pragma unroll
        for (int ai = 0; ai < 2; ++ai)
#pragma unroll
            for (int m = 0; m < 4; ++m) { const int row = row0 + ai * HALF + m * 16; bf16_t* rowp = O + (size_t)row * 1024 + u.pn * BM + cw;
#pragma unroll
                for (int bj = 0; bj < 2; ++bj) { const f32x4 v0 = acc[ai][bj][m][0], v1 = acc[ai][bj][m][1];
                    if (isk) { const float ss = quad_sum(sq8(v0, v1)); if (fq == 0) ssqm[(size_t)row * 16 + (u.pn * 2 + bj) * 4 + wc] = ss; }
                    *(u32x4*)(rowp + bj * HALF) = pack8(v0 * g0, v1 * g1); } }
    }
};
struct EpiSwiglu {
    static constexpr bool PERM = true, AFTER_DRAIN = false;
    const float* rs2; bf16_t* act;
    __device__ __forceinline__ void operator()(const f32x4 (&acc)[2][2][4][2], const Unit& u, int wr, int wc, int fr, int fq) const {
        const int row0 = u.pm * BM + wr * 64 + fr, cw = wc * 32 + 8 * fq;
        f32x4 rq[2][4];
#pragma unroll
        for (int ai = 0; ai < 2; ++ai)
#pragma unroll
            for (int m = 0; m < 4; ++m) rq[ai][m] = rs_quarter(rs2, row0 + ai * HALF + m * 16, fq);
#pragma unroll
        for (int ai = 0; ai < 2; ++ai)
#pragma unroll
            for (int m = 0; m < 4; ++m) { const int row = row0 + ai * HALF + m * 16; const float rstd = rstd_from_quarter(rq[ai][m]);
                f32x4 a[2];
#pragma unroll
                for (int n = 0; n < 2; ++n) { const f32x4 gg = acc[ai][0][m][n] * rstd, uu = acc[ai][1][m][n] * rstd;
#pragma unroll
                    for (int j = 0; j < 4; ++j) a[n][j] = gg[j] * __builtin_amdgcn_rcpf(1.0f + __expf(-gg[j])) * uu[j]; }
                *(u32x4*)(act + (size_t)row * 2816 + u.pn * HALF + cw) = pack8(a[0], a[1]); }
    }
};
}

#define LAS __attribute__((address_space(3)))
typedef unsigned short bf16_t;
typedef short bf16x8 __attribute__((ext_vector_type(8)));
typedef short s16x4 __attribute__((ext_vector_type(4)));
typedef float f32x4 __attribute__((ext_vector_type(4)));
typedef unsigned u32x4 __attribute__((ext_vector_type(4)));
typedef unsigned u32x2 __attribute__((ext_vector_type(2)));
constexpr int M = 16384, SEQ = 8192, DM = 1024, INW = 3072, DFF = 2816, NMEM = 256;
constexpr size_t MiB = 1u << 20;
constexpr size_t WS_WIN = 1 * MiB, WS_WOUT = 7 * MiB, WS_WCQ = 9 * MiB, WS_WCKV = 10 * MiB, WS_WCO = 12 * MiB, WS_WGU = 13 * MiB, WS_WDN = 24 * MiB;
constexpr size_t WS_SSQ = 30 * MiB, WS_COS = 34 * MiB, WS_SIN = 35 * MiB, WS_RS1 = 36 * MiB, WS_RS2 = 37 * MiB, WS_SSQC = 38 * MiB, WS_MEMN = 39 * MiB, WS_MEMKV = 40 * MiB, WS_SSQM = 41 * MiB, WS_ML = 42 * MiB;
constexpr size_t WS_A = 48 * MiB;
constexpr size_t WS_B = 80 * MiB;
constexpr size_t WS_OG = 80 * MiB;
constexpr size_t WS_QC = 112 * MiB, WS_OC = 128 * MiB;
constexpr size_t WS_BIG = 144 * MiB;
constexpr size_t WS_END = 240 * MiB;
constexpr int LDS_BYTES = 149504, XB_LDS_OFF = 149000;
constexpr int KST = 288, A_KOFF = 0, A_VOFF = 256 * KST, A_RKOFF = 2 * 256 * KST;
static_assert(A_RKOFF + 1024 <= LDS_BYTES && pg8::STAGE_BYTES <= LDS_BYTES, "LDS map");

struct Args { const float* in[20]; float* out; unsigned char* ws; float invf[16]; };

__device__ __forceinline__ float wave_sum(float v) {
#pragma unroll
    for (int o = 1; o < 64; o <<= 1) v += __shfl_xor(v, o);
    return v;
}
__device__ __forceinline__ float bf_lo(unsigned w) { return __uint_as_float(w << 16); }
__device__ __forceinline__ float bf_hi(unsigned w) { return __uint_as_float(w & 0xffff0000u); }
__device__ __forceinline__ void unpack8(const u32x4 w, float (&f)[8]) { f[0] = bf_lo(w.x); f[1] = bf_hi(w.x); f[2] = bf_lo(w.y); f[3] = bf_hi(w.y); f[4] = bf_lo(w.z); f[5] = bf_hi(w.z); f[6] = bf_lo(w.w); f[7] = bf_hi(w.w); }

template <int MODE>
__device__ __forceinline__ void tr_item(const float* W, int Nsrc, int Ndst, const float* gain, bf16_t* WT, int ldt, LAS float* scr, int item, int lane) {
    const int nblk = Ndst / 32, kb = item / nblk, nb = item % nblk, k0 = 64 * kb, n0 = 32 * nb;
    const int s0 = MODE == 1 ? (((n0 >> 7) & 1) * DFF + (n0 >> 8) * 128 + (n0 & 127)) : n0;
    const int kr = lane >> 3, ch = lane & 7; f32x4 w[8];
#pragma unroll
    for (int i = 0; i < 8; ++i) w[i] = *(const f32x4*)(W + (size_t)(k0 + kr + 8 * i) * Nsrc + s0 + 4 * ch);
#pragma unroll
    for (int i = 0; i < 8; ++i) { const int kk = kr + 8 * i; const float gm = gain ? gain[k0 + kk] : 1.0f;
#pragma unroll
        for (int j = 0; j < 4; ++j) scr[kk * 33 + 4 * ch + j] = w[i][j] * gm; }
    asm volatile("s_waitcnt lgkmcnt(0)" ::: "memory");
    const int c = lane & 7;
#pragma unroll
    for (int j = 0; j < 4; ++j) { const int n = (lane >> 3) + 8 * j; const LAS float* s = scr + (8 * c) * 33 + n;
        u32x4 o; o.x = pg8::cvt_pk_bf16(s[0 * 33], s[1 * 33]); o.y = pg8::cvt_pk_bf16(s[2 * 33], s[3 * 33]); o.z = pg8::cvt_pk_bf16(s[4 * 33], s[5 * 33]); o.w = pg8::cvt_pk_bf16(s[6 * 33], s[7 * 33]);
        *(u32x4*)(WT + (size_t)(n0 + n) * ldt + k0 + 8 * c) = o; }
    asm volatile("s_waitcnt lgkmcnt(0)" ::: "memory");
}
__device__ __forceinline__ void rms_rows2(const float* x0, const float* g0, bf16_t* o0, const float* x1, const float* g1, bf16_t* o1, bool has1, int lane) {
    const f32x4* xr0 = (const f32x4*)x0 + lane; const f32x4* xr1 = (const f32x4*)x1 + lane;
    f32x4 v0[4], v1[4]; float s0 = 0.f, s1 = 0.f;
#pragma unroll
    for (int j = 0; j < 4; ++j) { v0[j] = xr0[64 * j]; v1[j] = xr1[64 * j]; }
#pragma unroll
    for (int j = 0; j < 4; ++j) { s0 += (v0[j][0] * v0[j][0] + v0[j][1] * v0[j][1]) + (v0[j][2] * v0[j][2] + v0[j][3] * v0[j][3]); s1 += (v1[j][0] * v1[j][0] + v1[j][1] * v1[j][1]) + (v1[j][2] * v1[j][2] + v1[j][3] * v1[j][3]); }
    const float r0 = rsqrtf(wave_sum(s0) * (1.0f / 1024.0f) + 1e-6f), r1 = rsqrtf(wave_sum(s1) * (1.0f / 1024.0f) + 1e-6f);
    const f32x4* gr0 = (const f32x4*)g0 + lane; const f32x4* gr1 = (const f32x4*)g1 + lane;
    u32x2* p0 = (u32x2*)o0 + lane; u32x2* p1 = (u32x2*)o1 + lane;
#pragma unroll
    for (int j = 0; j < 4; ++j) { const f32x4 y = v0[j] * r0 * gr0[64 * j]; u32x2 w; w.x = pg8::cvt_pk_bf16(y[0], y[1]); w.y = pg8::cvt_pk_bf16(y[2], y[3]); p0[64 * j] = w; }
    if (has1) {
#pragma unroll
        for (int j = 0; j < 4; ++j) { const f32x4 y = v1[j] * r1 * gr1[64 * j]; u32x2 w; w.x = pg8::cvt_pk_bf16(y[0], y[1]); w.y = pg8::cvt_pk_bf16(y[2], y[3]); p1[64 * j] = w; } }
}
__device__ __forceinline__ void sincos_d(float ang, float& s, float& c) {
    const double x = (double)ang; const double kq = rint(x * 0.63661977236758134308);
    const double r = (x - kq * 1.5707963267948966192) - kq * 6.123233995736766036e-17; const double r2 = r * r;
    double sp = -7.6471637318198164759e-13; sp = sp * r2 + 1.6059043836821614599e-10; sp = sp * r2 - 2.5052108385441718775e-08; sp = sp * r2 + 2.7557319223985890653e-06;
    sp = sp * r2 - 1.9841269841269841270e-04; sp = sp * r2 + 8.3333333333333333333e-03; sp = sp * r2 - 1.6666666666666666667e-01; sp = r + r * r2 * sp;
    double cp = 4.7794773323873852974e-14; cp = cp * r2 - 1.1470745597729724714e-11; cp = cp * r2 + 2.0876756987868098979e-09; cp = cp * r2 - 2.7557319223985890653e-07;
    cp = cp * r2 + 2.4801587301587301587e-05; cp = cp * r2 - 1.3888888888888888889e-03; cp = cp * r2 + 4.1666666666666666667e-02; cp = cp * r2 - 0.5; cp = 1.0 + r2 * cp;
    const int q = (int)((long long)kq & 3);
    const double sv = (q & 1) ? cp : sp, cv = (q & 1) ? sp : cp;
    s = (float)((q & 2) ? -sv : sv); c = (float)(((q + 1) & 2) ? -cv : cv);
}

__device__ __forceinline__ s16x4 vtr(LAS unsigned char* p) { return __builtin_bit_cast(s16x4, __builtin_amdgcn_ds_read_tr16_b64_v4i16((LAS s16x4*)p)); }
struct AD {
    const bf16_t* qb; long qstep; const float* sq; long sqstep; const bf16_t* kb; const bf16_t* vb; long kstep; int ks0; const float* sk; long skstep;
    bf16_t* ob; long ostep; float* ml; long mlstep; bool nb0; };
struct KVR { u32x4 kr[8], vr[8]; f32x4 sp; };
__device__ __forceinline__ void attn_load(const AD& d, KVR& R, int tid, bool first) {
    const int c = tid & 15, rr = tid >> 4;
#pragma unroll
    for (int it = 0; it < 4; ++it) { const int sidx = d.ks0 + 128 + rr + 32 * it; const long off = (long)sidx * d.kstep + 8 * c;
        R.kr[it] = *(const u32x4*)(d.kb + off); R.vr[it] = *(const u32x4*)(d.vb + off); }
    if (first) {
#pragma unroll
        for (int it = 4; it < 8; ++it) { int sidx = d.ks0 + rr + 32 * (it - 4); sidx = sidx < 0 ? 0 : sidx; const long off = (long)sidx * d.kstep + 8 * c;
            R.kr[it] = *(const u32x4*)(d.kb + off); R.vr[it] = *(const u32x4*)(d.vb + off); } }
    { int sidx = d.ks0 + ((tid + 128) & 255); sidx = sidx < 0 ? 0 : sidx; R.sp = *(const f32x4*)(d.sk + (long)sidx * d.skstep); }
}
__device__ __forceinline__ void attn_store(LAS unsigned char* lds, const KVR& R, int tid, bool first, int par) {
    const int c = tid & 15, rr = tid >> 4;
#pragma unroll
    for (int it = 0; it < 4; ++it) { const int row = (128 + rr + 32 * it) ^ (128 * par);
        *(LAS u32x4*)(lds + A_KOFF + row * KST + c * 16) = R.kr[it]; *(LAS u32x4*)(lds + A_VOFF + row * KST + c * 16) = R.vr[it]; }
    if (first) {
#pragma unroll
        for (int it = 4; it < 8; ++it) { const int row = (rr + 32 * (it - 4)) ^ (128 * par);
            *(LAS u32x4*)(lds + A_KOFF + row * KST + c * 16) = R.kr[it]; *(LAS u32x4*)(lds + A_VOFF + row * KST + c * 16) = R.vr[it]; } }
    if (tid < 128 || (first && tid < 256)) ((LAS float*)(lds + A_RKOFF))[((tid + 128) & 255) ^ (128 * par)] = rsqrtf(((R.sp[0] + R.sp[1]) + (R.sp[2] + R.sp[3])) * (1.0f / 128.0f) + 1e-6f);
}
struct QR { bf16x8 qf[4]; f32x4 sp; };
__device__ __forceinline__ void attn_loadq(const AD& d, QR& Q, int lane, int wave) {
    const int fr = lane & 15, fq = lane >> 4, qi = wave * 16 + fr;
#pragma unroll
    for (int ks = 0; ks < 4; ++ks) Q.qf[ks] = *(const bf16x8*)(d.qb + (long)qi * d.qstep + 32 * ks + 8 * fq);
    Q.sp = *(const f32x4*)(d.sq + (long)qi * d.sqstep);
}
template <int NT, bool MASK>
__device__ __forceinline__ void attn_compute(LAS unsigned char* lds, const AD& d, const QR& Q, int lane, int wave, int par) {
    const int fr = lane & 15, fq = lane >> 4, qi = wave * 16 + fr;
    const float rq = rsqrtf(((Q.sp[0] + Q.sp[1]) + (Q.sp[2] + Q.sp[3])) * (1.0f / 128.0f) + 1e-6f);
    const int ts = MASK ? (wave < 6 ? wave : 6) : 0;
    f32x4 s[NT];
#pragma unroll
    for (int tt = 0; tt < NT; ++tt) { s[tt] = (f32x4){0.f, 0.f, 0.f, 0.f};
#pragma unroll
        for (int ks = 0; ks < 4; ++ks) { const bf16x8 kf = *(const LAS bf16x8*)(lds + A_KOFF + (((16 * (ts + tt)) ^ (128 * par)) + fr) * KST + (32 * ks + 8 * fq) * 2);
            s[tt] = __builtin_amdgcn_mfma_f32_16x16x32_bf16(kf, Q.qf[ks], s[tt], 0, 0, 0); } }
    float mx = -3.0e38f;
#pragma unroll
    for (int tt = 0; tt < NT; ++tt) { const f32x4 rk4 = *(const LAS f32x4*)(lds + A_RKOFF + (((16 * (ts + tt)) ^ (128 * par)) + 4 * fq) * 4);
#pragma unroll
        for (int j = 0; j < 4; ++j) { const int kj = 16 * (ts + tt) + 4 * fq + j; float v = s[tt][j] * rq * rk4[j];
            if (MASK) { const bool valid = (kj >= qi) && (kj <= qi + 128) && (!d.nb0 || kj >= 128); v = valid ? v : -1.0e30f; }
            s[tt][j] = v; mx = fmaxf(mx, v); } }
    mx = fmaxf(mx, __shfl_xor(mx, 16)); mx = fmaxf(mx, __shfl_xor(mx, 32));
    float l = 0.f;
#pragma unroll
    for (int tt = 0; tt < NT; ++tt)
#pragma unroll
        for (int j = 0; j < 4; ++j) { const float p = __expf(s[tt][j] - mx); s[tt][j] = p; l += p; }
    l = pg8::quad_sum(l);
    f32x4 o[8];
#pragma unroll
    for (int dt = 0; dt < 8; ++dt) o[dt] = (f32x4){0.f, 0.f, 0.f, 0.f};
    const int q4 = fr >> 2, p4 = fr & 3;
#pragma unroll
    for (int pr = 0; pr < NT / 2; ++pr) { const bf16x8 pf = __builtin_bit_cast(bf16x8, pg8::pack8(s[2 * pr], s[2 * pr + 1]));
        LAS unsigned char* v0p = lds + A_VOFF + (((16 * (ts + 2 * pr)) ^ (128 * par)) + 4 * fq + q4) * KST + 8 * p4;
        LAS unsigned char* v1p = lds + A_VOFF + (((16 * (ts + 2 * pr + 1)) ^ (128 * par)) + 4 * fq + q4) * KST + 8 * p4;
#pragma unroll
        for (int dt = 0; dt < 8; ++dt) { const s16x4 a0 = vtr(v0p + 32 * dt), a1 = vtr(v1p + 32 * dt);
            const bf16x8 vf = __builtin_shufflevector(a0, a1, 0, 1, 2, 3, 4, 5, 6, 7);
            o[dt] = __builtin_amdgcn_mfma_f32_16x16x32_bf16(vf, pf, o[dt], 0, 0, 0); } }
    const float inv = 1.0f / l;
#pragma unroll
    for (int dt = 0; dt < 8; ++dt) { u32x2 w; w.x = pg8::cvt_pk_bf16(o[dt][0] * inv, o[dt][1] * inv); w.y = pg8::cvt_pk_bf16(o[dt][2] * inv, o[dt][3] * inv);
        *(u32x2*)(d.ob + (long)qi * d.ostep + 16 * dt + 4 * fq) = w; }
    if (d.ml && fq == 0) { d.ml[(long)qi * d.mlstep] = mx; d.ml[(long)qi * d.mlstep + 1] = l; }
}
__device__ __forceinline__ int chain_len(int ch) { return ch < 256 ? 4 : 2; }
__device__ __forceinline__ AD dil_desc(int ch, int i, bf16_t* BIG, float* SSQ, bf16_t* OG, float* ML) {
    int g, b, h, r, nb;
    if (ch < 256) { g = ch >> 7; const int c = ch & 127;
        if (g == 0) { const int combo = c >> 4; b = combo >> 2; h = combo & 3; r = 0; nb = (c & 15) * 4 + i; }
        else { const int combo = c >> 2; b = combo >> 4; h = (combo >> 2) & 3; r = combo & 3; nb = (c & 3) * 4 + i; } }
    else { g = 2; const int c = ch - 256, seq = c >> 1; b = seq >> 6; h = (seq >> 4) & 3; r = seq & 15; nb = (c & 1) * 2 + i; }
    const int dil = 1 << (2 * g);
    const long row0 = (long)b * SEQ + r, qrow = row0 + (long)dil * 128 * nb;
    AD d; d.qb = BIG + qrow * INW + (g * 4 + h) * 128; d.qstep = (long)dil * INW; d.sq = SSQ + qrow * 64 + (g * 4 + h) * 4; d.sqstep = (long)dil * 64;
    d.kb = BIG + row0 * INW + 1536 + h * 128; d.vb = BIG + row0 * INW + 2048 + h * 128; d.kstep = (long)dil * INW; d.ks0 = 128 * (nb - 1); d.sk = SSQ + row0 * 64 + (12 + h) * 4; d.skstep = (long)dil * 64;
    d.ob = OG + (size_t)g * M * 512 + qrow * 512 + h * 128; d.ostep = (long)dil * 512; d.ml = ML + (((size_t)g * M + qrow) * 4 + h) * 2; d.mlstep = (long)dil * 8; d.nb0 = nb == 0; return d;
}
__device__ __forceinline__ AD cross_desc(int u, bf16_t* QC, float* SSQC, bf16_t* MEMKV, float* SSQM, bf16_t* OC) {
    const int h = u & 3, qb = u >> 2, b = qb >> 6; const long qrow = (long)qb * 128;
    AD d; d.qb = QC + qrow * 512 + h * 128; d.qstep = 512; d.sq = SSQC + qrow * 16 + h * 4; d.sqstep = 16;
    d.kb = MEMKV + (size_t)b * NMEM * 1024 + h * 128; d.vb = d.kb + 512; d.kstep = 1024; d.ks0 = 0; d.sk = SSQM + (size_t)b * NMEM * 16 + h * 4; d.skstep = 16;
    d.ob = OC + qrow * 512 + h * 128; d.ostep = 512; d.ml = nullptr; d.mlstep = 0; d.nb0 = false; return d;
}

#define XB_TMO      128
#define XB_XCNT(j)  (256  + 64 * (j))
#define XB_XSUB(j)  (1280 + 64 * (j))
#define XB_XGEN(j)  (2304 + 64 * (j))
#define XB_TOP      3328
#define XB_TOPGEN   3392
#define XCD_BAR_WORDS 3456
#define XB_SPIN_CAP (1u << 18)

__device__ __forceinline__ unsigned xb_ld(unsigned* p)              { return __hip_atomic_load(p, __ATOMIC_RELAXED, __HIP_MEMORY_SCOPE_AGENT); }
__device__ __forceinline__ unsigned xb_add(unsigned* p, unsigned v) { return __hip_atomic_fetch_add(p, v, __ATOMIC_RELAXED, __HIP_MEMORY_SCOPE_AGENT); }
__device__ __forceinline__ unsigned xb_xcc_id() { return (unsigned)__builtin_amdgcn_s_getreg((3 << 11) | 20) & 0xFu; }
#define XB_SPIN(cond, bar) do { unsigned _sp = 0; while (cond) { __builtin_amdgcn_s_sleep(1); \
    if ((++_sp & 255u) == 0u) { if (xb_ld(&(bar)[XB_TMO])) break; if (_sp > XB_SPIN_CAP) { atomicAdd(&(bar)[XB_TMO], 1u); break; } } } } while (0)

struct XcdBarrier {
    unsigned* bar; unsigned x;
    volatile LAS unsigned* st;
};

__device__ __forceinline__ XcdBarrier xcd_barrier_post(unsigned* bar, volatile LAS unsigned* st) {
    XcdBarrier b; b.bar = bar; b.x = xb_xcc_id(); b.st = st;
    if (threadIdx.x == 0) (void)xb_add(&bar[XB_XCNT(b.x)], 1u);
    return b;
}
__device__ __forceinline__ void xcd_barrier_complete(unsigned* bar, unsigned x, unsigned& nloc, unsigned& nx) {
    const unsigned G = gridDim.x * gridDim.y * gridDim.z;
    unsigned sum, cnt, mine, sp = 0u;
    for (;;) {
        sum = 0u; cnt = 0u; mine = 0u;
#pragma unroll
        for (unsigned j = 0; j < 16; ++j) { const unsigned c = xb_ld(&bar[XB_XCNT(j)]); sum += c; cnt += (c > 0u) ? 1u : 0u; mine = (j == x) ? c : mine; }
        if (sum == G) break;
        __builtin_amdgcn_s_sleep(1);
        if ((++sp & 255u) == 0u) { if (xb_ld(&bar[XB_TMO])) break; if (sp > XB_SPIN_CAP) { atomicAdd(&bar[XB_TMO], 1u); break; } }
    }
    nloc = mine > 0u ? mine : 1u; nx = cnt > 0u ? cnt : 1u;
}

__device__ __forceinline__ void xcd_barrier(const XcdBarrier& b) {
    asm volatile("s_waitcnt vmcnt(0)" ::: "memory");
    __syncthreads();
    if (threadIdx.x == 0) {
        unsigned* bar = b.bar;
        __builtin_amdgcn_s_waitcnt(0);
        unsigned nloc = b.st[0], nx = b.st[1];
        if (nloc == 0u) { xcd_barrier_complete(bar, b.x, nloc, nx); b.st[0] = nloc; b.st[1] = nx; }
        const unsigned old = xb_add(&bar[XB_XSUB(b.x)], 1u);
        const unsigned gen = old / nloc;
        if (old + 1u == (gen + 1u) * nloc) {
            __builtin_amdgcn_fence(__ATOMIC_RELEASE, "agent");
            asm volatile("s_waitcnt vmcnt(0)" ::: "memory");
            const unsigned og = xb_add(&bar[XB_TOP], 1u);
            const unsigned tg = og / nx;
            if (og + 1u == (tg + 1u) * nx) xb_add(&bar[XB_TOPGEN], 1u);
            else XB_SPIN(xb_ld(&bar[XB_TOPGEN]) == tg, bar);
            __builtin_amdgcn_fence(__ATOMIC_ACQUIRE, "agent");
            xb_add(&bar[XB_XGEN(b.x)], 1u);
            asm volatile("s_waitcnt vmcnt(0)" ::: "memory");
        } else {
            XB_SPIN(xb_ld(&bar[XB_XGEN(b.x)]) == gen, bar);
            __builtin_amdgcn_fence(__ATOMIC_ACQUIRE, "agent");
            asm volatile("s_waitcnt vmcnt(0)" ::: "memory");
        }
    }
    __syncthreads();
}

#define REP_P0 1
#define REP_P1 1
#define REP_P2 1
#define REP_P2B 1
#define REP_P3 1
#define REP_P4 1
#define REP_P5 1
#define REP_P6 1
#define REP_P7 1
#define REP_P8 1
#define REP_SYNC 1
__global__ void __launch_bounds__(512) fwd(Args a) {
    extern __shared__ __attribute__((aligned(16))) unsigned char lds_raw[];
    LAS unsigned char* lds = (LAS unsigned char*)lds_raw;
    cg::grid_group grid = cg::this_grid();
    const int wave = __builtin_amdgcn_readfirstlane(threadIdx.x >> 6);
    const int G = gridDim.x, bx = blockIdx.x;
    unsigned char* ws = a.ws;
    volatile LAS unsigned* xst = (volatile LAS unsigned*)(lds + XB_LDS_OFF);
    if (threadIdx.x < 2) xst[threadIdx.x] = 0u;
    __syncthreads();
    const XcdBarrier xbar = xcd_barrier_post((unsigned*)ws, xst);
    if (ws == nullptr) grid.sync();
    const float* x = a.in[0]; const float* mem = a.in[1]; const int* pos = (const int*)a.in[2];
    bf16_t* Win = (bf16_t*)(ws + WS_WIN); bf16_t* Wout = (bf16_t*)(ws + WS_WOUT); bf16_t* Wcq = (bf16_t*)(ws + WS_WCQ); bf16_t* Wckv = (bf16_t*)(ws + WS_WCKV);
    bf16_t* Wco = (bf16_t*)(ws + WS_WCO); bf16_t* Wgu = (bf16_t*)(ws + WS_WGU); bf16_t* Wdn = (bf16_t*)(ws + WS_WDN);
    float* SSQ = (float*)(ws + WS_SSQ); float* COS = (float*)(ws + WS_COS); float* SIN = (float*)(ws + WS_SIN); float* RS1 = (float*)(ws + WS_RS1); float* RS2 = (float*)(ws + WS_RS2);
    float* SSQC = (float*)(ws + WS_SSQC); bf16_t* MEMN = (bf16_t*)(ws + WS_MEMN); bf16_t* MEMKV = (bf16_t*)(ws + WS_MEMKV); float* SSQM = (float*)(ws + WS_SSQM); float* ML = (float*)(ws + WS_ML);
    bf16_t* BA = (bf16_t*)(ws + WS_A); bf16_t* BB = (bf16_t*)(ws + WS_B); bf16_t* OG = (bf16_t*)(ws + WS_OG); bf16_t* QC = (bf16_t*)(ws + WS_QC); bf16_t* OC = (bf16_t*)(ws + WS_OC);
    bf16_t* BIG = (bf16_t*)(ws + WS_BIG);

    for (int rep = 0; rep < REP_P0; ++rep)
    {
        const int lane = pg8::fresh_lane(), tid = wave * 64 + lane;
        LAS float* scr = (LAS float*)(lds + wave * 16384);
        const int gw = bx * 8 + wave, NGW = G * 8;
        constexpr int I_IN = 16 * 96, I_OUT = 8 * 32, I_CQ = 16 * 16, I_CKV = 16 * 32, I_CO = 8 * 32, I_GU = 16 * 176, I_DN = 44 * 32;
        constexpr int NITEMS = I_IN + I_OUT + I_CQ + I_CKV + I_CO + I_GU + I_DN;
        for (int it = gw; it < NITEMS; it += NGW) {
            int r = it;
            if (r < I_IN) { tr_item<0>(a.in[4], INW, INW, nullptr, Win, 1024, scr, r, lane); continue; } r -= I_IN;
            if (r < I_OUT) { tr_item<0>(a.in[9], 1024, 1024, nullptr, Wout, 1024, scr, r, lane); continue; } r -= I_OUT;
            if (r < I_CQ) { tr_item<0>(a.in[12], 512, 512, a.in[10], Wcq, 1024, scr, r, lane); continue; } r -= I_CQ;
            if (r < I_CKV) { tr_item<0>(a.in[13], 1024, 1024, nullptr, Wckv, 1024, scr, r, lane); continue; } r -= I_CKV;
            if (r < I_CO) { tr_item<0>(a.in[16], 1024, 1024, nullptr, Wco, 512, scr, r, lane); continue; } r -= I_CO;
            if (r < I_GU) { tr_item<1>(a.in[18], 2 * DFF, 2 * DFF, a.in[17], Wgu, 1024, scr, r, lane); continue; } r -= I_GU;
            tr_item<0>(a.in[19], 1024, 1024, nullptr, Wdn, DFF, scr, r, lane);
        }
        {
            const float* pw = a.in[7]; const float* psc = a.in[8]; const float* wo = a.in[9];
            for (int idx = bx * 512 + tid; idx < 512 * 256; idx += G * 512) { const int n4 = (idx & 255) * 4, kc = idx >> 8, g = kc >> 7;
                const float* pr = pw + (size_t)kc * 128; const float* sc = psc + g * 128; const float* wr_ = wo + (size_t)(512 + g * 128) * 1024 + n4; f32x4 acc = {0.f, 0.f, 0.f, 0.f};
#pragma unroll 16
                for (int e = 0; e < 128; ++e) acc += *(const f32x4*)(wr_ + (size_t)e * 1024) * (pr[e] * sc[e]);
#pragma unroll
                for (int j = 0; j < 4; ++j) Wout[(size_t)(n4 + j) * 1024 + 512 + kc] = (bf16_t)(pg8::cvt_pk_bf16(acc[j], 0.f) & 0xffffu); }
        }
        for (int m = gw; m < M + 512; m += 2 * NGW) { const int m1 = m + NGW; const bool has1 = m1 < M + 512; const int mb = has1 ? m1 : m;
            const float* xa = m < M ? x + (size_t)m * DM : mem + (size_t)(m - M) * DM; const float* ga = m < M ? a.in[3] : a.in[11]; bf16_t* oa = m < M ? BA + (size_t)m * DM : MEMN + (size_t)(m - M) * DM;
            const float* xb = mb < M ? x + (size_t)mb * DM : mem + (size_t)(mb - M) * DM; const float* gb = mb < M ? a.in[3] : a.in[11]; bf16_t* ob = mb < M ? BA + (size_t)mb * DM : MEMN + (size_t)(mb - M) * DM;
            rms_rows2(xa, ga, oa, xb, gb, ob, has1, lane);
        }
        for (int idx = bx * 512 + tid; idx < M * 16; idx += G * 512) { const int row = idx >> 4, i = idx & 15;
            const float ang = (float)pos[row] * a.invf[i]; float s, c; sincos_d(ang, s, c); COS[idx] = c; SIN[idx] = s; }
    }
    for (int rep = 0; rep < REP_SYNC; ++rep) xcd_barrier(xbar);

    for (int rep = 0; rep < REP_P1; ++rep)
    {
        pg8::Gemm g{BA, Win, M, INW, 1024}; pg8::StaticOrder S; S.init(M, INW, G, bx);
        pg8::EpiProj E{BIG, SSQ, COS, SIN, a.in[5], a.in[6]};
        pg8::gemm_phase<pg8::EpiProj, pg8::StaticOrder, true, true>(lds, g, S, E, wave);
    }
    for (int rep = 0; rep < REP_SYNC; ++rep) xcd_barrier(xbar);

    for (int rep = 0; rep < REP_P2; ++rep)
    { const int lane = pg8::fresh_lane(), tid = wave * 64 + lane;
      KVR R; int ch = bx, i = 0;
      if (ch < 512) { const AD d = dil_desc(ch, 0, BIG, SSQ, OG, ML); attn_load(d, R, tid, true); }
      while (ch < 512) {
        const AD d = dil_desc(ch, i, BIG, SSQ, OG, ML); const int par = i & 1;
        attn_store(lds, R, tid, i == 0, par); QR Q; attn_loadq(d, Q, lane, wave);
        __syncthreads();
        int ni = i + 1, nch = ch; if (ni == chain_len(ch)) { ni = 0; nch = ch + G; }
        if (nch < 512) { const AD dn = dil_desc(nch, ni, BIG, SSQ, OG, ML); attn_load(dn, R, tid, ni == 0); }
        attn_compute<10, true>(lds, d, Q, lane, wave, par);
        __syncthreads();
        ch = nch; i = ni;
      } }
    for (int rep = 0; rep < REP_SYNC; ++rep) xcd_barrier(xbar);

    for (int rep = 0; rep < REP_P2B; ++rep)
    { const int lane = pg8::fresh_lane(), tid = wave * 64 + lane; const long gt = (long)bx * 512 + tid, NTH = (long)G * 512;
      for (long i0 = gt; i0 < (long)M * 64; i0 += 2 * NTH) {
          const long i1 = i0 + NTH; const bool has1 = i1 < (long)M * 64; const long ii[2] = {i0, has1 ? i1 : i0};
          float mm[2][3], ll[2][3]; u32x4 og[2][3];
#pragma unroll
          for (int q = 0; q < 2; ++q) { const int row = (int)(ii[q] >> 6), c = (int)(ii[q] & 63), h = c >> 4;
#pragma unroll
              for (int g = 0; g < 3; ++g) { const float* p = ML + (((size_t)g * M + row) * 4 + h) * 2; mm[q][g] = p[0]; ll[q][g] = p[1]; og[q][g] = *(const u32x4*)(OG + (size_t)g * M * 512 + (size_t)row * 512 + c * 8); } }
#pragma unroll
          for (int q = 0; q < 2; ++q) { const int row = (int)(ii[q] >> 6), c = (int)(ii[q] & 63);
              const float mmax = fmaxf(mm[q][0], fmaxf(mm[q][1], mm[q][2])); float w[3], den = 0.f;
#pragma unroll
              for (int g = 0; g < 3; ++g) { w[g] = __expf(mm[q][g] - mmax) * ll[q][g]; den += w[g]; }
              const float inv = 1.0f / den; float o[8];
#pragma unroll
              for (int j = 0; j < 8; ++j) o[j] = 0.f;
#pragma unroll
              for (int g = 0; g < 3; ++g) { float f[8]; unpack8(og[q][g], f); const float wg = w[g] * inv;
#pragma unroll
                  for (int j = 0; j < 8; ++j) o[j] += wg * f[j]; }
              if (q == 0 || has1) *(u32x4*)(BA + (size_t)row * DM + c * 8) = pg8::pack8((f32x4){o[0], o[1], o[2], o[3]}, (f32x4){o[4], o[5], o[6], o[7]}); }
      }
#define POOL_GROUP(GP, W) \
      for (long i = gt; i < (long)M * 16; i += NTH) { const int row = (int)(i >> 4), ch = (int)(i & 15), t = row & (SEQ - 1); \
          const bf16_t* up = BIG + (size_t)row * INW + 2560 + (GP) * 128 + ch * 8; u32x4 ld[W]; \
          _Pragma("unroll") for (int k = 0; k < (W); ++k) ld[k] = *(const u32x4*)(up - (size_t)(k <= t ? k : 0) * INW); \
          float f0[8], sum[8]; unpack8(ld[0], f0); \
          _Pragma("unroll") for (int j = 0; j < 8; ++j) sum[j] = f0[j]; \
          _Pragma("unroll") for (int k = 1; k < (W); ++k) { float f[8]; unpack8(ld[k], f); const float v = k <= t ? 1.f : 0.f; \
              _Pragma("unroll") for (int j = 0; j < 8; ++j) sum[j] += v * f[j]; } \
          const int cnt = (t + 1) < (W) ? (t + 1) : (W); const float ic = 1.0f / (float)cnt; float d[8]; \
          _Pragma("unroll") for (int j = 0; j < 8; ++j) d[j] = sum[j] * ic - f0[j]; \
          *(u32x4*)(BA + (size_t)row * DM + 512 + (GP) * 128 + ch * 8) = pg8::pack8((f32x4){d[0], d[1], d[2], d[3]}, (f32x4){d[4], d[5], d[6], d[7]}); }
      POOL_GROUP(0, 2) POOL_GROUP(1, 4) POOL_GROUP(2, 8) POOL_GROUP(3, 16)
#undef POOL_GROUP
    }
    for (int rep = 0; rep < REP_SYNC; ++rep) xcd_barrier(xbar);

    for (int rep = 0; rep < REP_P3; ++rep)
    {
        pg8::Gemm g{BA, Wout, M, 1024, 1024}; pg8::StaticOrder S; S.init(M, 1024, G, bx);
        pg8::EpiRes E{x, nullptr, nullptr, BB, RS1};
        pg8::gemm_phase<pg8::EpiRes, pg8::StaticOrder, true, true>(lds, g, S, E, wave);
    }
    for (int rep = 0; rep < REP_SYNC; ++rep) xcd_barrier(xbar);

    for (int rep = 0; rep < REP_P4; ++rep)
    {
        const bool split = G >= 136;
        if (!split || bx < G - 8) {
            pg8::Gemm g{BB, Wcq, M, 512, 1024}; pg8::StaticOrder S; S.init(M, 512, split ? G - 8 : G, bx);
            pg8::EpiCq E{RS1, QC, SSQC, a.in[14]};
            pg8::gemm_phase<pg8::EpiCq, pg8::StaticOrder, true, true>(lds, g, S, E, wave);
        }
        if (!split || bx >= G - 8) {
            pg8::Gemm g{MEMN, Wckv, 512, 1024, 1024}; pg8::StaticOrder S; S.init(512, 1024, split ? 8 : G, split ? bx - (G - 8) : bx);
            pg8::EpiKv E{MEMKV, SSQM, a.in[15]};
            pg8::gemm_phase<pg8::EpiKv, pg8::StaticOrder, true, true>(lds, g, S, E, wave);
        }
    }
    for (int rep = 0; rep < REP_SYNC; ++rep) xcd_barrier(xbar);

    for (int rep = 0; rep < REP_P5; ++rep)
    { const int lane = pg8::fresh_lane(), tid = wave * 64 + lane;
      for (int u = bx; u < 512; u += G) {
        const AD d = cross_desc(u, QC, SSQC, MEMKV, SSQM, OC);
        { KVR R; attn_load(d, R, tid, true); attn_store(lds, R, tid, true, 0); }
        QR Q; attn_loadq(d, Q, lane, wave);
        __syncthreads();
        attn_compute<16, false>(lds, d, Q, lane, wave, 0);
        __syncthreads();
      } }
    for (int rep = 0; rep < REP_SYNC; ++rep) xcd_barrier(xbar);

    for (int rep = 0; rep < REP_P6; ++rep)
    {
        pg8::Gemm g{OC, Wco, M, 1024, 512}; pg8::StaticOrder S; S.init(M, 1024, G, bx);
        pg8::EpiRes E{nullptr, BB, nullptr, BA, RS2};
        pg8::gemm_phase<pg8::EpiRes, pg8::StaticOrder, true, true>(lds, g, S, E, wave);
    }
    for (int rep = 0; rep < REP_SYNC; ++rep) xcd_barrier(xbar);

    for (int rep = 0; rep < REP_P7; ++rep)
    {
        pg8::Gemm g{BA, Wgu, M, 2 * DFF, 1024}; pg8::StaticOrder S; S.init(M, 2 * DFF, G, bx);
        pg8::EpiSwiglu E{RS2, BIG};
        pg8::gemm_phase<pg8::EpiSwiglu, pg8::StaticOrder, true, true>(lds, g, S, E, wave);
    }
    for (int rep = 0; rep < REP_SYNC; ++rep) xcd_barrier(xbar);

    for (int rep = 0; rep < REP_P8; ++rep)
    {
        pg8::Gemm g{BIG, Wdn, M, 1024, DFF}; pg8::StaticOrder S; S.init(M, 1024, G, bx);
        pg8::EpiRes E{nullptr, BA, a.out, nullptr, nullptr};
        pg8::gemm_phase<pg8::EpiRes, pg8::StaticOrder, true, true>(lds, g, S, E, wave);
    }
}

extern "C" void kernel_launch(void* const* d_in, const int* in_sizes, int n_in, void* d_out, int out_size, void* d_ws, size_t ws_size, hipStream_t stream) {
    static int grid_blocks = 0;
    if (grid_blocks == 0) {
        if (n_in != 20 || ws_size < WS_END) { fprintf(stderr, "kernel_launch: unexpected inputs (n_in %d, ws %zu)\n", n_in, ws_size); grid_blocks = -1; return; }
        int dev = 0, cus = 0, per_cu = 0;
        hipGetDevice(&dev); hipDeviceGetAttribute(&cus, hipDeviceAttributeMultiprocessorCount, dev);
        if (hipFuncSetAttribute((const void*)fwd, hipFuncAttributeMaxDynamicSharedMemorySize, LDS_BYTES) != hipSuccess) { fprintf(stderr, "kernel_launch: hipFuncSetAttribute failed\n"); }
        if (hipOccupancyMaxActiveBlocksPerMultiprocessor(&per_cu, (const void*)fwd, 512, LDS_BYTES) != hipSuccess || per_cu < 1) { fprintf(stderr, "kernel_launch: occupancy query says %d\n", per_cu); per_cu = 1; }
        (void)hipGetLastError();
        grid_blocks = cus * 1;
        if (grid_blocks < 1) grid_blocks = 1;
    }
    if (grid_blocks < 0) return;
    if (hipMemsetAsync(d_ws, 0, 16384, stream) != hipSuccess) { fprintf(stderr, "kernel_launch: memset failed\n"); return; }
    Args a{};
    for (int i = 0; i < 20; ++i) a.in[i] = (const float*)d_in[i];
    a.out = (float*)d_out; a.ws = (unsigned char*)d_ws;
    for (int i = 0; i < 16; ++i) a.invf[i] = (float)std::pow(500000.0, -(double)i / 16.0);
    void* args[] = {&a};
    hipError_t e = hipLaunchCooperativeKernel((const void*)fwd, dim3(grid_blocks), dim3(512), args, LDS_BYTES, stream);
    if (e != hipSuccess) fprintf(stderr, "cooperative launch failed: %s (grid %d)\n", hipGetErrorString(e), grid_blocks);
}
```

```cpp
#include <hip/hip_runtime.h>
#include <hip/hip_cooperative_groups.h>
#include <cstdio>
#include <cstdint>
#include <cmath>
namespace cg = cooperative_groups;
namespace pg8 {
#define PG8_LAS __attribute__((address_space(3)))
typedef unsigned short bf16_t;
typedef short bf16x8 __attribute__((ext_vector_type(8)));
typedef float f32x4 __attribute__((ext_vector_type(4)));
typedef unsigned u32x4 __attribute__((ext_vector_type(4)));
constexpr int BM = 256, BK = 64, HALF = 128, HTB = HALF * BK * 2  , STAGE_BYTES = 8 * HTB, NXCD = 8, WGM = 8;

__host__ __device__ __forceinline__ int lds_byte(int r, int c) { const int st = (r >> 4) * 2 + (c >> 5), rr = r & 15, cc = c & 31, ob = rr * 64 + cc * 2; return st * 1024 + (ob ^ (((ob >> 9) & 1) << 5)); }
__host__ __device__ __forceinline__ void stage_rc(int b, int& R, int& C) { const int st = b / 1024, sb = b % 1024, swz = sb ^ (((sb >> 9) & 1) << 5); R = (st >> 1) * 16 + swz / 64; C = (st & 1) * 32 + (swz % 64) / 2; }
__host__ __device__ __forceinline__ int perm32(int rho) { const int n = rho >> 4, i = rho & 15; return 8 * (i >> 2) + 4 * n + (i & 3); }

struct Unit { int pm, pn; };
struct Gemm { const bf16_t* A; const bf16_t* Bt; int M, N, K; };

struct StaticOrder {
    int nM, nN, nwg, G, c;
    __host__ __device__ void init(int M, int N, int G_, int c_) { nM = M / BM; nN = N / BM; nwg = nM * nN; G = G_; c = c_; }
    __host__ __device__ bool next(int i, Unit& u) const {
        const long L = (long)i * G + c; if (L >= nwg) return false;
        int wgid = (int)L; { const int q = nwg / NXCD, r = nwg % NXCD, xcd = wgid % NXCD, off = wgid / NXCD; wgid = (xcd < r ? xcd * (q + 1) : r * (q + 1) + (xcd - r) * q) + off; }
        const int nig = WGM * nN, gid = wgid / nig, fm = gid * WGM, gsz = (nM - fm) < WGM ? (nM - fm) : WGM;
        u.pm = fm + ((wgid % nig) % gsz); u.pn = (wgid % nig) / gsz; return true;
    }
    __device__ __forceinline__ void a_ready(const Unit&) const {}
    __device__ __forceinline__ void done(const Unit&) const {}
};

__device__ __forceinline__ unsigned cvt_pk_bf16(float lo, float hi) { unsigned r; asm volatile("v_cvt_pk_bf16_f32 %0, %1, %2" : "=v"(r) : "v"(lo), "v"(hi)); return r; }
typedef float f32x2 __attribute__((ext_vector_type(2)));
__device__ __forceinline__ int fresh_lane() { int l; asm volatile("v_mbcnt_lo_u32_b32 %0, -1, 0\n\tv_mbcnt_hi_u32_b32 %0, -1, %0" : "=v"(l)); return l; }
template <class Epi, class Sched, bool ALIGN_EPI = false, bool SP2 = false>
__device__ __forceinline__ void gemm_phase(PG8_LAS unsigned char* lds, const Gemm g, const Sched& S, const Epi& E, const int wid) {
    const int lane = fresh_lane(), tid = wid * 64 + lane, wr = wid >> 2, wc = wid & 3, fr = lane & 15, fq = lane >> 4;
    const int K = g.K, nt = K / BK;
    unsigned voffA[2], voffB[2];
#pragma unroll
    for (int i = 0; i < 2; ++i) { int R, C; stage_rc(tid * 16 + i * 8192, R, C); const int Rb = Epi::PERM ? ((R & ~31) + perm32(R & 31)) : R;
        voffA[i] = (unsigned)(R * K + C) * 2u; voffB[i] = (unsigned)(Rb * K + C) * 2u; }
    const size_t kstep = (size_t)(BK * 2);
    const size_t hstep = (size_t)HALF * K * 2;
    const size_t tstep = 2 * hstep;
    const unsigned ldsw = (unsigned)wid * 1024u;
    const int aoff = lds_byte(wr * 64 + fr, fq * 8), boff = lds_byte(wc * 32 + fr, fq * 8);
#define PG8_SA(b, h) (((b) * 2 + (h)) * HTB)
#define PG8_SB(b, h) ((4 + (b) * 2 + (h)) * HTB)
#define PG8_STAGE(bufoff, gbase, voff) do { _Pragma("unroll") for (int _i = 0; _i < 2; ++_i) \
        __builtin_amdgcn_global_load_lds((const unsigned*)((const char*)(gbase) + (voff)[_i]), (PG8_LAS unsigned*)(lds + (bufoff) + ldsw + _i * 8192), 16, 0, 0); } while (0)
#define PG8_LDA(dst, b, h) do { _Pragma("unroll") for (int m = 0; m < 4; ++m) _Pragma("unroll") for (int k = 0; k < 2; ++k) dst[m][k] = *(const PG8_LAS bf16x8*)(lds + PG8_SA(b, h) + aoff + m * 2048 + k * 1024); } while (0)
#define PG8_LDB(dst, b, h) do { _Pragma("unroll") for (int n = 0; n < 2; ++n) _Pragma("unroll") for (int k = 0; k < 2; ++k) dst[n][k] = *(const PG8_LAS bf16x8*)(lds + PG8_SB(b, h) + boff + n * 2048 + k * 1024); } while (0)
#define PG8_MMA(ai, bj, At, Bt) do { __builtin_amdgcn_s_setprio(1); _Pragma("unroll") for (int m = 0; m < 4; ++m) _Pragma("unroll") for (int n = 0; n < 2; ++n) _Pragma("unroll") for (int k = 0; k < 2; ++k) \
        acc[ai][bj][m][n] = __builtin_amdgcn_mfma_f32_16x16x32_bf16(Bt[n][k], At[m][k], acc[ai][bj][m][n], 0, 0, 0); __builtin_amdgcn_s_setprio(0); } while (0)
#define PG8_WAIT_V(n) asm volatile("s_waitcnt vmcnt(" #n ")" ::: "memory")
#define PG8_WAIT_L(n) asm volatile("s_waitcnt lgkmcnt(" #n ")" ::: "memory")
#define PG8_BAR __builtin_amdgcn_s_barrier()
#define PG8_SCHED __builtin_amdgcn_sched_barrier(0)
    Unit cur, nxt; int ui = 0;
    if (!S.next(0, cur)) return;
    f32x4 acc[2][2][4][2];
#pragma unroll
    for (int a = 0; a < 2; ++a)
#pragma unroll
        for (int b = 0; b < 2; ++b)
#pragma unroll
            for (int m = 0; m < 4; ++m)
#pragma unroll
                for (int n = 0; n < 2; ++n) acc[a][b][m][n] = (f32x4){0.f, 0.f, 0.f, 0.f};
    bf16x8 At[4][2], B0[2][2], B1[2][2];
    const char* cA = (const char*)g.A + (size_t)cur.pm * tstep; const char* cB = (const char*)g.Bt + (size_t)cur.pn * tstep;
    S.a_ready(cur);
    if constexpr (SP2) {
        PG8_STAGE(PG8_SB(0, 0), cB, voffB); PG8_STAGE(PG8_SB(0, 1), cB + hstep, voffB); PG8_STAGE(PG8_SA(0, 0), cA, voffA); PG8_STAGE(PG8_SA(0, 1), cA + hstep, voffA);
        if (wr == 1) PG8_BAR;
        PG8_WAIT_V(2); PG8_BAR;
        PG8_STAGE(PG8_SB(1, 0), cB + kstep, voffB); PG8_STAGE(PG8_SA(1, 0), cA + kstep, voffA); PG8_STAGE(PG8_SB(1, 1), cB + hstep + kstep, voffB);
        PG8_WAIT_V(6); PG8_BAR;
    } else {
        PG8_STAGE(PG8_SB(0, 0), cB, voffB); PG8_STAGE(PG8_SA(0, 0), cA, voffA); PG8_STAGE(PG8_SB(0, 1), cB + hstep, voffB); PG8_STAGE(PG8_SA(0, 1), cA + hstep, voffA);
        if (wr == 1) PG8_BAR;
        PG8_WAIT_V(4); PG8_BAR;
        PG8_STAGE(PG8_SB(1, 0), cB + kstep, voffB); PG8_STAGE(PG8_SA(1, 0), cA + kstep, voffA); PG8_STAGE(PG8_SB(1, 1), cB + hstep + kstep, voffB);
        PG8_WAIT_V(6); PG8_BAR;
    }
    for (;;) {
        const bool has_next = S.next(ui + 1, nxt);
        const char* nA = has_next ? (const char*)g.A + (size_t)nxt.pm * tstep : cA; const char* nB = has_next ? (const char*)g.Bt + (size_t)nxt.pn * tstep : cB;
        for (int t = 0; t < nt; t += 2) {
            const bool last = (t == nt - 2);
            const char* a1 = cA + (size_t)(t + 1) * kstep;
            const char* a2 = last ? nA : cA + (size_t)(t + 2) * kstep; const char* b2 = last ? nB : cB + (size_t)(t + 2) * kstep;
            const char* a3 = a2 + kstep; const char* b3 = b2 + kstep;
            if (last && has_next) S.a_ready(nxt);
            if constexpr (SP2) {
            PG8_LDB(B0, 0, 0); PG8_LDB(B1, 0, 1); PG8_SCHED; PG8_LDA(At, 0, 0); PG8_STAGE(PG8_SA(1, 1), a1 + hstep, voffA);
            PG8_WAIT_V(8); PG8_WAIT_L(0); PG8_BAR; PG8_MMA(0, 0, At, B0); PG8_MMA(0, 1, At, B1); PG8_BAR; PG8_SCHED;
            PG8_LDA(At, 0, 1); PG8_STAGE(PG8_SB(0, 0), b2, voffB); PG8_STAGE(PG8_SB(0, 1), b2 + hstep, voffB); PG8_STAGE(PG8_SA(0, 0), a2, voffA);
            PG8_WAIT_V(8); PG8_WAIT_L(0); PG8_BAR; PG8_MMA(1, 0, At, B0); PG8_MMA(1, 1, At, B1); PG8_BAR; PG8_SCHED;
            PG8_LDB(B0, 1, 0); PG8_LDB(B1, 1, 1); PG8_SCHED; PG8_LDA(At, 1, 0); PG8_STAGE(PG8_SA(0, 1), a2 + hstep, voffA);
            PG8_WAIT_V(8); PG8_WAIT_L(0); PG8_BAR; PG8_MMA(0, 0, At, B0); PG8_MMA(0, 1, At, B1); PG8_BAR; PG8_SCHED;
            PG8_LDA(At, 1, 1); PG8_STAGE(PG8_SB(1, 0), b3, voffB); PG8_STAGE(PG8_SB(1, 1), b3 + hstep, voffB); PG8_STAGE(PG8_SA(1, 0), a3, voffA);
            PG8_WAIT_V(8); PG8_WAIT_L(0); PG8_BAR; PG8_MMA(1, 0, At, B0); PG8_MMA(1, 1, At, B1); PG8_BAR; PG8_SCHED;
            } else {
            PG8_LDB(B0, 0, 0); PG8_SCHED; PG8_LDA(At, 0, 0); PG8_STAGE(PG8_SA(1, 1), a1 + hstep, voffA);
            PG8_WAIT_L(8); PG8_BAR; PG8_WAIT_L(0); PG8_MMA(0, 0, At, B0); PG8_BAR; PG8_SCHED;
            PG8_LDB(B1, 0, 1); PG8_STAGE(PG8_SB(0, 0), b2, voffB);
            PG8_BAR; PG8_WAIT_L(0); PG8_MMA(0, 1, At, B1); PG8_BAR;
            PG8_LDA(At, 0, 1); PG8_STAGE(PG8_SA(0, 0), a2, voffA);
            PG8_BAR; PG8_WAIT_L(0); PG8_MMA(1, 0, At, B0); PG8_BAR; PG8_SCHED;
            PG8_STAGE(PG8_SB(0, 1), b2 + hstep, voffB);
            PG8_WAIT_V(6); PG8_BAR; PG8_MMA(1, 1, At, B1); PG8_BAR;
            PG8_LDB(B0, 1, 0); PG8_SCHED; PG8_LDA(At, 1, 0); PG8_STAGE(PG8_SA(0, 1), a2 + hstep, voffA);
            PG8_WAIT_L(8); PG8_BAR; PG8_WAIT_L(0); PG8_MMA(0, 0, At, B0); PG8_BAR; PG8_SCHED;
            PG8_LDB(B1, 1, 1); PG8_STAGE(PG8_SB(1, 0), b3, voffB);
            PG8_BAR; PG8_WAIT_L(0); PG8_MMA(0, 1, At, B1); PG8_BAR;
            PG8_LDA(At, 1, 1); PG8_STAGE(PG8_SA(1, 0), a3, voffA);
            PG8_BAR; PG8_WAIT_L(0); PG8_MMA(1, 0, At, B0); PG8_BAR; PG8_SCHED;
            PG8_STAGE(PG8_SB(1, 1), b3 + hstep, voffB);
            PG8_WAIT_V(6); PG8_BAR; PG8_MMA(1, 1, At, B1); PG8_BAR;
            }
        }
        if constexpr (ALIGN_EPI) { if (wr == 0) PG8_BAR; }
        if constexpr (!Epi::AFTER_DRAIN) { E(acc, cur, wr, wc, fr, fq); S.done(cur); }
        if (!has_next) break;
#pragma unroll
        for (int a = 0; a < 2; ++a)
#pragma unroll
            for (int b = 0; b < 2; ++b)
#pragma unroll
                for (int m = 0; m < 4; ++m)
#pragma unroll
                    for (int n = 0; n < 2; ++n) acc[a][b][m][n] = (f32x4){0.f, 0.f, 0.f, 0.f};
        cur = nxt; cA = nA; cB = nB; ++ui;
        if constexpr (ALIGN_EPI) { if (wr == 1) PG8_BAR; }
    }
    PG8_WAIT_V(0);
    if constexpr (!ALIGN_EPI) { if (wr == 0) PG8_BAR; }
    PG8_BAR;
    if constexpr (Epi::AFTER_DRAIN) { E.fused(acc, cur, wr, wc, fr, fq, lds, wid, lane); S.done(cur); }
#undef PG8_SA
#undef PG8_SB
#undef PG8_STAGE
#undef PG8_LDA
#undef PG8_LDB
#undef PG8_MMA
#undef PG8_WAIT_V
#undef PG8_WAIT_L
#undef PG8_BAR
#undef PG8_SCHED
}
}

namespace pg8 {
__device__ __forceinline__ u32x4 pack8(const f32x4 v0, const f32x4 v1) {
    u32x4 w; w.x = cvt_pk_bf16(v0[0], v0[1]); w.y = cvt_pk_bf16(v0[2], v0[3]); w.z = cvt_pk_bf16(v1[0], v1[1]); w.w = cvt_pk_bf16(v1[2], v1[3]); return w; }
__device__ __forceinline__ float quad_sum(float s) { s += __shfl_xor(s, 16); s += __shfl_xor(s, 32); return s; }
__device__ __forceinline__ float sq8(const f32x4 a, const f32x4 b) { return (a[0] * a[0] + a[1] * a[1]) + (a[2] * a[2] + a[3] * a[3]) + (b[0] * b[0] + b[1] * b[1]) + (b[2] * b[2] + b[3] * b[3]); }
__device__ __forceinline__ f32x4 rs_quarter(const float* rs, int row, int fq) { return *(const f32x4*)(rs + (size_t)row * 16 + 4 * fq); }
__device__ __forceinline__ float rstd_from_quarter(const f32x4 a) { return rsqrtf(quad_sum((a[0] + a[1]) + (a[2] + a[3])) * (1.0f / 1024.0f) + 1e-6f); }

struct EpiProj {
    static constexpr bool PERM = true, AFTER_DRAIN = false;
    bf16_t* O; float* ssq; const float* cosT; const float* sinT; const float* gq; const float* gk;
    __device__ __forceinline__ void operator()(const f32x4 (&acc)[2][2][4][2], const Unit& u, int wr, int wc, int fr, int fq) const {
        const int pn = u.pn, row0 = u.pm * BM + wr * 64 + fr, cw = wc * 32 + 8 * fq;
        if (pn >= 8) {
#pragma unroll
            for (int ai = 0; ai < 2; ++ai)
#pragma unroll
                for (int m = 0; m < 4; ++m) { bf16_t* rowp = O + (size_t)(row0 + ai * HALF + m * 16) * 3072 + pn * BM + cw;
#pragma unroll
                    for (int bj = 0; bj < 2; ++bj) *(u32x4*)(rowp + bj * HALF) = pack8(acc[ai][bj][m][0], acc[ai][bj][m][1]); }
        } else {
            const bool isq = pn < 6; const float* g = isq ? gq : gk;
            const f32x4 g0 = *(const f32x4*)(g + cw), g1 = *(const f32x4*)(g + cw + 4);
            const float sc = isq ? 0.08838834764831845f : 1.0f;
            const float sg = (fq < 2) ? -1.0f : 1.0f;
#pragma unroll
            for (int ai = 0; ai < 2; ++ai)
#pragma unroll
                for (int m = 0; m < 4; ++m) { const int row = row0 + ai * HALF + m * 16;
                    f32x4 c0 = {0.f, 0.f, 0.f, 0.f}, c1 = c0, s0 = c0, s1 = c0;
                    if (wc == 0) { const float* cp = cosT + (size_t)row * 16 + 8 * (fq & 1); const float* sp = sinT + (size_t)row * 16 + 8 * (fq & 1);
                        c0 = *(const f32x4*)cp; c1 = *(const f32x4*)(cp + 4); s0 = *(const f32x4*)sp; s1 = *(const f32x4*)(sp + 4); }
                    bf16_t* rowp = O + (size_t)row * 3072 + pn * BM + cw;
#pragma unroll
                    for (int bj = 0; bj < 2; ++bj) { f32x4 v0 = acc[ai][bj][m][0], v1 = acc[ai][bj][m][1];
                        const float ss = quad_sum(sq8(v0, v1));
                        if (fq == 0) ssq[(size_t)row * 64 + (pn * 2 + bj) * 4 + wc] = ss;
                        v0 = v0 * g0; v1 = v1 * g1;
                        if (wc == 0) { f32x4 p0, p1;
#pragma unroll
                            for (int j = 0; j < 4; ++j) { p0[j] = __shfl_xor(v0[j], 32); p1[j] = __shfl_xor(v1[j], 32); }
                            v0 = v0 * c0 + (p0 * s0) * sg; v1 = v1 * c1 + (p1 * s1) * sg; }
                        v0 = v0 * sc; v1 = v1 * sc;
                        *(u32x4*)(rowp + bj * HALF) = pack8(v0, v1); } }
        }
    }
};
__device__ __forceinline__ void bf8_to_f32(const u32x4 w, f32x4& b0, f32x4& b1) {
    b0 = (f32x4){__uint_as_float(w.x << 16), __uint_as_float(w.x & 0xffff0000u), __uint_as_float(w.y << 16), __uint_as_float(w.y & 0xffff0000u)};
    b1 = (f32x4){__uint_as_float(w.z << 16), __uint_as_float(w.z & 0xffff0000u), __uint_as_float(w.w << 16), __uint_as_float(w.w & 0xffff0000u)}; }
struct EpiRes {
    static constexpr bool PERM = true, AFTER_DRAIN = false;
    const float* baseF; const bf16_t* baseB; float* outF; bf16_t* outB; float* rs;
    __device__ __forceinline__ void operator()(const f32x4 (&acc)[2][2][4][2], const Unit& u, int wr, int wc, int fr, int fq) const {
        const int row0 = u.pm * BM + wr * 64 + fr, col0 = u.pn * BM + wc * 32 + 8 * fq;
#pragma unroll
        for (int ai = 0; ai < 2; ++ai) {
            f32x4 b[4][2][2];
            if (baseF) {
#pragma unroll
                for (int m = 0; m < 4; ++m)
#pragma unroll
                    for (int bj = 0; bj < 2; ++bj) { const float* bp = baseF + (size_t)(row0 + ai * HALF + m * 16) * 1024 + col0 + bj * HALF; b[m][bj][0] = *(const f32x4*)bp; b[m][bj][1] = *(const f32x4*)(bp + 4); }
            } else { u32x4 w[4][2];
#pragma unroll
                for (int m = 0; m < 4; ++m)
#pragma unroll
                    for (int bj = 0; bj < 2; ++bj) w[m][bj] = *(const u32x4*)(baseB + (size_t)(row0 + ai * HALF + m * 16) * 1024 + col0 + bj * HALF);
#pragma unroll
                for (int m = 0; m < 4; ++m)
#pragma unroll
                    for (int bj = 0; bj < 2; ++bj) bf8_to_f32(w[m][bj], b[m][bj][0], b[m][bj][1]); }
#pragma unroll
            for (int m = 0; m < 4; ++m) { const int row = row0 + ai * HALF + m * 16; const size_t off = (size_t)row * 1024 + col0; float ss = 0.f;
#pragma unroll
                for (int bj = 0; bj < 2; ++bj) { const f32x4 v0 = acc[ai][bj][m][0] + b[m][bj][0], v1 = acc[ai][bj][m][1] + b[m][bj][1];
                    if (outF) { *(f32x4*)(outF + off + bj * HALF) = v0; *(f32x4*)(outF + off + bj * HALF + 4) = v1; }
                    if (outB) *(u32x4*)(outB + off + bj * HALF) = pack8(v0, v1);
                    ss += sq8(v0, v1); }
                if (rs) { ss = quad_sum(ss); if (fq == 0) rs[(size_t)row * 16 + u.pn * 4 + wc] = ss; } }
        }
    }
};
struct EpiCq {
    static constexpr bool PERM = true, AFTER_DRAIN = false;
    const float* rs1; bf16_t* O; float* ssqc; const float* g;
    __device__ __forceinline__ void operator()(const f32x4 (&acc)[2][2][4][2], const Unit& u, int wr, int wc, int fr, int fq) const {
        const int row0 = u.pm * BM + wr * 64 + fr, cw = wc * 32 + 8 * fq;
        const f32x4 g0 = *(const f32x4*)(g + cw) * 0.08838834764831845f, g1 = *(const f32x4*)(g + cw + 4) * 0.08838834764831845f;
        f32x4 rq[2][4];
#pragma unroll
        for (int ai = 0; ai < 2; ++ai)
#pragma unroll
            for (int m = 0; m < 4; ++m) rq[ai][m] = rs_quarter(rs1, row0 + ai * HALF + m * 16, fq);
#pragma unroll
        for (int ai = 0; ai < 2; ++ai)
#pragma unroll
            for (int m = 0; m < 4; ++m) { const int row = row0 + ai * HALF + m * 16; const float rstd = rstd_from_quarter(rq[ai][m]);
                bf16_t* rowp = O + (size_t)row * 512 + u.pn * BM + cw;
#pragma unroll
                for (int bj = 0; bj < 2; ++bj) { f32x4 v0 = acc[ai][bj][m][0] * rstd, v1 = acc[ai][bj][m][1] * rstd;
                    const float ss = quad_sum(sq8(v0, v1));
                    if (fq == 0) ssqc[(size_t)row * 16 + (u.pn * 2 + bj) * 4 + wc] = ss;
                    *(u32x4*)(rowp + bj * HALF) = pack8(v0 * g0, v1 * g1); } }
    }
};
struct EpiKv {
    static constexpr bool PERM = true, AFTER_DRAIN = false;
    bf16_t* O; float* ssqm; const float* g;
    __device__ __forceinline__ void operator()(const f32x4 (&acc)[2][2][4][2], const Unit& u, int wr, int wc, int fr, int fq) const {
        const int row0 = u.pm * BM + wr * 64 + fr, cw = wc * 32 + 8 * fq; const bool isk = u.pn < 2;
        f32x4 g0 = {1.f, 1.f, 1.f, 1.f}, g1 = g0;
        if (isk) { g0 = *(const f32x4*)(g + cw); g1 = *(const f32x4*)(g + cw + 4); }
#pragma unroll
        for (int ai = 0; ai < 2; ++ai)
#pragma unroll
            for (int m = 0; m < 4; ++m) { const int row = row0 + ai * HALF + m * 16; bf16_t* rowp = O + (size_t)row * 1024 + u.pn * BM + cw;
#pragma unroll
                for (int bj = 0; bj < 2; ++bj) { const f32x4 v0 = acc[ai][bj][m][0], v1 = acc[ai][bj][m][1];
                    if (isk) { const float ss = quad_sum(sq8(v0, v1)); if (fq == 0) ssqm[(size_t)row * 16 + (u.pn * 2 + bj) * 4 + wc] = ss; }
                    *(u32x4*)(rowp + bj * HALF) = pack8(v0 * g0, v1 * g1); } }
    }
};
struct EpiSwiglu {
    static constexpr bool PERM = true, AFTER_DRAIN = false;
    const float* rs2; bf16_t* act;
    __device__ __forceinline__ void operator()(const f32x4 (&acc)[2][2][4][2], const Unit& u, int wr, int wc, int fr, int fq) const {
        const int row0 = u.pm * BM + wr * 64 + fr, cw = wc * 32 + 8 * fq;
        f32x4 rq[2][4];
#pragma unroll
        for (int ai = 0; ai < 2; ++ai)
#pragma unroll
            for (int m = 0; m < 4; ++m) rq[ai][m] = rs_quarter(rs2, row0 + ai * HALF + m * 16, fq);
#pragma unroll
        for (int ai = 0; ai < 2; ++ai)
#pragma unroll
            for (int m = 0; m < 4; ++m) { const int row = row0 + ai * HALF + m * 16; const float rstd = rstd_from_quarter(rq[ai][m]);
                f32x4 a[2];
#pragma unroll
                for (int n = 0; n < 2; ++n) { const f32x4 gg = acc[ai][0][m][n] * rstd, uu = acc[ai][1][m][n] * rstd;
#pragma unroll
                    for (int j = 0; j < 4; ++j) a[n][j] = gg[j] * __builtin_amdgcn_rcpf(1.0f + __expf(-gg[j])) * uu[j]; }
                *(u32x4*)(act + (size_t)row * 2816 + u.pn * HALF + cw) = pack8(a[0], a[1]); }
    }
};
}

#define LAS __attribute__((address_space(3)))
typedef unsigned short bf16_t;
typedef short bf16x8 __attribute__((ext_vector_type(8)));
typedef short s16x4 __attribute__((ext_vector_type(4)));
typedef float f32x4 __attribute__((ext_vector_type(4)));
typedef unsigned u32x4 __attribute__((ext_vector_type(4)));
typedef unsigned u32x2 __attribute__((ext_vector_type(2)));
constexpr int M = 16384, SEQ = 8192, DM = 1024, INW = 3072, DFF = 2816, NMEM = 256;
constexpr size_t MiB = 1u << 20;
constexpr size_t WS_WIN = 1 * MiB, WS_WOUT = 7 * MiB, WS_WCQ = 9 * MiB, WS_WCKV = 10 * MiB, WS_WCO = 12 * MiB, WS_WGU = 13 * MiB, WS_WDN = 24 * MiB;
constexpr size_t WS_SSQ = 30 * MiB, WS_COS = 34 * MiB, WS_SIN = 35 * MiB, WS_RS1 = 36 * MiB, WS_RS2 = 37 * MiB, WS_SSQC = 38 * MiB, WS_MEMN = 39 * MiB, WS_MEMKV = 40 * MiB, WS_SSQM = 41 * MiB, WS_ML = 42 * MiB;
constexpr size_t WS_A = 48 * MiB;
constexpr size_t WS_B = 80 * MiB;
constexpr size_t WS_OG = 80 * MiB;
constexpr size_t WS_QC = 112 * MiB, WS_OC = 128 * MiB;
constexpr size_t WS_BIG = 144 * MiB;
constexpr size_t WS_END = 240 * MiB;
constexpr int LDS_BYTES = 149504, XB_LDS_OFF = 149000;
constexpr int KST = 288, A_KOFF = 0, A_VOFF = 256 * KST, A_RKOFF = 2 * 256 * KST;
static_assert(A_RKOFF + 1024 <= LDS_BYTES && pg8::STAGE_BYTES <= LDS_BYTES, "LDS map");

struct Args { const float* in[20]; float* out; unsigned char* ws; float invf[16]; };

__device__ __forceinline__ float wave_sum(float v) {
#pragma unroll
    for (int o = 1; o < 64; o <<= 1) v += __shfl_xor(v, o);
    return v;
}
__device__ __forceinline__ float bf_lo(unsigned w) { return __uint_as_float(w << 16); }
__device__ __forceinline__ float bf_hi(unsigned w) { return __uint_as_float(w & 0xffff0000u); }
__device__ __forceinline__ void unpack8(const u32x4 w, float (&f)[8]) { f[0] = bf_lo(w.x); f[1] = bf_hi(w.x); f[2] = bf_lo(w.y); f[3] = bf_hi(w.y); f[4] = bf_lo(w.z); f[5] = bf_hi(w.z); f[6] = bf_lo(w.w); f[7] = bf_hi(w.w); }

template <int MODE>
__device__ __forceinline__ void tr_item(const float* W, int Nsrc, int Ndst, const float* gain, bf16_t* WT, int ldt, LAS float* scr, int item, int lane) {
    const int nblk = Ndst / 32, kb = item / nblk, nb = item % nblk, k0 = 64 * kb, n0 = 32 * nb;
    const int s0 = MODE == 1 ? (((n0 >> 7) & 1) * DFF + (n0 >> 8) * 128 + (n0 & 127)) : n0;
    const int kr = lane >> 3, ch = lane & 7; f32x4 w[8];
#pragma unroll
    for (int i = 0; i < 8; ++i) w[i] = *(const f32x4*)(W + (size_t)(k0 + kr + 8 * i) * Nsrc + s0 + 4 * ch);
#pragma unroll
    for (int i = 0; i < 8; ++i) { const int kk = kr + 8 * i; const float gm = gain ? gain[k0 + kk] : 1.0f;
#pragma unroll
        for (int j = 0; j < 4; ++j) scr[kk * 33 + 4 * ch + j] = w[i][j] * gm; }
    asm volatile("s_waitcnt lgkmcnt(0)" ::: "memory");
    const int c = lane & 7;
#pragma unroll
    for (int j = 0; j < 4; ++j) { const int n = (lane >> 3) + 8 * j; const LAS float* s = scr + (8 * c) * 33 + n;
        u32x4 o; o.x = pg8::cvt_pk_bf16(s[0 * 33], s[1 * 33]); o.y = pg8::cvt_pk_bf16(s[2 * 33], s[3 * 33]); o.z = pg8::cvt_pk_bf16(s[4 * 33], s[5 * 33]); o.w = pg8::cvt_pk_bf16(s[6 * 33], s[7 * 33]);
        *(u32x4*)(WT + (size_t)(n0 + n) * ldt + k0 + 8 * c) = o; }
    asm volatile("s_waitcnt lgkmcnt(0)" ::: "memory");
}
__device__ __forceinline__ void rms_rows2(const float* x0, const float* g0, bf16_t* o0, const float* x1, const float* g1, bf16_t* o1, bool has1, int lane) {
    const f32x4* xr0 = (const f32x4*)x0 + lane; const f32x4* xr1 = (const f32x4*)x1 + lane;
    f32x4 v0[4], v1[4]; float s0 = 0.f, s1 = 0.f;
#pragma unroll
    for (int j = 0; j < 4; ++j) { v0[j] = xr0[64 * j]; v1[j] = xr1[64 * j]; }
#pragma unroll
    for (int j = 0; j < 4; ++j) { s0 += (v0[j][0] * v0[j][0] + v0[j][1] * v0[j][1]) + (v0[j][2] * v0[j][2] + v0[j][3] * v0[j][3]); s1 += (v1[j][0] * v1[j][0] + v1[j][1] * v1[j][1]) + (v1[j][2] * v1[j][2] + v1[j][3] * v1[j][3]); }
    const float r0 = rsqrtf(wave_sum(s0) * (1.0f / 1024.0f) + 1e-6f), r1 = rsqrtf(wave_sum(s1) * (1.0f / 1024.0f) + 1e-6f);
    const f32x4* gr0 = (const f32x4*)g0 + lane; const f32x4* gr1 = (const f32x4*)g1 + lane;
    u32x2* p0 = (u32x2*)o0 + lane; u32x2* p1 = (u32x2*)o1 + lane;
#pragma unroll
    for (int j = 0; j < 4; ++j) { const f32x4 y = v0[j] * r0 * gr0[64 * j]; u32x2 w; w.x = pg8::cvt_pk_bf16(y[0], y[1]); w.y = pg8::cvt_pk_bf16(y[2], y[3]); p0[64 * j] = w; }
    if (has1) {
#pragma unroll
        for (int j = 0; j < 4; ++j) { const f32x4 y = v1[j] * r1 * gr1[64 * j]; u32x2 w; w.x = pg8::cvt_pk_bf16(y[0], y[1]); w.y = pg8::cvt_pk_bf16(y[2], y[3]); p1[64 * j] = w; } }
}
__device__ __forceinline__ void sincos_d(float ang, float& s, float& c) {
    const double x = (double)ang; const double kq = rint(x * 0.63661977236758134308);
    const double r = (x - kq * 1.5707963267948966192) - kq * 6.123233995736766036e-17; const double r2 = r * r;
    double sp = -7.6471637318198164759e-13; sp = sp * r2 + 1.6059043836821614599e-10; sp = sp * r2 - 2.5052108385441718775e-08; sp = sp * r2 + 2.7557319223985890653e-06;
    sp = sp * r2 - 1.9841269841269841270e-04; sp = sp * r2 + 8.3333333333333333333e-03; sp = sp * r2 - 1.6666666666666666667e-01; sp = r + r * r2 * sp;
    double cp = 4.7794773323873852974e-14; cp = cp * r2 - 1.1470745597729724714e-11; cp = cp * r2 + 2.0876756987868098979e-09; cp = cp * r2 - 2.7557319223985890653e-07;
    cp = cp * r2 + 2.4801587301587301587e-05; cp = cp * r2 - 1.3888888888888888889e-03; cp = cp * r2 + 4.1666666666666666667e-02; cp = cp * r2 - 0.5; cp = 1.0 + r2 * cp;
    const int q = (int)((long long)kq & 3);
    const double sv = (q & 1) ? cp : sp, cv = (q & 1) ? sp : cp;
    s = (float)((q & 2) ? -sv : sv); c = (float)(((q + 1) & 2) ? -cv : cv);
}

__device__ __forceinline__ s16x4 vtr(LAS unsigned char* p) { return __builtin_bit_cast(s16x4, __builtin_amdgcn_ds_read_tr16_b64_v4i16((LAS s16x4*)p)); }
struct AD {
    const bf16_t* qb; long qstep; const float* sq; long sqstep; const bf16_t* kb; const bf16_t* vb; long kstep; int ks0; const float* sk; long skstep;
    bf16_t* ob; long ostep; float* ml; long mlstep; bool nb0; };
struct KVR { u32x4 kr[8], vr[8]; f32x4 sp; };
__device__ __forceinline__ void attn_load(const AD& d, KVR& R, int tid, bool first) {
    const int c = tid & 15, rr = tid >> 4;
#pragma unroll
    for (int it = 0; it < 4; ++it) { const int sidx = d.ks0 + 128 + rr + 32 * it; const long off = (long)sidx * d.kstep + 8 * c;
        R.kr[it] = *(const u32x4*)(d.kb + off); R.vr[it] = *(const u32x4*)(d.vb + off); }
    if (first) {
#pragma unroll
        for (int it = 4; it < 8; ++it) { int sidx = d.ks0 + rr + 32 * (it - 4); sidx = sidx < 0 ? 0 : sidx; const long off = (long)sidx * d.kstep + 8 * c;
            R.kr[it] = *(const u32x4*)(d.kb + off); R.vr[it] = *(const u32x4*)(d.vb + off); } }
    { int sidx = d.ks0 + ((tid + 128) & 255); sidx = sidx < 0 ? 0 : sidx; R.sp = *(const f32x4*)(d.sk + (long)sidx * d.skstep); }
}
__device__ __forceinline__ void attn_store(LAS unsigned char* lds, const KVR& R, int tid, bool first, int par) {
    const int c = tid & 15, rr = tid >> 4;
#pragma unroll
    for (int it = 0; it < 4; ++it) { const int row = (128 + rr + 32 * it) ^ (128 * par);
        *(LAS u32x4*)(lds + A_KOFF + row * KST + c * 16) = R.kr[it]; *(LAS u32x4*)(lds + A_VOFF + row * KST + c * 16) = R.vr[it]; }
    if (first) {
#pragma unroll
        for (int it = 4; it < 8; ++it) { const int row = (rr + 32 * (it - 4)) ^ (128 * par);
            *(LAS u32x4*)(lds + A_KOFF + row * KST + c * 16) = R.kr[it]; *(LAS u32x4*)(lds + A_VOFF + row * KST + c * 16) = R.vr[it]; } }
    if (tid < 128 || (first && tid < 256)) ((LAS float*)(lds + A_RKOFF))[((tid + 128) & 255) ^ (128 * par)] = rsqrtf(((R.sp[0] + R.sp[1]) + (R.sp[2] + R.sp[3])) * (1.0f / 128.0f) + 1e-6f);
}
struct QR { bf16x8 qf[4]; f32x4 sp; };
__device__ __forceinline__ void attn_loadq(const AD& d, QR& Q, int lane, int wave) {
    const int fr = lane & 15, fq = lane >> 4, qi = wave * 16 + fr;
#pragma unroll
    for (int ks = 0; ks < 4; ++ks) Q.qf[ks] = *(const bf16x8*)(d.qb + (long)qi * d.qstep + 32 * ks + 8 * fq);
    Q.sp = *(const f32x4*)(d.sq + (long)qi * d.sqstep);
}
template <int NT, bool MASK>
__device__ __forceinline__ void attn_compute(LAS unsigned char* lds, const AD& d, const QR& Q, int lane, int wave, int par) {
    const int fr = lane & 15, fq = lane >> 4, qi = wave * 16 + fr;
    const float rq = rsqrtf(((Q.sp[0] + Q.sp[1]) + (Q.sp[2] + Q.sp[3])) * (1.0f / 128.0f) + 1e-6f);
    const int ts = MASK ? (wave < 6 ? wave : 6) : 0;
    f32x4 s[NT];
#pragma unroll
    for (int tt = 0; tt < NT; ++tt) { s[tt] = (f32x4){0.f, 0.f, 0.f, 0.f};
#pragma unroll
        for (int ks = 0; ks < 4; ++ks) { const bf16x8 kf = *(const LAS bf16x8*)(lds + A_KOFF + (((16 * (ts + tt)) ^ (128 * par)) + fr) * KST + (32 * ks + 8 * fq) * 2);
            s[tt] = __builtin_amdgcn_mfma_f32_16x16x32_bf16(kf, Q.qf[ks], s[tt], 0, 0, 0); } }
    float mx = -3.0e38f;
#pragma unroll
    for (int tt = 0; tt < NT; ++tt) { const f32x4 rk4 = *(const LAS f32x4*)(lds + A_RKOFF + (((16 * (ts + tt)) ^ (128 * par)) + 4 * fq) * 4);
#pragma unroll
        for (int j = 0; j < 4; ++j) { const int kj = 16 * (ts + tt) + 4 * fq + j; float v = s[tt][j] * rq * rk4[j];
            if (MASK) { const bool valid = (kj >= qi) && (kj <= qi + 128) && (!d.nb0 || kj >= 128); v = valid ? v : -1.0e30f; }
            s[tt][j] = v; mx = fmaxf(mx, v); } }
    mx = fmaxf(mx, __shfl_xor(mx, 16)); mx = fmaxf(mx, __shfl_xor(mx, 32));
    float l = 0.f;
#pragma unroll
    for (int tt = 0; tt < NT; ++tt)
#pragma unroll
        for (int j = 0; j < 4; ++j) { const float p = __expf(s[tt][j] - mx); s[tt][j] = p; l += p; }
    l = pg8::quad_sum(l);
    f32x4 o[8];
#pragma unroll
    for (int dt = 0; dt < 8; ++dt) o[dt] = (f32x4){0.f, 0.f, 0.f, 0.f};
    const int q4 = fr >> 2, p4 = fr & 3;
#pragma unroll
    for (int pr = 0; pr < NT / 2; ++pr) { const bf16x8 pf = __builtin_bit_cast(bf16x8, pg8::pack8(s[2 * pr], s[2 * pr + 1]));
        LAS unsigned char* v0p = lds + A_VOFF + (((16 * (ts + 2 * pr)) ^ (128 * par)) + 4 * fq + q4) * KST + 8 * p4;
        LAS unsigned char* v1p = lds + A_VOFF + (((16 * (ts + 2 * pr + 1)) ^ (128 * par)) + 4 * fq + q4) * KST + 8 * p4;
#pragma unroll
        for (int dt = 0; dt < 8; ++dt) { const s16x4 a0 = vtr(v0p + 32 * dt), a1 = vtr(v1p + 32 * dt);
            const bf16x8 vf = __builtin_shufflevector(a0, a1, 0, 1, 2, 3, 4, 5, 6, 7);
            o[dt] = __builtin_amdgcn_mfma_f32_16x16x32_bf16(vf, pf, o[dt], 0, 0, 0); } }
    const float inv = 1.0f / l;
#pragma unroll
    for (int dt = 0; dt < 8; ++dt) { u32x2 w; w.x = pg8::cvt_pk_bf16(o[dt][0] * inv, o[dt][1] * inv); w.y = pg8::cvt_pk_bf16(o[dt][2] * inv, o[dt][3] * inv);
        *(u32x2*)(d.ob + (long)qi * d.ostep + 16 * dt + 4 * fq) = w; }
    if (d.ml && fq == 0) { d.ml[(long)qi * d.mlstep] = mx; d.ml[(long)qi * d.mlstep + 1] = l; }
}
__device__ __forceinline__ int chain_len(int ch) { return ch < 256 ? 4 : 2; }
__device__ __forceinline__ AD dil_desc(int ch, int i, bf16_t* BIG, float* SSQ, bf16_t* OG, float* ML) {
    int g, b, h, r, nb;
    if (ch < 256) { g = ch >> 7; const int c = ch & 127;
        if (g == 0) { const int combo = c >> 4; b = combo >> 2; h = combo & 3; r = 0; nb = (c & 15) * 4 + i; }
        else { const int combo = c >> 2; b = combo >> 4; h = (combo >> 2) & 3; r = combo & 3; nb = (c & 3) * 4 + i; } }
    else { g = 2; const int c = ch - 256, seq = c >> 1; b = seq >> 6; h = (seq >> 4) & 3; r = seq & 15; nb = (c & 1) * 2 + i; }
    const int dil = 1 << (2 * g);
    const long row0 = (long)b * SEQ + r, qrow = row0 + (long)dil * 128 * nb;
    AD d; d.qb = BIG + qrow * INW + (g * 4 + h) * 128; d.qstep = (long)dil * INW; d.sq = SSQ + qrow * 64 + (g * 4 + h) * 4; d.sqstep = (long)dil * 64;
    d.kb = BIG + row0 * INW + 1536 + h * 128; d.vb = BIG + row0 * INW + 2048 + h * 128; d.kstep = (long)dil * INW; d.ks0 = 128 * (nb - 1); d.sk = SSQ + row0 * 64 + (12 + h) * 4; d.skstep = (long)dil * 64;
    d.ob = OG + (size_t)g * M * 512 + qrow * 512 + h * 128; d.ostep = (long)dil * 512; d.ml = ML + (((size_t)g * M + qrow) * 4 + h) * 2; d.mlstep = (long)dil * 8; d.nb0 = nb == 0; return d;
}
__device__ __forceinline__ AD cross_desc(int u, bf16_t* QC, float* SSQC, bf16_t* MEMKV, float* SSQM, bf16_t* OC) {
    const int h = u & 3, qb = u >> 2, b = qb >> 6; const long qrow = (long)qb * 128;
    AD d; d.qb = QC + qrow * 512 + h * 128; d.qstep = 512; d.sq = SSQC + qrow * 16 + h * 4; d.sqstep = 16;
    d.kb = MEMKV + (size_t)b * NMEM * 1024 + h * 128; d.vb = d.kb + 512; d.kstep = 1024; d.ks0 = 0; d.sk = SSQM + (size_t)b * NMEM * 16 + h * 4; d.skstep = 16;
    d.ob = OC + qrow * 512 + h * 128; d.ostep = 512; d.ml = nullptr; d.mlstep = 0; d.nb0 = false; return d;
}

#define XB_TMO      128
#define XB_XCNT(j)  (256  + 64 * (j))
#define XB_XSUB(j)  (1280 + 64 * (j))
#define XB_XGEN(j)  (2304 + 64 * (j))
#define XB_TOP      3328
#define XB_TOPGEN   3392
#define XCD_BAR_WORDS 3456
#define XB_SPIN_CAP (1u << 18)

__device__ __forceinline__ unsigned xb_ld(unsigned* p)              { return __hip_atomic_load(p, __ATOMIC_RELAXED, __HIP_MEMORY_SCOPE_AGENT); }
__device__ __forceinline__ unsigned xb_add(unsigned* p, unsigned v) { return __hip_atomic_fetch_add(p, v, __ATOMIC_RELAXED, __HIP_MEMORY_SCOPE_AGENT); }
__device__ __forceinline__ unsigned xb_xcc_id() { return (unsigned)__builtin_amdgcn_s_getreg((3 << 11) | 20) & 0xFu; }
#define XB_SPIN(cond, bar) do { unsigned _sp = 0; while (cond) { __builtin_amdgcn_s_sleep(1); \
    if ((++_sp & 255u) == 0u) { if (xb_ld(&(bar)[XB_TMO])) break; if (_sp > XB_SPIN_CAP) { atomicAdd(&(bar)[XB_TMO], 1u); break; } } } } while (0)

struct XcdBarrier {
    unsigned* bar; unsigned x;
    volatile LAS unsigned* st;
};

__device__ __forceinline__ XcdBarrier xcd_barrier_post(unsigned* bar, volatile LAS unsigned* st) {
    XcdBarrier b; b.bar = bar; b.x = xb_xcc_id(); b.st = st;
    if (threadIdx.x == 0) (void)xb_add(&bar[XB_XCNT(b.x)], 1u);
    return b;
}
__device__ __forceinline__ void xcd_barrier_complete(unsigned* bar, unsigned x, unsigned& nloc, unsigned& nx) {
    const unsigned G = gridDim.x * gridDim.y * gridDim.z;
    unsigned sum, cnt, mine, sp = 0u;
    for (;;) {
        sum = 0u; cnt = 0u; mine = 0u;
#pragma unroll
        for (unsigned j = 0; j < 16; ++j) { const unsigned c = xb_ld(&bar[XB_XCNT(j)]); sum += c; cnt += (c > 0u) ? 1u : 0u; mine = (j == x) ? c : mine; }
        if (sum == G) break;
        __builtin_amdgcn_s_sleep(1);
        if ((++sp & 255u) == 0u) { if (xb_ld(&bar[XB_TMO])) break; if (sp > XB_SPIN_CAP) { atomicAdd(&bar[XB_TMO], 1u); break; } }
    }
    nloc = mine > 0u ? mine : 1u; nx = cnt > 0u ? cnt : 1u;
}

__device__ __forceinline__ void xcd_barrier(const XcdBarrier& b) {
    asm volatile("s_waitcnt vmcnt(0)" ::: "memory");
    __syncthreads();
    if (threadIdx.x == 0) {
        unsigned* bar = b.bar;
        __builtin_amdgcn_s_waitcnt(0);
        unsigned nloc = b.st[0], nx = b.st[1];
        if (nloc == 0u) { xcd_barrier_complete(bar, b.x, nloc, nx); b.st[0] = nloc; b.st[1] = nx; }
        const unsigned old = xb_add(&bar[XB_XSUB(b.x)], 1u);
        const unsigned gen = old / nloc;
        if (old + 1u == (gen + 1u) * nloc) {
            __builtin_amdgcn_fence(__ATOMIC_RELEASE, "agent");
            asm volatile("s_waitcnt vmcnt(0)" ::: "memory");
            const unsigned og = xb_add(&bar[XB_TOP], 1u);
            const unsigned tg = og / nx;
            if (og + 1u == (tg + 1u) * nx) xb_add(&bar[XB_TOPGEN], 1u);
            else XB_SPIN(xb_ld(&bar[XB_TOPGEN]) == tg, bar);
            __builtin_amdgcn_fence(__ATOMIC_ACQUIRE, "agent");
            xb_add(&bar[XB_XGEN(b.x)], 1u);
            asm volatile("s_waitcnt vmcnt(0)" ::: "memory");
        } else {
            XB_SPIN(xb_ld(&bar[XB_XGEN(b.x)]) == gen, bar);
            __builtin_amdgcn_fence(__ATOMIC_ACQUIRE, "agent");
            asm volatile("s_waitcnt vmcnt(0)" ::: "memory");
        }
    }
    __syncthreads();
}

#define REP_P0 1
#define REP_P1 1
#define REP_P2 1
#define REP_P2B 1
#define REP_P3 1
#define REP_P4 1
#define REP_P5 1
#define REP_P6 1
#define REP_P7 1
#define REP_P8 1
#define REP_SYNC 1
__global__ void __launch_bounds__(512) fwd(Args a) {
    extern __shared__ __attribute__((aligned(16))) unsigned char lds_raw[];
    LAS unsigned char* lds = (LAS unsigned char*)lds_raw;
    cg::grid_group grid = cg::this_grid();
    const int wave = __builtin_amdgcn_readfirstlane(threadIdx.x >> 6);
    const int G = gridDim.x, bx = blockIdx.x;
    unsigned char* ws = a.ws;
    volatile LAS unsigned* xst = (volatile LAS unsigned*)(lds + XB_LDS_OFF);
    if (threadIdx.x < 2) xst[threadIdx.x] = 0u;
    __syncthreads();
    const XcdBarrier xbar = xcd_barrier_post((unsigned*)ws, xst);
    if (ws == nullptr) grid.sync();
    const float* x = a.in[0]; const float* mem = a.in[1]; const int* pos = (const int*)a.in[2];
    bf16_t* Win = (bf16_t*)(ws + WS_WIN); bf16_t* Wout = (bf16_t*)(ws + WS_WOUT); bf16_t* Wcq = (bf16_t*)(ws + WS_WCQ); bf16_t* Wckv = (bf16_t*)(ws + WS_WCKV);
    bf16_t* Wco = (bf16_t*)(ws + WS_WCO); bf16_t* Wgu = (bf16_t*)(ws + WS_WGU); bf16_t* Wdn = (bf16_t*)(ws + WS_WDN);
    float* SSQ = (float*)(ws + WS_SSQ); float* COS = (float*)(ws + WS_COS); float* SIN = (float*)(ws + WS_SIN); float* RS1 = (float*)(ws + WS_RS1); float* RS2 = (float*)(ws + WS_RS2);
    float* SSQC = (float*)(ws + WS_SSQC); bf16_t* MEMN = (bf16_t*)(ws + WS_MEMN); bf16_t* MEMKV = (bf16_t*)(ws + WS_MEMKV); float* SSQM = (float*)(ws + WS_SSQM); float* ML = (float*)(ws + WS_ML);
    bf16_t* BA = (bf16_t*)(ws + WS_A); bf16_t* BB = (bf16_t*)(ws + WS_B); bf16_t* OG = (bf16_t*)(ws + WS_OG); bf16_t* QC = (bf16_t*)(ws + WS_QC); bf16_t* OC = (bf16_t*)(ws + WS_OC);
    bf16_t* BIG = (bf16_t*)(ws + WS_BIG);

    for (int rep = 0; rep < REP_P0; ++rep)
    {
        const int lane = pg8::fresh_lane(), tid = wave * 64 + lane;
        LAS float* scr = (LAS float*)(lds + wave * 16384);
        const int gw = bx * 8 + wave, NGW = G * 8;
        constexpr int I_IN = 16 * 96, I_OUT = 8 * 32, I_CQ = 16 * 16, I_CKV = 16 * 32;
        constexpr int NITEMS = I_IN + I_OUT + I_CQ + I_CKV;
        for (int it = gw; it < NITEMS; it += NGW) {
            int r = it;
            if (r < I_IN) { tr_item<0>(a.in[4], INW, INW, nullptr, Win, 1024, scr, r, lane); continue; } r -= I_IN;
            if (r < I_OUT) { tr_item<0>(a.in[9], 1024, 1024, nullptr, Wout, 1024, scr, r, lane); continue; } r -= I_OUT;
            if (r < I_CQ) { tr_item<0>(a.in[12], 512, 512, a.in[10], Wcq, 1024, scr, r, lane); continue; } r -= I_CQ;
            tr_item<0>(a.in[13], 1024, 1024, nullptr, Wckv, 1024, scr, r, lane);
        }
        {
            const float* pw = a.in[7]; const float* psc = a.in[8]; const float* wo = a.in[9];
            for (int idx = bx * 512 + tid; idx < 512 * 256; idx += G * 512) { const int n4 = (idx & 255) * 4, kc = idx >> 8, g = kc >> 7;
                const float* pr = pw + (size_t)kc * 128; const float* sc = psc + g * 128; const float* wr_ = wo + (size_t)(512 + g * 128) * 1024 + n4; f32x4 acc = {0.f, 0.f, 0.f, 0.f};
#pragma unroll 16
                for (int e = 0; e < 128; ++e) acc += *(const f32x4*)(wr_ + (size_t)e * 1024) * (pr[e] * sc[e]);
#pragma unroll
                for (int j = 0; j < 4; ++j) Wout[(size_t)(n4 + j) * 1024 + 512 + kc] = (bf16_t)(pg8::cvt_pk_bf16(acc[j], 0.f) & 0xffffu); }
        }
        for (int m = gw; m < M + 512; m += 2 * NGW) { const int m1 = m + NGW; const bool has1 = m1 < M + 512; const int mb = has1 ? m1 : m;
            const float* xa = m < M ? x + (size_t)m * DM : mem + (size_t)(m - M) * DM; const float* ga = m < M ? a.in[3] : a.in[11]; bf16_t* oa = m < M ? BA + (size_t)m * DM : MEMN + (size_t)(m - M) * DM;
            const float* xb = mb < M ? x + (size_t)mb * DM : mem + (size_t)(mb - M) * DM; const float* gb = mb < M ? a.in[3] : a.in[11]; bf16_t* ob = mb < M ? BA + (size_t)mb * DM : MEMN + (size_t)(mb - M) * DM;
            rms_rows2(xa, ga, oa, xb, gb, ob, has1, lane);
        }
        for (int idx = bx * 512 + tid; idx < M * 16; idx += G * 512) { const int row = idx >> 4, i = idx & 15;
            const float ang = (float)pos[row] * a.invf[i]; float s, c; sincos_d(ang, s, c); COS[idx] = c; SIN[idx] = s; }
    }
    for (int rep = 0; rep < REP_SYNC; ++rep) xcd_barrier(xbar);

    for (int rep = 0; rep < REP_P1; ++rep)
    {
        pg8::Gemm g{BA, Win, M, INW, 1024}; pg8::StaticOrder S; S.init(M, INW, G, bx);
        pg8::EpiProj E{BIG, SSQ, COS, SIN, a.in[5], a.in[6]};
        pg8::gemm_phase<pg8::EpiProj, pg8::StaticOrder, true, true>(lds, g, S, E, wave);
    }
    for (int rep = 0; rep < REP_SYNC; ++rep) xcd_barrier(xbar);

    for (int rep = 0; rep < REP_P2; ++rep)
    { const int lane = pg8::fresh_lane(), tid = wave * 64 + lane;
      KVR R; QR Qn; int ch = bx, i = 0;
      if (ch < 512) { const AD d = dil_desc(ch, 0, BIG, SSQ, OG, ML); attn_load(d, R, tid, true); attn_loadq(d, Qn, lane, wave); }
      while (ch < 512) {
        const AD d = dil_desc(ch, i, BIG, SSQ, OG, ML); const int par = i & 1;
        attn_store(lds, R, tid, i == 0, par); const QR Q = Qn;
        __syncthreads();
        int ni = i + 1, nch = ch; if (ni == chain_len(ch)) { ni = 0; nch = ch + G; }
        if (nch < 512) { const AD dn = dil_desc(nch, ni, BIG, SSQ, OG, ML); attn_load(dn, R, tid, ni == 0); attn_loadq(dn, Qn, lane, wave); }
        attn_compute<10, true>(lds, d, Q, lane, wave, par);
        __syncthreads();
        ch = nch; i = ni;
      } }
    for (int rep = 0; rep < REP_SYNC; ++rep) xcd_barrier(xbar);

    for (int rep = 0; rep < REP_P2B; ++rep)
    { const int lane = pg8::fresh_lane(), tid = wave * 64 + lane; const long gt = (long)bx * 512 + tid, NTH = (long)G * 512;
      for (long i0 = gt; i0 < (long)M * 64; i0 += 2 * NTH) {
          const long i1 = i0 + NTH; const bool has1 = i1 < (long)M * 64; const long ii[2] = {i0, has1 ? i1 : i0};
          float mm[2][3], ll[2][3]; u32x4 og[2][3];
#pragma unroll
          for (int q = 0; q < 2; ++q) { const int row = (int)(ii[q] >> 6), c = (int)(ii[q] & 63), h = c >> 4;
#pragma unroll
              for (int g = 0; g < 3; ++g) { const float* p = ML + (((size_t)g * M + row) * 4 + h) * 2; mm[q][g] = p[0]; ll[q][g] = p[1]; og[q][g] = *(const u32x4*)(OG + (size_t)g * M * 512 + (size_t)row * 512 + c * 8); } }
#pragma unroll
          for (int q = 0; q < 2; ++q) { const int row = (int)(ii[q] >> 6), c = (int)(ii[q] & 63);
              const float mmax = fmaxf(mm[q][0], fmaxf(mm[q][1], mm[q][2])); float w[3], den = 0.f;
#pragma unroll
              for (int g = 0; g < 3; ++g) { w[g] = __expf(mm[q][g] - mmax) * ll[q][g]; den += w[g]; }
              const float inv = 1.0f / den; float o[8];
#pragma unroll
              for (int j = 0; j < 8; ++j) o[j] = 0.f;
#pragma unroll
              for (int g = 0; g < 3; ++g) { float f[8]; unpack8(og[q][g], f); const float wg = w[g] * inv;
#pragma unroll
                  for (int j = 0; j < 8; ++j) o[j] += wg * f[j]; }
              if (q == 0 || has1) *(u32x4*)(BA + (size_t)row * DM + c * 8) = pg8::pack8((f32x4){o[0], o[1], o[2], o[3]}, (f32x4){o[4], o[5], o[6], o[7]}); }
      }
#define POOL_GROUP(GP, W) \
      for (long i = gt; i < (long)M * 16; i += NTH) { const int row = (int)(i >> 4), ch = (int)(i & 15), t = row & (SEQ - 1); \
          const bf16_t* up = BIG + (size_t)row * INW + 2560 + (GP) * 128 + ch * 8; u32x4 ld[W]; \
          _Pragma("unroll") for (int k = 0; k < (W); ++k) ld[k] = *(const u32x4*)(up - (size_t)(k <= t ? k : 0) * INW); \
          float f0[8], sum[8]; unpack8(ld[0], f0); \
          _Pragma("unroll") for (int j = 0; j < 8; ++j) sum[j] = f0[j]; \
          _Pragma("unroll") for (int k = 1; k < (W); ++k) { float f[8]; unpack8(ld[k], f); const float v = k <= t ? 1.f : 0.f; \
              _Pragma("unroll") for (int j = 0; j < 8; ++j) sum[j] += v * f[j]; } \
          const int cnt = (t + 1) < (W) ? (t + 1) : (W); const float ic = 1.0f / (float)cnt; float d[8]; \
          _Pragma("unroll") for (int j = 0; j < 8; ++j) d[j] = sum[j] * ic - f0[j]; \
          *(u32x4*)(BA + (size_t)row * DM + 512 + (GP) * 128 + ch * 8) = pg8::pack8((f32x4){d[0], d[1], d[2], d[3]}, (f32x4){d[4], d[5], d[6], d[7]}); }
      POOL_GROUP(0, 2) POOL_GROUP(1, 4) POOL_GROUP(2, 8) POOL_GROUP(3, 16)
#undef POOL_GROUP
    }
    for (int rep = 0; rep < REP_SYNC; ++rep) xcd_barrier(xbar);

    for (int rep = 0; rep < REP_P3; ++rep)
    {
        pg8::Gemm g{BA, Wout, M, 1024, 1024}; pg8::StaticOrder S; S.init(M, 1024, G, bx);
        pg8::EpiRes E{x, nullptr, nullptr, BB, RS1};
        pg8::gemm_phase<pg8::EpiRes, pg8::StaticOrder, true, true>(lds, g, S, E, wave);
    }
    for (int rep = 0; rep < REP_SYNC; ++rep) xcd_barrier(xbar);

    for (int rep = 0; rep < REP_P4; ++rep)
    {
        const bool split = G >= 136;
        if (!split || bx < G - 8) {
            pg8::Gemm g{BB, Wcq, M, 512, 1024}; pg8::StaticOrder S; S.init(M, 512, split ? G - 8 : G, bx);
            pg8::EpiCq E{RS1, QC, SSQC, a.in[14]};
            pg8::gemm_phase<pg8::EpiCq, pg8::StaticOrder, true, true>(lds, g, S, E, wave);
        }
        if (!split || bx >= G - 8) {
            pg8::Gemm g{MEMN, Wckv, 512, 1024, 1024}; pg8::StaticOrder S; S.init(512, 1024, split ? 8 : G, split ? bx - (G - 8) : bx);
            pg8::EpiKv E{MEMKV, SSQM, a.in[15]};
            pg8::gemm_phase<pg8::EpiKv, pg8::StaticOrder, true, true>(lds, g, S, E, wave);
        }
        {
            const int nidle = split ? G - 8 - 128 : 0; const bool useidle = nidle >= 32;
            if (!useidle || (bx >= 128 && bx < G - 8)) {
                const int lane = pg8::fresh_lane(); LAS float* scr = (LAS float*)(lds + wave * 16384);
                const int gw = (useidle ? bx - 128 : bx) * 8 + wave, NGW = (useidle ? nidle : G) * 8;
                constexpr int I_CO = 8 * 32, I_GU = 16 * 176, I_DN = 44 * 32;
                for (int it = gw; it < I_CO + I_GU + I_DN; it += NGW) {
                    int r = it;
                    if (r < I_CO) { tr_item<0>(a.in[16], 1024, 1024, nullptr, Wco, 512, scr, r, lane); continue; } r -= I_CO;
                    if (r < I_GU) { tr_item<1>(a.in[18], 2 * DFF, 2 * DFF, a.in[17], Wgu, 1024, scr, r, lane); continue; } r -= I_GU;
                    tr_item<0>(a.in[19], 1024, 1024, nullptr, Wdn, DFF, scr, r, lane);
                }
            }
        }
    }
    for (int rep = 0; rep < REP_SYNC; ++rep) xcd_barrier(xbar);

    for (int rep = 0; rep < REP_P5; ++rep)
    { const int lane = pg8::fresh_lane(), tid = wave * 64 + lane;
      for (int u = bx; u < 512; u += G) {
        const AD d = cross_desc(u, QC, SSQC, MEMKV, SSQM, OC);
        { KVR R; attn_load(d, R, tid, true); attn_store(lds, R, tid, true, 0); }
        QR Q; attn_loadq(d, Q, lane, wave);
        __syncthreads();
        attn_compute<16, false>(lds, d, Q, lane, wave, 0);
        __syncthreads();
      } }
    for (int rep = 0; rep < REP_SYNC; ++rep) xcd_barrier(xbar);

    for (int rep = 0; rep < REP_P6; ++rep)
    {
        pg8::Gemm g{OC, Wco, M, 1024, 512}; pg8::StaticOrder S; S.init(M, 1024, G, bx);
        pg8::EpiRes E{nullptr, BB, nullptr, BA, RS2};
        pg8::gemm_phase<pg8::EpiRes, pg8::StaticOrder, true, true>(lds, g, S, E, wave);
    }
    for (int rep = 0; rep < REP_SYNC; ++rep) xcd_barrier(xbar);

    for (int rep = 0; rep < REP_P7; ++rep)
    {
        pg8::Gemm g{BA, Wgu, M, 2 * DFF, 1024}; pg8::StaticOrder S; S.init(M, 2 * DFF, G, bx);
        pg8::EpiSwiglu E{RS2, BIG};
        pg8::gemm_phase<pg8::EpiSwiglu, pg8::StaticOrder, true, true>(lds, g, S, E, wave);
    }
    for (int rep = 0; rep < REP_SYNC; ++rep) xcd_barrier(xbar);

    for (int rep = 0; rep < REP_P8; ++rep)
    {
        pg8::Gemm g{BIG, Wdn, M, 1024, DFF}; pg8::StaticOrder S; S.init(M, 1024, G, bx);
        pg8::EpiRes E{nullptr, BA, a.out, nullptr, nullptr};
        pg8::gemm_phase<pg8::EpiRes, pg8::StaticOrder, true, true>(lds, g, S, E, wave);
    }
}

extern "C" void kernel_launch(void* const* d_in, const int* in_sizes, int n_in, void* d_out, int out_size, void* d_ws, size_t ws_size, hipStream_t stream) {
    static int grid_blocks = 0;
    if (grid_blocks == 0) {
        if (n_in != 20 || ws_size < WS_END) { fprintf(stderr, "kernel_launch: unexpected inputs (n_in %d, ws %zu)\n", n_in, ws_size); grid_blocks = -1; return; }
        int dev = 0, cus = 0, per_cu = 0;
        hipGetDevice(&dev); hipDeviceGetAttribute(&cus, hipDeviceAttributeMultiprocessorCount, dev);
        if (hipFuncSetAttribute((const void*)fwd, hipFuncAttributeMaxDynamicSharedMemorySize, LDS_BYTES) != hipSuccess) { fprintf(stderr, "kernel_launch: hipFuncSetAttribute failed\n"); }
        if (hipOccupancyMaxActiveBlocksPerMultiprocessor(&per_cu, (const void*)fwd, 512, LDS_BYTES) != hipSuccess || per_cu < 1) { fprintf(stderr, "kernel_launch: occupancy query says %d\n", per_cu); per_cu = 1; }
        (void)hipGetLastError();
        grid_blocks = cus * 1;
        if (grid_blocks < 1) grid_blocks = 1;
    }
    if (grid_blocks < 0) return;
    if (hipMemsetAsync(d_ws, 0, 16384, stream) != hipSuccess) { fprintf(stderr, "kernel_launch: memset failed\n"); return; }
    Args a{};
    for (int i = 0; i < 20; ++i) a.in[i] = (const float*)d_in[i];
    a.out = (float*)d_out; a.ws = (unsigned char*)d_ws;
    for (int i = 0; i < 16; ++i) a.invf[i] = (float)std::pow(500000.0, -(double)i / 16.0);
    void* args[] = {&a};
    hipError_t e = hipLaunchCooperativeKernel((const void*)fwd, dim3(grid_blocks), dim3(512), args, LDS_BYTES, stream);
    if (e != hipSuccess) fprintf(stderr, "cooperative launch failed: %s (grid %d)\n", hipGetErrorString(e), grid_blocks);
}
```

```cpp
#include <hip/hip_runtime.h>
#include <hip/hip_cooperative_groups.h>
#include <cstdio>
#include <cstdint>
#include <cmath>
namespace cg = cooperative_groups;
namespace pg8 {
#define PG8_LAS __attribute__((address_space(3)))
typedef unsigned short bf16_t;
typedef short bf16x8 __attribute__((ext_vector_type(8)));
typedef float f32x4 __attribute__((ext_vector_type(4)));
typedef unsigned u32x4 __attribute__((ext_vector_type(4)));
constexpr int BM = 256, BK = 64, HALF = 128, HTB = HALF * BK * 2  , STAGE_BYTES = 8 * HTB, NXCD = 8, WGM = 8;

__host__ __device__ __forceinline__ int lds_byte(int r, int c) { const int st = (r >> 4) * 2 + (c >> 5), rr = r & 15, cc = c & 31, ob = rr * 64 + cc * 2; return st * 1024 + (ob ^ (((ob >> 9) & 1) << 5)); }
__host__ __device__ __forceinline__ void stage_rc(int b, int& R, int& C) { const int st = b / 1024, sb = b % 1024, swz = sb ^ (((sb >> 9) & 1) << 5); R = (st >> 1) * 16 + swz / 64; C = (st & 1) * 32 + (swz % 64) / 2; }
__host__ __device__ __forceinline__ int perm32(int rho) { const int n = rho >> 4, i = rho & 15; return 8 * (i >> 2) + 4 * n + (i & 3); }

struct Unit { int pm, pn; };
struct Gemm { const bf16_t* A; const bf16_t* Bt; int M, N, K; };

struct StaticOrder {
    int nM, nN, nwg, G, c;
    __host__ __device__ __forceinline__ void init(int M, int N, int G_, int c_) { nM = M / BM; nN = N / BM; nwg = nM * nN; G = G_; c = c_; }
    __host__ __device__ __forceinline__ bool next(int i, Unit& u) const {
        const long L = (long)i * G + c; if (L >= nwg) return false;
        int wgid = (int)L; { const int q = nwg / NXCD, r = nwg % NXCD, xcd = wgid % NXCD, off = wgid / NXCD; wgid = (xcd < r ? xcd * (q + 1) : r * (q + 1) + (xcd - r) * q) + off; }
        const int nig = WGM * nN, gid = wgid / nig, fm = gid * WGM, gsz = (nM - fm) < WGM ? (nM - fm) : WGM;
        u.pm = fm + ((wgid % nig) % gsz); u.pn = (wgid % nig) / gsz; return true;
    }
    __device__ __forceinline__ void a_ready(const Unit&) const {}
    __device__ __forceinline__ void done(const Unit&) const {}
};

__device__ __forceinline__ unsigned cvt_pk_bf16(float lo, float hi) { unsigned r; asm volatile("v_cvt_pk_bf16_f32 %0, %1, %2" : "=v"(r) : "v"(lo), "v"(hi)); return r; }
typedef float f32x2 __attribute__((ext_vector_type(2)));
__device__ __forceinline__ int fresh_lane() { int l; asm volatile("v_mbcnt_lo_u32_b32 %0, -1, 0\n\tv_mbcnt_hi_u32_b32 %0, -1, %0" : "=v"(l)); return l; }
template <class Epi, class Sched, bool ALIGN_EPI = false, bool SP2 = false>
__device__ __forceinline__ void gemm_phase(PG8_LAS unsigned char* lds, const Gemm g, const Sched& S, const Epi& E, const int wid) {
    const int lane = fresh_lane(), tid = wid * 64 + lane, wr = wid >> 2, wc = wid & 3, fr = lane & 15, fq = lane >> 4;
    const int K = g.K, nt = K / BK;
    unsigned voffA[2], voffB[2];
#pragma unroll
    for (int i = 0; i < 2; ++i) { int R, C; stage_rc(tid * 16 + i * 8192, R, C); const int Rb = Epi::PERM ? ((R & ~31) + perm32(R & 31)) : R;
        voffA[i] = (unsigned)(R * K + C) * 2u; voffB[i] = (unsigned)(Rb * K + C) * 2u; }
    const size_t kstep = (size_t)(BK * 2);
    const size_t hstep = (size_t)HALF * K * 2;
    const size_t tstep = 2 * hstep;
    const unsigned ldsw = (unsigned)wid * 1024u;
    const int aoff = lds_byte(wr * 64 + fr, fq * 8), boff = lds_byte(wc * 32 + fr, fq * 8);
#define PG8_SA(b, h) (((b) * 2 + (h)) * HTB)
#define PG8_SB(b, h) ((4 + (b) * 2 + (h)) * HTB)
#define PG8_STAGE(bufoff, gbase, voff) do { _Pragma("unroll") for (int _i = 0; _i < 2; ++_i) \
        __builtin_amdgcn_global_load_lds((const unsigned*)((const char*)(gbase) + (voff)[_i]), (PG8_LAS unsigned*)(lds + (bufoff) + ldsw + _i * 8192), 16, 0, 0); } while (0)
#define PG8_LDA(dst, b, h) do { _Pragma("unroll") for (int m = 0; m < 4; ++m) _Pragma("unroll") for (int k = 0; k < 2; ++k) dst[m][k] = *(const PG8_LAS bf16x8*)(lds + PG8_SA(b, h) + aoff + m * 2048 + k * 1024); } while (0)
#define PG8_LDB(dst, b, h) do { _Pragma("unroll") for (int n = 0; n < 2; ++n) _Pragma("unroll") for (int k = 0; k < 2; ++k) dst[n][k] = *(const PG8_LAS bf16x8*)(lds + PG8_SB(b, h) + boff + n * 2048 + k * 1024); } while (0)
#define PG8_MMA(ai, bj, At, Bt) do { __builtin_amdgcn_s_setprio(1); _Pragma("unroll") for (int m = 0; m < 4; ++m) _Pragma("unroll") for (int n = 0; n < 2; ++n) _Pragma("unroll") for (int k = 0; k < 2; ++k) \
        acc[ai][bj][m][n] = __builtin_amdgcn_mfma_f32_16x16x32_bf16(Bt[n][k], At[m][k], acc[ai][bj][m][n], 0, 0, 0); __builtin_amdgcn_s_setprio(0); } while (0)
#define PG8_WAIT_V(n) asm volatile("s_waitcnt vmcnt(" #n ")" ::: "memory")
#define PG8_WAIT_L(n) asm volatile("s_waitcnt lgkmcnt(" #n ")" ::: "memory")
#define PG8_BAR __builtin_amdgcn_s_barrier()
#define PG8_SCHED __builtin_amdgcn_sched_barrier(0)
    Unit cur, nxt; int ui = 0;
    if (!S.next(0, cur)) return;
    f32x4 acc[2][2][4][2];
#pragma unroll
    for (int a = 0; a < 2; ++a)
#pragma unroll
        for (int b = 0; b < 2; ++b)
#pragma unroll
            for (int m = 0; m < 4; ++m)
#pragma unroll
                for (int n = 0; n < 2; ++n) acc[a][b][m][n] = (f32x4){0.f, 0.f, 0.f, 0.f};
    bf16x8 At[4][2], B0[2][2], B1[2][2];
    const char* cA = (const char*)g.A + (size_t)cur.pm * tstep; const char* cB = (const char*)g.Bt + (size_t)cur.pn * tstep;
    S.a_ready(cur);
    if constexpr (SP2) {
        PG8_STAGE(PG8_SB(0, 0), cB, voffB); PG8_STAGE(PG8_SB(0, 1), cB + hstep, voffB); PG8_STAGE(PG8_SA(0, 0), cA, voffA); PG8_STAGE(PG8_SA(0, 1), cA + hstep, voffA);
        if (wr == 1) PG8_BAR;
        PG8_WAIT_V(2); PG8_BAR;
        PG8_STAGE(PG8_SB(1, 0), cB + kstep, voffB); PG8_STAGE(PG8_SA(1, 0), cA + kstep, voffA); PG8_STAGE(PG8_SB(1, 1), cB + hstep + kstep, voffB);
        PG8_WAIT_V(6); PG8_BAR;
    } else {
        PG8_STAGE(PG8_SB(0, 0), cB, voffB); PG8_STAGE(PG8_SA(0, 0), cA, voffA); PG8_STAGE(PG8_SB(0, 1), cB + hstep, voffB); PG8_STAGE(PG8_SA(0, 1), cA + hstep, voffA);
        if (wr == 1) PG8_BAR;
        PG8_WAIT_V(4); PG8_BAR;
        PG8_STAGE(PG8_SB(1, 0), cB + kstep, voffB); PG8_STAGE(PG8_SA(1, 0), cA + kstep, voffA); PG8_STAGE(PG8_SB(1, 1), cB + hstep + kstep, voffB);
        PG8_WAIT_V(6); PG8_BAR;
    }
    for (;;) {
        const bool has_next = S.next(ui + 1, nxt);
        const char* nA = has_next ? (const char*)g.A + (size_t)nxt.pm * tstep : cA; const char* nB = has_next ? (const char*)g.Bt + (size_t)nxt.pn * tstep : cB;
        for (int t = 0; t < nt; t += 2) {
            const bool last = (t == nt - 2);
            const char* a1 = cA + (size_t)(t + 1) * kstep;
            const char* a2 = last ? nA : cA + (size_t)(t + 2) * kstep; const char* b2 = last ? nB : cB + (size_t)(t + 2) * kstep;
            const char* a3 = a2 + kstep; const char* b3 = b2 + kstep;
            if (last && has_next) S.a_ready(nxt);
            if constexpr (SP2) {
            PG8_LDB(B0, 0, 0); PG8_LDB(B1, 0, 1); PG8_SCHED; PG8_LDA(At, 0, 0); PG8_STAGE(PG8_SA(1, 1), a1 + hstep, voffA);
            PG8_WAIT_V(8); PG8_WAIT_L(0); PG8_BAR; PG8_MMA(0, 0, At, B0); PG8_MMA(0, 1, At, B1); PG8_BAR; PG8_SCHED;
            PG8_LDA(At, 0, 1); PG8_STAGE(PG8_SB(0, 0), b2, voffB); PG8_STAGE(PG8_SB(0, 1), b2 + hstep, voffB); PG8_STAGE(PG8_SA(0, 0), a2, voffA);
            PG8_WAIT_V(8); PG8_WAIT_L(0); PG8_BAR; PG8_MMA(1, 0, At, B0); PG8_MMA(1, 1, At, B1); PG8_BAR; PG8_SCHED;
            PG8_LDB(B0, 1, 0); PG8_LDB(B1, 1, 1); PG8_SCHED; PG8_LDA(At, 1, 0); PG8_STAGE(PG8_SA(0, 1), a2 + hstep, voffA);
            PG8_WAIT_V(8); PG8_WAIT_L(0); PG8_BAR; PG8_MMA(0, 0, At, B0); PG8_MMA(0, 1, At, B1); PG8_BAR; PG8_SCHED;
            PG8_LDA(At, 1, 1); PG8_STAGE(PG8_SB(1, 0), b3, voffB); PG8_STAGE(PG8_SB(1, 1), b3 + hstep, voffB); PG8_STAGE(PG8_SA(1, 0), a3, voffA);
            PG8_WAIT_V(8); PG8_WAIT_L(0); PG8_BAR; PG8_MMA(1, 0, At, B0); PG8_MMA(1, 1, At, B1); PG8_BAR; PG8_SCHED;
            } else {
            PG8_LDB(B0, 0, 0); PG8_SCHED; PG8_LDA(At, 0, 0); PG8_STAGE(PG8_SA(1, 1), a1 + hstep, voffA);
            PG8_WAIT_L(8); PG8_BAR; PG8_WAIT_L(0); PG8_MMA(0, 0, At, B0); PG8_BAR; PG8_SCHED;
            PG8_LDB(B1, 0, 1); PG8_STAGE(PG8_SB(0, 0), b2, voffB);
            PG8_BAR; PG8_WAIT_L(0); PG8_MMA(0, 1, At, B1); PG8_BAR;
            PG8_LDA(At, 0, 1); PG8_STAGE(PG8_SA(0, 0), a2, voffA);
            PG8_BAR; PG8_WAIT_L(0); PG8_MMA(1, 0, At, B0); PG8_BAR; PG8_SCHED;
            PG8_STAGE(PG8_SB(0, 1), b2 + hstep, voffB);
            PG8_WAIT_V(6); PG8_BAR; PG8_MMA(1, 1, At, B1); PG8_BAR;
            PG8_LDB(B0, 1, 0); PG8_SCHED; PG8_LDA(At, 1, 0); PG8_STAGE(PG8_SA(0, 1), a2 + hstep, voffA);
            PG8_WAIT_L(8); PG8_BAR; PG8_WAIT_L(0); PG8_MMA(0, 0, At, B0); PG8_BAR; PG8_SCHED;
            PG8_LDB(B1, 1, 1); PG8_STAGE(PG8_SB(1, 0), b3, voffB);
            PG8_BAR; PG8_WAIT_L(0); PG8_MMA(0, 1, At, B1); PG8_BAR;
            PG8_LDA(At, 1, 1); PG8_STAGE(PG8_SA(1, 0), a3, voffA);
            PG8_BAR; PG8_WAIT_L(0); PG8_MMA(1, 0, At, B0); PG8_BAR; PG8_SCHED;
            PG8_STAGE(PG8_SB(1, 1), b3 + hstep, voffB);
            PG8_WAIT_V(6); PG8_BAR; PG8_MMA(1, 1, At, B1); PG8_BAR;
            }
        }
        if constexpr (ALIGN_EPI) { if (wr == 0) PG8_BAR; }
        if constexpr (!Epi::AFTER_DRAIN) { E(acc, cur, wr, wc, fr, fq); S.done(cur); }
        if (!has_next) break;
#pragma unroll
        for (int a = 0; a < 2; ++a)
#pragma unroll
            for (int b = 0; b < 2; ++b)
#pragma unroll
                for (int m = 0; m < 4; ++m)
#pragma unroll
                    for (int n = 0; n < 2; ++n) acc[a][b][m][n] = (f32x4){0.f, 0.f, 0.f, 0.f};
        cur = nxt; cA = nA; cB = nB; ++ui;
        if constexpr (ALIGN_EPI) { if (wr == 1) PG8_BAR; }
    }
    PG8_WAIT_V(0);
    if constexpr (!ALIGN_EPI) { if (wr == 0) PG8_BAR; }
    PG8_BAR;
    if constexpr (Epi::AFTER_DRAIN) { E.fused(acc, cur, wr, wc, fr, fq, lds, wid, lane); S.done(cur); }
#undef PG8_SA
#undef PG8_SB
#undef PG8_STAGE
#undef PG8_LDA
#undef PG8_LDB
#undef PG8_MMA
#undef PG8_WAIT_V
#undef PG8_WAIT_L
#undef PG8_BAR
#undef PG8_SCHED
}
}

namespace pg8 {
__device__ __forceinline__ u32x4 pack8(const f32x4 v0, const f32x4 v1) {
    u32x4 w; w.x = cvt_pk_bf16(v0[0], v0[1]); w.y = cvt_pk_bf16(v0[2], v0[3]); w.z = cvt_pk_bf16(v1[0], v1[1]); w.w = cvt_pk_bf16(v1[2], v1[3]); return w; }
__device__ __forceinline__ float quad_sum(float s) { s += __shfl_xor(s, 16); s += __shfl_xor(s, 32); return s; }
__device__ __forceinline__ float sq8(const f32x4 a, const f32x4 b) { return (a[0] * a[0] + a[1] * a[1]) + (a[2] * a[2] + a[3] * a[3]) + (b[0] * b[0] + b[1] * b[1]) + (b[2] * b[2] + b[3] * b[3]); }
__device__ __forceinline__ f32x4 rs_quarter(const float* rs, int row, int fq) { return *(const f32x4*)(rs + (size_t)row * 16 + 4 * fq); }
__device__ __forceinline__ float rstd_from_quarter(const f32x4 a) { return rsqrtf(quad_sum((a[0] + a[1]) + (a[2] + a[3])) * (1.0f / 1024.0f) + 1e-6f); }

struct EpiProj {
    static constexpr bool PERM = true, AFTER_DRAIN = false;
    bf16_t* O; float* ssq; const float* cosT; const float* sinT; const float* gq; const float* gk;
    __device__ __forceinline__ void operator()(const f32x4 (&acc)[2][2][4][2], const Unit& u, int wr, int wc, int fr, int fq) const {
        const int pn = u.pn, row0 = u.pm * BM + wr * 64 + fr, cw = wc * 32 + 8 * fq;
        if (pn >= 8) {
#pragma unroll
            for (int ai = 0; ai < 2; ++ai)
#pragma unroll
                for (int m = 0; m < 4; ++m) { bf16_t* rowp = O + (size_t)(row0 + ai * HALF + m * 16) * 3072 + pn * BM + cw;
#pragma unroll
                    for (int bj = 0; bj < 2; ++bj) *(u32x4*)(rowp + bj * HALF) = pack8(acc[ai][bj][m][0], acc[ai][bj][m][1]); }
        } else {
            const bool isq = pn < 6; const float* g = isq ? gq : gk;
            const f32x4 g0 = *(const f32x4*)(g + cw), g1 = *(const f32x4*)(g + cw + 4);
            const float sc = isq ? 0.08838834764831845f : 1.0f;
            const float sg = (fq < 2) ? -1.0f : 1.0f;
#pragma unroll
            for (int ai = 0; ai < 2; ++ai)
#pragma unroll
                for (int m = 0; m < 4; ++m) { const int row = row0 + ai * HALF + m * 16;
                    f32x4 c0 = {0.f, 0.f, 0.f, 0.f}, c1 = c0, s0 = c0, s1 = c0;
                    if (wc == 0) { const float* cp = cosT + (size_t)row * 16 + 8 * (fq & 1); const float* sp = sinT + (size_t)row * 16 + 8 * (fq & 1);
                        c0 = *(const f32x4*)cp; c1 = *(const f32x4*)(cp + 4); s0 = *(const f32x4*)sp; s1 = *(const f32x4*)(sp + 4); }
                    bf16_t* rowp = O + (size_t)row * 3072 + pn * BM + cw;
#pragma unroll
                    for (int bj = 0; bj < 2; ++bj) { f32x4 v0 = acc[ai][bj][m][0], v1 = acc[ai][bj][m][1];
                        const float ss = quad_sum(sq8(v0, v1));
                        if (fq == 0) ssq[(size_t)row * 64 + (pn * 2 + bj) * 4 + wc] = ss;
                        v0 = v0 * g0; v1 = v1 * g1;
                        if (wc == 0) { f32x4 p0, p1;
#pragma unroll
                            for (int j = 0; j < 4; ++j) { p0[j] = __shfl_xor(v0[j], 32); p1[j] = __shfl_xor(v1[j], 32); }
                            v0 = v0 * c0 + (p0 * s0) * sg; v1 = v1 * c1 + (p1 * s1) * sg; }
                        v0 = v0 * sc; v1 = v1 * sc;
                        *(u32x4*)(rowp + bj * HALF) = pack8(v0, v1); } }
        }
    }
};
__device__ __forceinline__ void bf8_to_f32(const u32x4 w, f32x4& b0, f32x4& b1) {
    b0 = (f32x4){__uint_as_float(w.x << 16), __uint_as_float(w.x & 0xffff0000u), __uint_as_float(w.y << 16), __uint_as_float(w.y & 0xffff0000u)};
    b1 = (f32x4){__uint_as_float(w.z << 16), __uint_as_float(w.z & 0xffff0000u), __uint_as_float(w.w << 16), __uint_as_float(w.w & 0xffff0000u)}; }
struct EpiRes {
    static constexpr bool PERM = true, AFTER_DRAIN = false;
    const float* baseF; const bf16_t* baseB; float* outF; bf16_t* outB; float* rs; const float* invr; const float* gcol;
    __device__ __forceinline__ void operator()(const f32x4 (&acc)[2][2][4][2], const Unit& u, int wr, int wc, int fr, int fq) const {
        const int row0 = u.pm * BM + wr * 64 + fr, col0 = u.pn * BM + wc * 32 + 8 * fq;
#pragma unroll
        for (int ai = 0; ai < 2; ++ai) {
            f32x4 b[4][2][2];
            if (invr) {
                f32x4 gi[2][2]; bool bad[2];
#pragma unroll
                for (int bj = 0; bj < 2; ++bj) { const f32x4 g0 = *(const f32x4*)(gcol + col0 + bj * HALF), g1 = *(const f32x4*)(gcol + col0 + bj * HALF + 4); float mn = 3.0e38f;
#pragma unroll
                    for (int j = 0; j < 4; ++j) { mn = fminf(mn, fminf(fabsf(g0[j]), fabsf(g1[j]))); gi[bj][0][j] = 1.0f / g0[j]; gi[bj][1][j] = 1.0f / g1[j]; }
                    bad[bj] = !(mn > 0.015625f); }
                u32x4 w[4][2]; float ir[4];
#pragma unroll
                for (int m = 0; m < 4; ++m) { ir[m] = invr[row0 + ai * HALF + m * 16];
#pragma unroll
                    for (int bj = 0; bj < 2; ++bj) w[m][bj] = *(const u32x4*)(baseB + (size_t)(row0 + ai * HALF + m * 16) * 1024 + col0 + bj * HALF); }
#pragma unroll
                for (int m = 0; m < 4; ++m)
#pragma unroll
                    for (int bj = 0; bj < 2; ++bj) { bf8_to_f32(w[m][bj], b[m][bj][0], b[m][bj][1]); b[m][bj][0] = b[m][bj][0] * (gi[bj][0] * ir[m]); b[m][bj][1] = b[m][bj][1] * (gi[bj][1] * ir[m]);
                        if (bad[bj]) { const float* bp = baseF + (size_t)(row0 + ai * HALF + m * 16) * 1024 + col0 + bj * HALF; b[m][bj][0] = *(const f32x4*)bp; b[m][bj][1] = *(const f32x4*)(bp + 4); } }
            } else if (baseF) {
#pragma unroll
                for (int m = 0; m < 4; ++m)
#pragma unroll
                    for (int bj = 0; bj < 2; ++bj) { const float* bp = baseF + (size_t)(row0 + ai * HALF + m * 16) * 1024 + col0 + bj * HALF; b[m][bj][0] = *(const f32x4*)bp; b[m][bj][1] = *(const f32x4*)(bp + 4); }
            } else { u32x4 w[4][2];
#pragma unroll
                for (int m = 0; m < 4; ++m)
#pragma unroll
                    for (int bj = 0; bj < 2; ++bj) w[m][bj] = *(const u32x4*)(baseB + (size_t)(row0 + ai * HALF + m * 16) * 1024 + col0 + bj * HALF);
#pragma unroll
                for (int m = 0; m < 4; ++m)
#pragma unroll
                    for (int bj = 0; bj < 2; ++bj) bf8_to_f32(w[m][bj], b[m][bj][0], b[m][bj][1]); }
#pragma unroll
            for (int m = 0; m < 4; ++m) { const int row = row0 + ai * HALF + m * 16; const size_t off = (size_t)row * 1024 + col0; float ss = 0.f;
#pragma unroll
                for (int bj = 0; bj < 2; ++bj) { const f32x4 v0 = acc[ai][bj][m][0] + b[m][bj][0], v1 = acc[ai][bj][m][1] + b[m][bj][1];
                    if (outF) { __builtin_nontemporal_store(v0, (f32x4*)(outF + off + bj * HALF)); __builtin_nontemporal_store(v1, (f32x4*)(outF + off + bj * HALF + 4)); }
                    if (outB) *(u32x4*)(outB + off + bj * HALF) = pack8(v0, v1);
                    ss += sq8(v0, v1); }
                if (rs) { ss = quad_sum(ss); if (fq == 0) rs[(size_t)row * 16 + u.pn * 4 + wc] = ss; } }
        }
    }
};
struct EpiCq {
    static constexpr bool PERM = true, AFTER_DRAIN = false;
    const float* rs1; bf16_t* O; float* ssqc; const float* g;
    __device__ __forceinline__ void operator()(const f32x4 (&acc)[2][2][4][2], const Unit& u, int wr, int wc, int fr, int fq) const {
        const int row0 = u.pm * BM + wr * 64 + fr, cw = wc * 32 + 8 * fq;
        const f32x4 g0 = *(const f32x4*)(g + cw) * 0.08838834764831845f, g1 = *(const f32x4*)(g + cw + 4) * 0.08838834764831845f;
        f32x4 rq[2][4];
#pragma unroll
        for (int ai = 0; ai < 2; ++ai)
#pragma unroll
            for (int m = 0; m < 4; ++m) rq[ai][m] = rs_quarter(rs1, row0 + ai * HALF + m * 16, fq);
#pragma unroll
        for (int ai = 0; ai < 2; ++ai)
#pragma unroll
            for (int m = 0; m < 4; ++m) { const int row = row0 + ai * HALF + m * 16; const float rstd = rstd_from_quarter(rq[ai][m]);
                bf16_t* rowp = O + (size_t)row * 512 + u.pn * BM + cw;
#pragma unroll
                for (int bj = 0; bj < 2; ++bj) { f32x4 v0 = acc[ai][bj][m][0] * rstd, v1 = acc[ai][bj][m][1] * rstd;
                    const float ss = quad_sum(sq8(v0, v1));
                    if (fq == 0) ssqc[(size_t)row * 16 + (u.pn * 2 + bj) * 4 + wc] = ss;
                    *(u32x4*)(rowp + bj * HALF) = pack8(v0 * g0, v1 * g1); } }
    }
};
struct EpiKv {
    static constexpr bool PERM = true, AFTER_DRAIN = false;
    bf16_t* O; float* ssqm; const float* g;
    __device__ __forceinline__ void operator()(const f32x4 (&acc)[2][2][4][2], const Unit& u, int wr, int wc, int fr, int fq) const {
        const int row0 = u.pm * BM + wr * 64 + fr, cw = wc * 32 + 8 * fq; const bool isk = u.pn < 2;
        f32x4 g0 = {1.f, 1.f, 1.f, 1.f}, g1 = g0;
        if (isk) { g0 = *(const f32x4*)(g + cw); g1 = *(const f32x4*)(g + cw + 4); }
#pragma unroll
        for (int ai = 0; ai < 2; ++ai)
#pragma unroll
            for (int m = 0; m < 4; ++m) { const int row = row0 + ai * HALF + m * 16; bf16_t* rowp = O + (size_t)row * 1024 + u.pn * BM + cw;
#pragma unroll
                for (int bj = 0; bj < 2; ++bj) { const f32x4 v0 = acc[ai][bj][m][0], v1 = acc[ai][bj][m][1];
                    if (isk) { const float ss = quad_sum(sq8(v0, v1)); if (fq == 0) ssqm[(size_t)row * 16 + (u.pn * 2 + bj) * 4 + wc] = ss; }
                    *(u32x4*)(rowp + bj * HALF) = pack8(v0 * g0, v1 * g1); } }
    }
};
struct EpiSwiglu {
    static constexpr bool PERM = true, AFTER_DRAIN = false;
    const float* rs2; bf16_t* act;
    __device__ __forceinline__ void operator()(const f32x4 (&acc)[2][2][4][2], const Unit& u, int wr, int wc, int fr, int fq) const {
        const int row0 = u.pm * BM + wr * 64 + fr, cw = wc * 32 + 8 * fq;
        f32x4 rq[2][4];
#pragma unroll
        for (int ai = 0; ai < 2; ++ai)
#pragma unroll
            for (int m = 0; m < 4; ++m) rq[ai][m] = rs_quarter(rs2, row0 + ai * HALF + m * 16, fq);
#pragma unroll
        for (int ai = 0; ai < 2; ++ai)
#pragma unroll
            for (int m = 0; m < 4; ++m) { const int row = row0 + ai * HALF + m * 16; const float rstd = rstd_from_quarter(rq[ai][m]);
                f32x4 a[2];
#pragma unroll
                for (int n = 0; n < 2; ++n) { const f32x4 gg = acc[ai][0][m][n] * rstd, uu = acc[ai][1][m][n] * rstd;
#pragma unroll
                    for (int j = 0; j < 4; ++j) a[n][j] = gg[j] * __builtin_amdgcn_rcpf(1.0f + __expf(-gg[j])) * uu[j]; }
                *(u32x4*)(act + (size_t)row * 2816 + u.pn * HALF + cw) = pack8(a[0], a[1]); }
    }
};
}

#define LAS __attribute__((address_space(3)))
typedef unsigned short bf16_t;
typedef short bf16x8 __attribute__((ext_vector_type(8)));
typedef short s16x4 __attribute__((ext_vector_type(4)));
typedef float f32x4 __attribute__((ext_vector_type(4)));
typedef unsigned u32x4 __attribute__((ext_vector_type(4)));
typedef unsigned u32x2 __attribute__((ext_vector_type(2)));
constexpr int M = 16384, SEQ = 8192, DM = 1024, INW = 3072, DFF = 2816, NMEM = 256;
constexpr size_t MiB = 1u << 20;
constexpr size_t WS_WIN = 1 * MiB, WS_WOUT = 7 * MiB, WS_WCQ = 9 * MiB, WS_WCKV = 10 * MiB, WS_WCO = 12 * MiB, WS_WGU = 13 * MiB, WS_WDN = 24 * MiB;
constexpr size_t WS_SSQ = 30 * MiB, WS_COS = 34 * MiB, WS_SIN = 35 * MiB, WS_RS1 = 36 * MiB, WS_RS2 = 37 * MiB, WS_SSQC = 38 * MiB, WS_MEMN = 39 * MiB, WS_MEMKV = 40 * MiB, WS_SSQM = 41 * MiB, WS_ML = 42 * MiB;
constexpr size_t WS_INVR = 44 * MiB;
constexpr size_t WS_A = 48 * MiB;
constexpr size_t WS_B = 80 * MiB;
constexpr size_t WS_OG = 80 * MiB;
constexpr size_t WS_QC = 112 * MiB, WS_OC = 128 * MiB;
constexpr size_t WS_BIG = 144 * MiB;
constexpr size_t WS_END = 240 * MiB;
constexpr int LDS_BYTES = 149504, XB_LDS_OFF = 149000;
constexpr int KST = 288, KSK = 272, A_KOFF = 0, A_VOFF = 256 * KSK, A_RKOFF = A_VOFF + 256 * KST;
static_assert(A_RKOFF + 1024 <= LDS_BYTES && pg8::STAGE_BYTES <= LDS_BYTES, "LDS map");

struct Args { const float* in[20]; float* out; unsigned char* ws; float invf[16]; };

__device__ __forceinline__ float wave_sum(float v) {
#pragma unroll
    for (int o = 1; o < 64; o <<= 1) v += __shfl_xor(v, o);
    return v;
}
__device__ __forceinline__ float bf_lo(unsigned w) { return __uint_as_float(w << 16); }
__device__ __forceinline__ float bf_hi(unsigned w) { return __uint_as_float(w & 0xffff0000u); }
__device__ __forceinline__ void unpack8(const u32x4 w, float (&f)[8]) { f[0] = bf_lo(w.x); f[1] = bf_hi(w.x); f[2] = bf_lo(w.y); f[3] = bf_hi(w.y); f[4] = bf_lo(w.z); f[5] = bf_hi(w.z); f[6] = bf_lo(w.w); f[7] = bf_hi(w.w); }

template <int MODE>
__device__ __forceinline__ void tr_item(const float* W, int Nsrc, int Ndst, const float* gain, bf16_t* WT, int ldt, LAS float* scr, int item, int lane) {
    const int nblk = Ndst / 32, kb = item / nblk, nb = item % nblk, k0 = 64 * kb, n0 = 32 * nb;
    const int s0 = MODE == 1 ? (((n0 >> 7) & 1) * DFF + (n0 >> 8) * 128 + (n0 & 127)) : n0;
    const int kr = lane >> 3, ch = lane & 7; f32x4 w[8];
#pragma unroll
    for (int i = 0; i < 8; ++i) w[i] = __builtin_nontemporal_load((const f32x4*)(W + (size_t)(k0 + kr + 8 * i) * Nsrc + s0 + 4 * ch));
#pragma unroll
    for (int i = 0; i < 8; ++i) { const int kk = kr + 8 * i; const float gm = gain ? gain[k0 + kk] : 1.0f;
#pragma unroll
        for (int j = 0; j < 4; ++j) scr[kk * 33 + 4 * ch + j] = w[i][j] * gm; }
    asm volatile("s_waitcnt lgkmcnt(0)" ::: "memory");
    const int c = lane & 7;
#pragma unroll
    for (int j = 0; j < 4; ++j) { const int n = (lane >> 3) + 8 * j; const LAS float* s = scr + (8 * c) * 33 + n;
        u32x4 o; o.x = pg8::cvt_pk_bf16(s[0 * 33], s[1 * 33]); o.y = pg8::cvt_pk_bf16(s[2 * 33], s[3 * 33]); o.z = pg8::cvt_pk_bf16(s[4 * 33], s[5 * 33]); o.w = pg8::cvt_pk_bf16(s[6 * 33], s[7 * 33]);
        *(u32x4*)(WT + (size_t)(n0 + n) * ldt + k0 + 8 * c) = o; }
    asm volatile("s_waitcnt lgkmcnt(0)" ::: "memory");
}
__device__ __forceinline__ void rms_rows2(const float* x0, const float* g0, bf16_t* o0, float* iv0, const float* x1, const float* g1, bf16_t* o1, float* iv1, bool has1, int lane) {
    const f32x4* xr0 = (const f32x4*)x0 + lane; const f32x4* xr1 = (const f32x4*)x1 + lane;
    f32x4 v0[4], v1[4]; float s0 = 0.f, s1 = 0.f;
#pragma unroll
    for (int j = 0; j < 4; ++j) { v0[j] = __builtin_nontemporal_load(xr0 + 64 * j); v1[j] = __builtin_nontemporal_load(xr1 + 64 * j); }
#pragma unroll
    for (int j = 0; j < 4; ++j) { s0 += (v0[j][0] * v0[j][0] + v0[j][1] * v0[j][1]) + (v0[j][2] * v0[j][2] + v0[j][3] * v0[j][3]); s1 += (v1[j][0] * v1[j][0] + v1[j][1] * v1[j][1]) + (v1[j][2] * v1[j][2] + v1[j][3] * v1[j][3]); }
    const float r0 = rsqrtf(wave_sum(s0) * (1.0f / 1024.0f) + 1e-6f), r1 = rsqrtf(wave_sum(s1) * (1.0f / 1024.0f) + 1e-6f);
    if (lane == 0) { if (iv0) *iv0 = 1.0f / r0; if (iv1 && has1) *iv1 = 1.0f / r1; }
    const f32x4* gr0 = (const f32x4*)g0 + lane; const f32x4* gr1 = (const f32x4*)g1 + lane;
    u32x2* p0 = (u32x2*)o0 + lane; u32x2* p1 = (u32x2*)o1 + lane;
#pragma unroll
    for (int j = 0; j < 4; ++j) { const f32x4 y = v0[j] * r0 * gr0[64 * j]; u32x2 w; w.x = pg8::cvt_pk_bf16(y[0], y[1]); w.y = pg8::cvt_pk_bf16(y[2], y[3]); p0[64 * j] = w; }
    if (has1) {
#pragma unroll
        for (int j = 0; j < 4; ++j) { const f32x4 y = v1[j] * r1 * gr1[64 * j]; u32x2 w; w.x = pg8::cvt_pk_bf16(y[0], y[1]); w.y = pg8::cvt_pk_bf16(y[2], y[3]); p1[64 * j] = w; } }
}
__device__ __forceinline__ void sincos_d(float ang, float& s, float& c) {
    const double x = (double)ang; const double kq = rint(x * 0.63661977236758134308);
    const double r = (x - kq * 1.5707963267948966192) - kq * 6.123233995736766036e-17; const double r2 = r * r;
    double sp = -7.6471637318198164759e-13; sp = sp * r2 + 1.6059043836821614599e-10; sp = sp * r2 - 2.5052108385441718775e-08; sp = sp * r2 + 2.7557319223985890653e-06;
    sp = sp * r2 - 1.9841269841269841270e-04; sp = sp * r2 + 8.3333333333333333333e-03; sp = sp * r2 - 1.6666666666666666667e-01; sp = r + r * r2 * sp;
    double cp = 4.7794773323873852974e-14; cp = cp * r2 - 1.1470745597729724714e-11; cp = cp * r2 + 2.0876756987868098979e-09; cp = cp * r2 - 2.7557319223985890653e-07;
    cp = cp * r2 + 2.4801587301587301587e-05; cp = cp * r2 - 1.3888888888888888889e-03; cp = cp * r2 + 4.1666666666666666667e-02; cp = cp * r2 - 0.5; cp = 1.0 + r2 * cp;
    const int q = (int)((long long)kq & 3);
    const double sv = (q & 1) ? cp : sp, cv = (q & 1) ? sp : cp;
    s = (float)((q & 2) ? -sv : sv); c = (float)(((q + 1) & 2) ? -cv : cv);
}

__device__ __forceinline__ s16x4 vtr(LAS unsigned char* p) { return __builtin_bit_cast(s16x4, __builtin_amdgcn_ds_read_tr16_b64_v4i16((LAS s16x4*)p)); }
struct AD {
    const bf16_t* qb; long qstep; const float* sq; long sqstep; const bf16_t* kb; const bf16_t* vb; long kstep; int ks0; const float* sk; long skstep;
    bf16_t* ob; long ostep; float* ml; long mlstep; bool nb0; };
struct KVR { u32x4 kr[8], vr[8]; f32x4 sp; };
__device__ __forceinline__ void attn_load(const AD& d, KVR& R, int tid, bool first) {
    const int c = tid & 15, rr = tid >> 4;
#pragma unroll
    for (int it = 0; it < 4; ++it) { const int sidx = d.ks0 + 128 + rr + 32 * it; const long off = (long)sidx * d.kstep + 8 * c;
        R.kr[it] = *(const u32x4*)(d.kb + off); R.vr[it] = *(const u32x4*)(d.vb + off); }
    if (first) {
#pragma unroll
        for (int it = 4; it < 8; ++it) { int sidx = d.ks0 + rr + 32 * (it - 4); sidx = sidx < 0 ? 0 : sidx; const long off = (long)sidx * d.kstep + 8 * c;
            R.kr[it] = *(const u32x4*)(d.kb + off); R.vr[it] = *(const u32x4*)(d.vb + off); } }
    { int sidx = d.ks0 + ((tid + 128) & 255); sidx = sidx < 0 ? 0 : sidx; R.sp = *(const f32x4*)(d.sk + (long)sidx * d.skstep); }
}
__device__ __forceinline__ void attn_store(LAS unsigned char* lds, const KVR& R, int tid, bool first, int par) {
    const int c = tid & 15, rr = tid >> 4;
#pragma unroll
    for (int it = 0; it < 4; ++it) { const int row = (128 + rr + 32 * it) ^ (128 * par);
        *(LAS u32x4*)(lds + A_KOFF + row * KSK + c * 16) = R.kr[it]; *(LAS u32x4*)(lds + A_VOFF + row * KST + c * 16) = R.vr[it]; }
    if (first) {
#pragma unroll
        for (int it = 4; it < 8; ++it) { const int row = (rr + 32 * (it - 4)) ^ (128 * par);
            *(LAS u32x4*)(lds + A_KOFF + row * KSK + c * 16) = R.kr[it]; *(LAS u32x4*)(lds + A_VOFF + row * KST + c * 16) = R.vr[it]; } }
    if (tid < 128 || (first && tid < 256)) ((LAS float*)(lds + A_RKOFF))[((tid + 128) & 255) ^ (128 * par)] = rsqrtf(((R.sp[0] + R.sp[1]) + (R.sp[2] + R.sp[3])) * (1.0f / 128.0f) + 1e-6f);
}
struct QR { bf16x8 qf[4]; f32x4 sp; };
__device__ __forceinline__ void attn_loadq(const AD& d, QR& Q, int lane, int wave) {
    const int fr = lane & 15, fq = lane >> 4, qi = wave * 16 + fr;
#pragma unroll
    for (int ks = 0; ks < 4; ++ks) Q.qf[ks] = *(const bf16x8*)(d.qb + (long)qi * d.qstep + 32 * ks + 8 * fq);
    Q.sp = *(const f32x4*)(d.sq + (long)qi * d.sqstep);
}
template <int NT, bool MASK>
__device__ __forceinline__ void attn_compute(LAS unsigned char* lds, const AD& d, const QR& Q, int lane, int wave, int par) {
    const int fr = lane & 15, fq = lane >> 4, qi = wave * 16 + fr;
    const float rq2 = rsqrtf(((Q.sp[0] + Q.sp[1]) + (Q.sp[2] + Q.sp[3])) * (1.0f / 128.0f) + 1e-6f) * 1.4426950408889634f;
    const int ts = MASK ? wave : 0;
    f32x4 s[NT];
    {
        bf16x8 kf[4], kn[4];
#pragma unroll
        for (int ks = 0; ks < 4; ++ks) { kf[ks] = *(const LAS bf16x8*)(lds + A_KOFF + (((16 * ts) ^ (128 * par)) + fr) * KSK + (32 * ks + 8 * fq) * 2); kn[ks] = kf[ks]; }
#pragma unroll
        for (int tt = 0; tt < NT; ++tt) {
            if (tt + 1 < NT) {
#pragma unroll
                for (int ks = 0; ks < 4; ++ks) kn[ks] = *(const LAS bf16x8*)(lds + A_KOFF + (((16 * (ts + tt + 1)) ^ (128 * par)) + fr) * KSK + (32 * ks + 8 * fq) * 2); }
            __builtin_amdgcn_sched_barrier(0);
            f32x4 acc = {0.f, 0.f, 0.f, 0.f};
#pragma unroll
            for (int ks = 0; ks < 4; ++ks) acc = __builtin_amdgcn_mfma_f32_16x16x32_bf16(kf[ks], Q.qf[ks], acc, 0, 0, 0);
            s[tt] = acc;
            __builtin_amdgcn_sched_barrier(0);
#pragma unroll
            for (int ks = 0; ks < 4; ++ks) kf[ks] = kn[ks];
        }
    }
    float tm = -3.0e38f;
#pragma unroll
    for (int tt = 0; tt < NT; ++tt) { const f32x4 rk4 = *(const LAS f32x4*)(lds + A_RKOFF + (((16 * (ts + tt)) ^ (128 * par)) + 4 * fq) * 4);
#pragma unroll
        for (int j = 0; j < 4; ++j) { const int kj = 16 * (ts + tt) + 4 * fq + j; float v = s[tt][j] * rk4[j];
            if (MASK) { bool valid;
                if (tt == 0) valid = (kj >= qi) && (!d.nb0 || kj >= 128);
                else if (tt == NT - 1) valid = (kj <= qi + 128);
                else valid = (!d.nb0 || kj >= 128);
                v = valid ? v : -1.0e30f; }
            s[tt][j] = v; tm = fmaxf(tm, v); } }
    tm = fmaxf(tm, __shfl_xor(tm, 16)); tm = fmaxf(tm, __shfl_xor(tm, 32));
    const float mx = tm * rq2, nmx = -mx;
    float l = 0.f;
#pragma unroll
    for (int tt = 0; tt < NT; ++tt)
#pragma unroll
        for (int j = 0; j < 4; ++j) { const float p = __builtin_amdgcn_exp2f(__builtin_fmaf(s[tt][j], rq2, nmx)); s[tt][j] = p; l += p; }
    l = pg8::quad_sum(l);
    f32x4 o[8];
#pragma unroll
    for (int dt = 0; dt < 8; ++dt) o[dt] = (f32x4){0.f, 0.f, 0.f, 0.f};
    const int q4 = fr >> 2, p4 = fr & 3;
    {
        s16x4 cur[8], nxt[8];
#define VSTEP_LOAD(dst, q_) do { const int pr_ = (q_) >> 1, d0_ = 4 * ((q_) & 1), t1_ = (2 * pr_ + 1 < NT) ? 2 * pr_ + 1 : 2 * pr_; \
            LAS unsigned char* v0p = lds + A_VOFF + (((16 * (ts + 2 * pr_)) ^ (128 * par)) + 4 * fq + q4) * KST + 8 * p4; \
            LAS unsigned char* v1p = lds + A_VOFF + (((16 * (ts + t1_)) ^ (128 * par)) + 4 * fq + q4) * KST + 8 * p4; \
            _Pragma("unroll") for (int e = 0; e < 4; ++e) { dst[2 * e] = vtr(v0p + 32 * (d0_ + e)); dst[2 * e + 1] = vtr(v1p + 32 * (d0_ + e)); } } while (0)
        VSTEP_LOAD(cur, 0);
#pragma unroll
        for (int e = 0; e < 8; ++e) nxt[e] = cur[e];
        constexpr int NSTEP = 2 * ((NT + 1) / 2); const f32x4 zero4 = {0.f, 0.f, 0.f, 0.f};
        bf16x8 pf = __builtin_bit_cast(bf16x8, pg8::pack8(s[0], s[1]));
#pragma unroll
        for (int q = 0; q < NSTEP; ++q) {
            if (q + 1 < NSTEP) VSTEP_LOAD(nxt, q + 1);
            if ((q & 1) == 0) pf = __builtin_bit_cast(bf16x8, pg8::pack8(s[q < NT ? q : NT - 1], q + 1 < NT ? s[q + 1 < NT ? q + 1 : NT - 1] : zero4));
            __builtin_amdgcn_sched_barrier(0);
#pragma unroll
            for (int e = 0; e < 4; ++e) { const bf16x8 vf = __builtin_shufflevector(cur[2 * e], cur[2 * e + 1], 0, 1, 2, 3, 4, 5, 6, 7);
                o[4 * (q & 1) + e] = __builtin_amdgcn_mfma_f32_16x16x32_bf16(vf, pf, o[4 * (q & 1) + e], 0, 0, 0); }
            __builtin_amdgcn_sched_barrier(0);
#pragma unroll
            for (int e = 0; e < 8; ++e) cur[e] = nxt[e];
        }
#undef VSTEP_LOAD
    }
    const float inv = 1.0f / l;
#pragma unroll
    for (int dt = 0; dt < 8; ++dt) { u32x2 w; w.x = pg8::cvt_pk_bf16(o[dt][0] * inv, o[dt][1] * inv); w.y = pg8::cvt_pk_bf16(o[dt][2] * inv, o[dt][3] * inv);
        *(u32x2*)(d.ob + (long)qi * d.ostep + 16 * dt + 4 * fq) = w; }
    if (d.ml && fq == 0) { d.ml[(long)qi * d.mlstep] = mx * 0.6931471805599453f; d.ml[(long)qi * d.mlstep + 1] = l; }
}
__device__ __forceinline__ int chain_len(int ch) { return ch < 256 ? 4 : 2; }
__device__ __forceinline__ AD dil_desc(int ch, int i, bf16_t* BIG, float* SSQ, bf16_t* OG, float* ML) {
    int g, b, h, r, nb;
    if (ch < 256) { g = ch >> 7; const int c = ch & 127;
        if (g == 0) { const int combo = c >> 4; b = combo >> 2; h = combo & 3; r = 0; nb = (c & 15) * 4 + i; }
        else { const int combo = c >> 2; b = combo >> 4; h = (combo >> 2) & 3; r = combo & 3; nb = (c & 3) * 4 + i; } }
    else { g = 2; const int c = ch - 256, seq = c >> 1; b = seq >> 6; h = (seq >> 4) & 3; r = seq & 15; nb = (c & 1) * 2 + i; }
    const int dil = 1 << (2 * g);
    const long row0 = (long)b * SEQ + r, qrow = row0 + (long)dil * 128 * nb;
    AD d; d.qb = BIG + qrow * INW + (g * 4 + h) * 128; d.qstep = (long)dil * INW; d.sq = SSQ + qrow * 64 + (g * 4 + h) * 4; d.sqstep = (long)dil * 64;
    d.kb = BIG + row0 * INW + 1536 + h * 128; d.vb = BIG + row0 * INW + 2048 + h * 128; d.kstep = (long)dil * INW; d.ks0 = 128 * (nb - 1); d.sk = SSQ + row0 * 64 + (12 + h) * 4; d.skstep = (long)dil * 64;
    d.ob = OG + (size_t)g * M * 512 + qrow * 512 + h * 128; d.ostep = (long)dil * 512; d.ml = ML + (((size_t)g * M + qrow) * 4 + h) * 2; d.mlstep = (long)dil * 8; d.nb0 = nb == 0; return d;
}
__device__ __forceinline__ AD cross_desc(int u, bf16_t* QC, float* SSQC, bf16_t* MEMKV, float* SSQM, bf16_t* OC) {
    const int h = u & 3, qb = u >> 2, b = qb >> 6; const long qrow = (long)qb * 128;
    AD d; d.qb = QC + qrow * 512 + h * 128; d.qstep = 512; d.sq = SSQC + qrow * 16 + h * 4; d.sqstep = 16;
    d.kb = MEMKV + (size_t)b * NMEM * 1024 + h * 128; d.vb = d.kb + 512; d.kstep = 1024; d.ks0 = 0; d.sk = SSQM + (size_t)b * NMEM * 16 + h * 4; d.skstep = 16;
    d.ob = OC + qrow * 512 + h * 128; d.ostep = 512; d.ml = nullptr; d.mlstep = 0; d.nb0 = false; return d;
}

#define XB_TMO      128
#define XB_XCNT(j)  (256  + 64 * (j))
#define XB_XSUB(j)  (1280 + 64 * (j))
#define XB_XGEN(j)  (2304 + 64 * (j))
#define XB_TOP      3328
#define XB_TOPGEN   3392
#define XCD_BAR_WORDS 3456
#define XB_SPIN_CAP (1u << 18)

__device__ __forceinline__ unsigned xb_ld(unsigned* p)              { return __hip_atomic_load(p, __ATOMIC_RELAXED, __HIP_MEMORY_SCOPE_AGENT); }
__device__ __forceinline__ unsigned xb_add(unsigned* p, unsigned v) { return __hip_atomic_fetch_add(p, v, __ATOMIC_RELAXED, __HIP_MEMORY_SCOPE_AGENT); }
__device__ __forceinline__ unsigned xb_xcc_id() { return (unsigned)__builtin_amdgcn_s_getreg((3 << 11) | 20) & 0xFu; }
#define XB_SPIN(cond, bar) do { unsigned _sp = 0; while (cond) { __builtin_amdgcn_s_sleep(1); \
    if ((++_sp & 255u) == 0u) { if (xb_ld(&(bar)[XB_TMO])) break; if (_sp > XB_SPIN_CAP) { atomicAdd(&(bar)[XB_TMO], 1u); break; } } } } while (0)

struct XcdBarrier {
    unsigned* bar; unsigned x;
    volatile LAS unsigned* st;
};

__device__ __forceinline__ XcdBarrier xcd_barrier_post(unsigned* bar, volatile LAS unsigned* st) {
    XcdBarrier b; b.bar = bar; b.x = xb_xcc_id(); b.st = st;
    if (threadIdx.x == 0) (void)xb_add(&bar[XB_XCNT(b.x)], 1u);
    return b;
}
__device__ __forceinline__ void xcd_barrier_complete(unsigned* bar, unsigned x, unsigned& nloc, unsigned& nx) {
    const unsigned G = gridDim.x * gridDim.y * gridDim.z;
    unsigned sum, cnt, mine, sp = 0u;
    for (;;) {
        sum = 0u; cnt = 0u; mine = 0u;
#pragma unroll
        for (unsigned j = 0; j < 16; ++j) { const unsigned c = xb_ld(&bar[XB_XCNT(j)]); sum += c; cnt += (c > 0u) ? 1u : 0u; mine = (j == x) ? c : mine; }
        if (sum == G) break;
        __builtin_amdgcn_s_sleep(1);
        if ((++sp & 255u) == 0u) { if (xb_ld(&bar[XB_TMO])) break; if (sp > XB_SPIN_CAP) { atomicAdd(&bar[XB_TMO], 1u); break; } }
    }
    nloc = mine > 0u ? mine : 1u; nx = cnt > 0u ? cnt : 1u;
}

__device__ __forceinline__ void xcd_barrier(const XcdBarrier& b) {
    asm volatile("s_waitcnt vmcnt(0)" ::: "memory");
    __syncthreads();
    if (threadIdx.x == 0) {
        unsigned* bar = b.bar;
        __builtin_amdgcn_s_waitcnt(0);
        unsigned nloc = b.st[0], nx = b.st[1];
        if (nloc == 0u) { xcd_barrier_complete(bar, b.x, nloc, nx); b.st[0] = nloc; b.st[1] = nx; }
        const unsigned old = xb_add(&bar[XB_XSUB(b.x)], 1u);
        const unsigned gen = old / nloc;
        if (old + 1u == (gen + 1u) * nloc) {
            __builtin_amdgcn_fence(__ATOMIC_RELEASE, "agent");
            asm volatile("s_waitcnt vmcnt(0)" ::: "memory");
            const unsigned og = xb_add(&bar[XB_TOP], 1u);
            const unsigned tg = og / nx;
            if (og + 1u == (tg + 1u) * nx) xb_add(&bar[XB_TOPGEN], 1u);
            else XB_SPIN(xb_ld(&bar[XB_TOPGEN]) == tg, bar);
            __builtin_amdgcn_fence(__ATOMIC_ACQUIRE, "agent");
            xb_add(&bar[XB_XGEN(b.x)], 1u);
            asm volatile("s_waitcnt vmcnt(0)" ::: "memory");
        } else {
            XB_SPIN(xb_ld(&bar[XB_XGEN(b.x)]) == gen, bar);
            __builtin_amdgcn_fence(__ATOMIC_ACQUIRE, "agent");
            asm volatile("s_waitcnt vmcnt(0)" ::: "memory");
        }
    }
    __syncthreads();
}

#define REP_P0 1
#define REP_P1 1
#define REP_P2 1
#define REP_P2B 1
#define REP_P3 1
#define REP_P4 1
#define REP_P5 1
#define REP_P6 1
#define REP_P7 1
#define REP_P8 1
#define REP_SYNC 1
#define SKEW_MASK 0
__global__ void __launch_bounds__(512) fwd(Args a) {
    extern __shared__ __attribute__((aligned(16))) unsigned char lds_raw[];
    LAS unsigned char* lds = (LAS unsigned char*)lds_raw;
    cg::grid_group grid = cg::this_grid();
    const int wave = __builtin_amdgcn_readfirstlane(threadIdx.x >> 6);
    const int G = gridDim.x, bx = blockIdx.x;
    unsigned char* ws = a.ws;
    volatile LAS unsigned* xst = (volatile LAS unsigned*)(lds + XB_LDS_OFF);
    if (threadIdx.x < 2) xst[threadIdx.x] = 0u;
    __syncthreads();
    const XcdBarrier xbar = xcd_barrier_post((unsigned*)ws, xst);
    if (ws == nullptr) grid.sync();
    const float* x = a.in[0]; const float* mem = a.in[1]; const int* pos = (const int*)a.in[2];
    bf16_t* Win = (bf16_t*)(ws + WS_WIN); bf16_t* Wout = (bf16_t*)(ws + WS_WOUT); bf16_t* Wcq = (bf16_t*)(ws + WS_WCQ); bf16_t* Wckv = (bf16_t*)(ws + WS_WCKV);
    bf16_t* Wco = (bf16_t*)(ws + WS_WCO); bf16_t* Wgu = (bf16_t*)(ws + WS_WGU); bf16_t* Wdn = (bf16_t*)(ws + WS_WDN);
    float* SSQ = (float*)(ws + WS_SSQ); float* COS = (float*)(ws + WS_COS); float* SIN = (float*)(ws + WS_SIN); float* RS1 = (float*)(ws + WS_RS1); float* RS2 = (float*)(ws + WS_RS2);
    float* SSQC = (float*)(ws + WS_SSQC); bf16_t* MEMN = (bf16_t*)(ws + WS_MEMN); bf16_t* MEMKV = (bf16_t*)(ws + WS_MEMKV); float* SSQM = (float*)(ws + WS_SSQM); float* ML = (float*)(ws + WS_ML);
    bf16_t* BA = (bf16_t*)(ws + WS_A); bf16_t* BB = (bf16_t*)(ws + WS_B); bf16_t* OG = (bf16_t*)(ws + WS_OG); bf16_t* QC = (bf16_t*)(ws + WS_QC); bf16_t* OC = (bf16_t*)(ws + WS_OC);
    bf16_t* BIG = (bf16_t*)(ws + WS_BIG); float* INVR = (float*)(ws + WS_INVR);
    bf16_t* MIXB = (bf16_t*)a.out;

#define SEAM(k) do { if (SKEW_MASK != 0 && threadIdx.x == 0) { const unsigned long long t_ = __builtin_amdgcn_s_memrealtime(); \
        atomicAdd((unsigned long long*)(ws + 16384) + 2 * (k), t_); atomicMax((unsigned long long*)(ws + 16384) + 2 * (k) + 1, t_); } \
    for (int rep = 0; rep < REP_SYNC; ++rep) xcd_barrier(xbar); } while (0)
    for (int rep = 0; rep < REP_P0; ++rep)
    {
        const int lane = pg8::fresh_lane(), tid = wave * 64 + lane;
        LAS float* scr = (LAS float*)(lds + wave * 16384);
        const int gw = wave * G + bx, NGW = G * 8;
        constexpr int I_IN = 16 * 96, I_OUT = 8 * 32, I_CQ = 16 * 16, I_CKV = 16 * 32;
        constexpr int NITEMS = I_IN + I_OUT + I_CQ + I_CKV;
        for (int it = gw; it < NITEMS; it += NGW) {
            int r = it;
            if (r < I_IN) { tr_item<0>(a.in[4], INW, INW, nullptr, Win, 1024, scr, r, lane); continue; } r -= I_IN;
            if (r < I_OUT) { tr_item<0>(a.in[9], 1024, 1024, nullptr, Wout, 1024, scr, r, lane); continue; } r -= I_OUT;
            if (r < I_CQ) { tr_item<0>(a.in[12], 512, 512, a.in[10], Wcq, 1024, scr, r, lane); continue; } r -= I_CQ;
            tr_item<0>(a.in[13], 1024, 1024, nullptr, Wckv, 1024, scr, r, lane);
        }
        {
            const float* pw = a.in[7]; const float* psc = a.in[8]; const float* wo = a.in[9];
            LAS float* T = (LAS float*)(lds + 131072);
            for (int item = bx; item < 256; item += G) { const int g = item >> 6, n0 = (item & 63) * 16, e = tid >> 2, c4 = (tid & 3) * 4;
                *(LAS f32x4*)(T + e * 16 + c4) = *(const f32x4*)(wo + (size_t)(512 + g * 128 + e) * 1024 + n0 + c4) * psc[g * 128 + e];
                __syncthreads();
                const int kc = tid >> 2; const float* pr = pw + (size_t)(g * 128 + kc) * 128; f32x4 acc = {0.f, 0.f, 0.f, 0.f};
#pragma unroll 8
                for (int e4 = 0; e4 < 32; ++e4) { const f32x4 pv = *(const f32x4*)(pr + 4 * e4);
#pragma unroll
                    for (int q = 0; q < 4; ++q) acc += *(const LAS f32x4*)(T + (4 * e4 + q) * 16 + c4) * pv[q]; }
#pragma unroll
                for (int j = 0; j < 4; ++j) Wout[(size_t)(n0 + c4 + j) * 1024 + 512 + g * 128 + kc] = (bf16_t)(pg8::cvt_pk_bf16(acc[j], 0.f) & 0xffffu);
                __syncthreads(); }
        }
        for (int m = gw; m < M + 512; m += 2 * NGW) { const int m1 = m + NGW; const bool has1 = m1 < M + 512; const int mb = has1 ? m1 : m;
            const float* xa = m < M ? x + (size_t)m * DM : mem + (size_t)(m - M) * DM; const float* ga = m < M ? a.in[3] : a.in[11]; bf16_t* oa = m < M ? BA + (size_t)m * DM : MEMN + (size_t)(m - M) * DM;
            const float* xb = mb < M ? x + (size_t)mb * DM : mem + (size_t)(mb - M) * DM; const float* gb = mb < M ? a.in[3] : a.in[11]; bf16_t* ob = mb < M ? BA + (size_t)mb * DM : MEMN + (size_t)(mb - M) * DM;
            rms_rows2(xa, ga, oa, m < M ? INVR + m : nullptr, xb, gb, ob, mb < M ? INVR + mb : nullptr, has1, lane);
        }
        for (int idx = bx * 512 + tid; idx < M * 16; idx += G * 512) { const int row = idx >> 4, i = idx & 15;
            const float ang = (float)pos[row] * a.invf[i]; float s, c; sincos_d(ang, s, c); COS[idx] = c; SIN[idx] = s; }
    }
    SEAM(0);

    for (int rep = 0; rep < REP_P1; ++rep)
    {
        pg8::Gemm g{BA, Win, M, INW, 1024}; pg8::StaticOrder S; S.init(M, INW, G, bx);
        pg8::EpiProj E{BIG, SSQ, COS, SIN, a.in[5], a.in[6]};
        pg8::gemm_phase<pg8::EpiProj, pg8::StaticOrder, true, true>(lds, g, S, E, wave);
    }
    SEAM(1);

    for (int rep = 0; rep < REP_P2; ++rep)
    { const int lane = pg8::fresh_lane(), tid = wave * 64 + lane;
      KVR R; QR Qn; int ch = bx, i = 0;
      if (ch < 512) { const AD d = dil_desc(ch, 0, BIG, SSQ, OG, ML); attn_load(d, R, tid, true); attn_loadq(d, Qn, lane, wave); }
      while (ch < 512) {
        const AD d = dil_desc(ch, i, BIG, SSQ, OG, ML); const int par = i & 1;
        attn_store(lds, R, tid, i == 0, par); const QR Q = Qn;
        __syncthreads();
        int ni = i + 1, nch = ch; if (ni == chain_len(ch)) { ni = 0; nch = ch + G; }
        if (nch < 512) { const AD dn = dil_desc(nch, ni, BIG, SSQ, OG, ML); attn_load(dn, R, tid, ni == 0); attn_loadq(dn, Qn, lane, wave); }
        attn_compute<9, true>(lds, d, Q, lane, wave, par);
        __syncthreads();
        ch = nch; i = ni;
      } }
    SEAM(2);

    for (int rep = 0; rep < REP_P2B; ++rep)
    { const int lane = pg8::fresh_lane(), tid = wave * 64 + lane; const long gt = (long)bx * 512 + tid, NTH = (long)G * 512;
      for (long i0 = gt; i0 < (long)M * 64; i0 += 2 * NTH) {
          const long i1 = i0 + NTH; const bool has1 = i1 < (long)M * 64; const long ii[2] = {i0, has1 ? i1 : i0};
          float mm[2][3], ll[2][3]; u32x4 og[2][3];
#pragma unroll
          for (int q = 0; q < 2; ++q) { const int row = (int)(ii[q] >> 6), c = (int)(ii[q] & 63), h = c >> 4;
#pragma unroll
              for (int g = 0; g < 3; ++g) { const float* p = ML + (((size_t)g * M + row) * 4 + h) * 2; mm[q][g] = p[0]; ll[q][g] = p[1]; og[q][g] = *(const u32x4*)(OG + (size_t)g * M * 512 + (size_t)row * 512 + c * 8); } }
#pragma unroll
          for (int q = 0; q < 2; ++q) { const int row = (int)(ii[q] >> 6), c = (int)(ii[q] & 63);
              const float mmax = fmaxf(mm[q][0], fmaxf(mm[q][1], mm[q][2])); float w[3], den = 0.f;
#pragma unroll
              for (int g = 0; g < 3; ++g) { w[g] = __expf(mm[q][g] - mmax) * ll[q][g]; den += w[g]; }
              const float inv = 1.0f / den; float o[8];
#pragma unroll
              for (int j = 0; j < 8; ++j) o[j] = 0.f;
#pragma unroll
              for (int g = 0; g < 3; ++g) { float f[8]; unpack8(og[q][g], f); const float wg = w[g] * inv;
#pragma unroll
                  for (int j = 0; j < 8; ++j) o[j] += wg * f[j]; }
              if (q == 0 || has1) *(u32x4*)(MIXB + (size_t)row * DM + c * 8) = pg8::pack8((f32x4){o[0], o[1], o[2], o[3]}, (f32x4){o[4], o[5], o[6], o[7]}); }
      }
#define POOL_GROUP(GP, W) { const int j_ = (int)(jj & 65535), row0 = (j_ >> 4) * 4, ch = j_ & 15, t0 = row0 & (SEQ - 1);     \
          const bf16_t* up = BIG + (size_t)row0 * INW + 2560 + (GP) * 128 + ch * 8; u32x4 ld[(W) + 3]; \
          _Pragma("unroll") for (int k = 0; k < (W) + 3; ++k) { const int dk = k - ((W) - 1); ld[k] = *(const u32x4*)(up + (long)(t0 + dk >= 0 ? dk : 0) * INW); } \
          float win[8]; \
          _Pragma("unroll") for (int j = 0; j < 8; ++j) win[j] = 0.f; \
          _Pragma("unroll") for (int k = 0; k < (W) - 1; ++k) { float f[8]; unpack8(ld[k], f); const float v = (t0 + k - ((W) - 1) >= 0) ? 1.f : 0.f; \
              _Pragma("unroll") for (int j = 0; j < 8; ++j) win[j] += v * f[j]; } \
          _Pragma("unroll") for (int r = 0; r < 4; ++r) { float fn[8], d[8]; unpack8(ld[(W) - 1 + r], fn); \
              _Pragma("unroll") for (int j = 0; j < 8; ++j) win[j] += fn[j]; \
              const int cnt = (t0 + r + 1) < (W) ? (t0 + r + 1) : (W); const float ic = 1.0f / (float)cnt; \
              _Pragma("unroll") for (int j = 0; j < 8; ++j) d[j] = win[j] * ic - fn[j]; \
              *(u32x4*)(MIXB + (size_t)(row0 + r) * DM + 512 + (GP) * 128 + ch * 8) = pg8::pack8((f32x4){d[0], d[1], d[2], d[3]}, (f32x4){d[4], d[5], d[6], d[7]}); \
              float fo[8]; unpack8(ld[r], fo); const float vo = (t0 + r - ((W) - 1) >= 0) ? 1.f : 0.f; \
              _Pragma("unroll") for (int j = 0; j < 8; ++j) win[j] -= vo * fo[j]; } }
      for (long jj = gt; jj < 4 * 65536; jj += NTH) { const int gsel = (int)(jj >> 16);
          if (gsel == 0) POOL_GROUP(0, 2) else if (gsel == 1) POOL_GROUP(1, 4) else if (gsel == 2) POOL_GROUP(2, 8) else POOL_GROUP(3, 16) }
#undef POOL_GROUP
    }
    SEAM(3);

    for (int rep = 0; rep < REP_P3; ++rep)
    {
        pg8::Gemm g{MIXB, Wout, M, 1024, 1024}; pg8::StaticOrder S; S.init(M, 1024, G, bx);
        pg8::EpiRes E{x, BA, nullptr, BB, RS1, INVR, a.in[3]};
        pg8::gemm_phase<pg8::EpiRes, pg8::StaticOrder, true, true>(lds, g, S, E, wave);
    }
    SEAM(4);

    for (int rep = 0; rep < REP_P4; ++rep)
    {
        const bool split = G >= 136;
        if (!split || bx < G - 8) {
            pg8::Gemm g{BB, Wcq, M, 512, 1024}; pg8::StaticOrder S; S.init(M, 512, split ? G - 8 : G, bx);
            pg8::EpiCq E{RS1, QC, SSQC, a.in[14]};
            pg8::gemm_phase<pg8::EpiCq, pg8::StaticOrder, true, true>(lds, g, S, E, wave);
        }
        if (!split || bx >= G - 8) {
            pg8::Gemm g{MEMN, Wckv, 512, 1024, 1024}; pg8::StaticOrder S; S.init(512, 1024, split ? 8 : G, split ? bx - (G - 8) : bx);
            pg8::EpiKv E{MEMKV, SSQM, a.in[15]};
            pg8::gemm_phase<pg8::EpiKv, pg8::StaticOrder, true, true>(lds, g, S, E, wave);
        }
        {
            const int nidle = split ? G - 8 - 128 : 0; const bool useidle = nidle >= 32;
            if (!useidle || (bx >= 128 && bx < G - 8)) {
                const int lane = pg8::fresh_lane(); LAS float* scr = (LAS float*)(lds + wave * 16384);
                const int gw = (useidle ? bx - 128 : bx) * 8 + wave, NGW = (useidle ? nidle : G) * 8;
                constexpr int I_CO = 8 * 32, I_GU = 16 * 176, I_DN = 44 * 32;
                for (int it = gw; it < I_CO + I_GU + I_DN; it += NGW) {
                    int r = it;
                    if (r < I_CO) { tr_item<0>(a.in[16], 1024, 1024, nullptr, Wco, 512, scr, r, lane); continue; } r -= I_CO;
                    if (r < I_GU) { tr_item<1>(a.in[18], 2 * DFF, 2 * DFF, a.in[17], Wgu, 1024, scr, r, lane); continue; } r -= I_GU;
                    tr_item<0>(a.in[19], 1024, 1024, nullptr, Wdn, DFF, scr, r, lane);
                }
            }
        }
    }
    SEAM(5);

    for (int rep = 0; rep < REP_P5; ++rep)
    { const int lane = pg8::fresh_lane(), tid = wave * 64 + lane;
      for (int pr = bx; pr < 256; pr += G) {
        const int h = pr & 3, b = (pr >> 2) & 1, qb0 = b * 64 + (pr >> 3) * 2;
        const AD d0 = cross_desc(qb0 * 4 + h, QC, SSQC, MEMKV, SSQM, OC), d1 = cross_desc((qb0 + 1) * 4 + h, QC, SSQC, MEMKV, SSQM, OC);
        { KVR R; attn_load(d0, R, tid, true); attn_store(lds, R, tid, true, 0); }
        QR Q0, Q1; attn_loadq(d0, Q0, lane, wave); attn_loadq(d1, Q1, lane, wave);
        __syncthreads();
        attn_compute<16, false>(lds, d0, Q0, lane, wave, 0);
        attn_compute<16, false>(lds, d1, Q1, lane, wave, 0);
        __syncthreads();
      } }
    SEAM(6);

    for (int rep = 0; rep < REP_P6; ++rep)
    {
        pg8::Gemm g{OC, Wco, M, 1024, 512}; pg8::StaticOrder S; S.init(M, 1024, G, bx);
        pg8::EpiRes E{nullptr, BB, nullptr, BA, RS2, nullptr, nullptr};
        pg8::gemm_phase<pg8::EpiRes, pg8::StaticOrder, true, true>(lds, g, S, E, wave);
    }
    SEAM(7);

    for (int rep = 0; rep < REP_P7; ++rep)
    {
        pg8::Gemm g{BA, Wgu, M, 2 * DFF, 1024}; pg8::StaticOrder S; S.init(M, 2 * DFF, G, bx);
        pg8::EpiSwiglu E{RS2, BIG};
        pg8::gemm_phase<pg8::EpiSwiglu, pg8::StaticOrder, true, true>(lds, g, S, E, wave);
    }
    SEAM(8);

    for (int rep = 0; rep < REP_P8; ++rep)
    {
        pg8::Gemm g{BIG, Wdn, M, 1024, DFF}; pg8::StaticOrder S; S.init(M, 1024, G, bx);
        pg8::EpiRes E{nullptr, BA, a.out, nullptr, nullptr, nullptr, nullptr};
        pg8::gemm_phase<pg8::EpiRes, pg8::StaticOrder, true, true>(lds, g, S, E, wave);
    }
    if (SKEW_MASK != 0) {
        if (threadIdx.x == 0) { const unsigned long long t_ = __builtin_amdgcn_s_memrealtime(); atomicAdd((unsigned long long*)(ws + 16384) + 2 * 9, t_); atomicMax((unsigned long long*)(ws + 16384) + 2 * 9 + 1, t_); }
        xcd_barrier(xbar);
        if (bx == 0 && threadIdx.x == 0) { unsigned long long loss = 0;
            for (int k = 0; k < 10; ++k) if ((SKEW_MASK >> k) & 1) { const unsigned long long sm = __hip_atomic_load((unsigned long long*)(ws + 16384) + 2 * k, __ATOMIC_RELAXED, __HIP_MEMORY_SCOPE_AGENT), mx = __hip_atomic_load((unsigned long long*)(ws + 16384) + 2 * k + 1, __ATOMIC_RELAXED, __HIP_MEMORY_SCOPE_AGENT); loss += mx - sm / (unsigned long long)G; }
            const unsigned long long t0_ = __builtin_amdgcn_s_memrealtime(); while (__builtin_amdgcn_s_memrealtime() - t0_ < loss) __builtin_amdgcn_s_sleep(8); }
    }
}

extern "C" void kernel_launch(void* const* d_in, const int* in_sizes, int n_in, void* d_out, int out_size, void* d_ws, size_t ws_size, hipStream_t stream) {
    static int grid_blocks = 0;
    if (grid_blocks == 0) {
        if (n_in != 20 || ws_size < WS_END) { fprintf(stderr, "kernel_launch: unexpected inputs (n_in %d, ws %zu)\n", n_in, ws_size); grid_blocks = -1; return; }
        int dev = 0, cus = 0, per_cu = 0;
        hipGetDevice(&dev); hipDeviceGetAttribute(&cus, hipDeviceAttributeMultiprocessorCount, dev);
        if (hipFuncSetAttribute((const void*)fwd, hipFuncAttributeMaxDynamicSharedMemorySize, LDS_BYTES) != hipSuccess) { fprintf(stderr, "kernel_launch: hipFuncSetAttribute failed\n"); }
        if (hipOccupancyMaxActiveBlocksPerMultiprocessor(&per_cu, (const void*)fwd, 512, LDS_BYTES) != hipSuccess || per_cu < 1) { fprintf(stderr, "kernel_launch: occupancy query says %d\n", per_cu); per_cu = 1; }
        (void)hipGetLastError();
        grid_blocks = cus * 1;
        if (grid_blocks < 1) grid_blocks = 1;
    }
    if (grid_blocks < 0) return;
    if (hipMemsetAsync(d_ws, 0, 32768, stream) != hipSuccess) { fprintf(stderr, "kernel_launch: memset failed\n"); return; }
    Args a{};
    for (int i = 0; i < 20; ++i) a.in[i] = (const float*)d_in[i];
    a.out = (float*)d_out; a.ws = (unsigned char*)d_ws;
    for (int i = 0; i < 16; ++i) a.invf[i] = (float)std::pow(500000.0, -(double)i / 16.0);
    void* args[] = {&a};
    hipError_t e = hipLaunchCooperativeKernel((const void*)fwd, dim3(grid_blocks), dim3(512), args, LDS_BYTES, stream);
    if (e != hipSuccess) fprintf(stderr, "cooperative launch failed: %s (grid %d)\n", hipGetErrorString(e), grid_blocks);
}
```

```cpp
#include <hip/hip_runtime.h>
#include <hip/hip_cooperative_groups.h>
#include <cstdio>
#include <cstdint>
#include <cmath>
namespace cg = cooperative_groups;
namespace pg8 {
#define PG8_LAS __attribute__((address_space(3)))
typedef unsigned short bf16_t;
typedef short bf16x8 __attribute__((ext_vector_type(8)));
typedef float f32x4 __attribute__((ext_vector_type(4)));
typedef unsigned u32x4 __attribute__((ext_vector_type(4)));
constexpr int BM = 256, BK = 64, HALF = 128, HTB = HALF * BK * 2  , STAGE_BYTES = 8 * HTB, NXCD = 8, WGM = 8;

__host__ __device__ __forceinline__ int lds_byte(int r, int c) { const int st = (r >> 4) * 2 + (c >> 5), rr = r & 15, cc = c & 31, ob = rr * 64 + cc * 2; return st * 1024 + (ob ^ (((ob >> 9) & 1) << 5)); }
__host__ __device__ __forceinline__ void stage_rc(int b, int& R, int& C) { const int st = b / 1024, sb = b % 1024, swz = sb ^ (((sb >> 9) & 1) << 5); R = (st >> 1) * 16 + swz / 64; C = (st & 1) * 32 + (swz % 64) / 2; }
__host__ __device__ __forceinline__ int perm32(int rho) { const int n = rho >> 4, i = rho & 15; return 8 * (i >> 2) + 4 * n + (i & 3); }

struct Unit { int pm, pn; };
struct Gemm { const bf16_t* A; const bf16_t* Bt; int M, N, K; };

struct StaticOrder {
    int nM, nN, nwg, G, c;
    __host__ __device__ __forceinline__ void init(int M, int N, int G_, int c_) { nM = M / BM; nN = N / BM; nwg = nM * nN; G = G_; c = c_; }
    __host__ __device__ __forceinline__ bool next(int i, Unit& u) const {
        const long L = (long)i * G + c; if (L >= nwg) return false;
        int wgid = (int)L; { const int q = nwg / NXCD, r = nwg % NXCD, xcd = wgid % NXCD, off = wgid / NXCD; wgid = (xcd < r ? xcd * (q + 1) : r * (q + 1) + (xcd - r) * q) + off; }
        const int nig = WGM * nN, gid = wgid / nig, fm = gid * WGM, gsz = (nM - fm) < WGM ? (nM - fm) : WGM;
        u.pm = fm + ((wgid % nig) % gsz); u.pn = (wgid % nig) / gsz; return true;
    }
    __device__ __forceinline__ void a_ready(const Unit&) const {}
    __device__ __forceinline__ void done(const Unit&) const {}
};

__device__ __forceinline__ unsigned cvt_pk_bf16(float lo, float hi) { unsigned r; asm volatile("v_cvt_pk_bf16_f32 %0, %1, %2" : "=v"(r) : "v"(lo), "v"(hi)); return r; }
typedef float f32x2 __attribute__((ext_vector_type(2)));
__device__ __forceinline__ int fresh_lane() { int l; asm volatile("v_mbcnt_lo_u32_b32 %0, -1, 0\n\tv_mbcnt_hi_u32_b32 %0, -1, %0" : "=v"(l)); return l; }
template <class Epi, class Sched, bool ALIGN_EPI = false, bool SP2 = false>
__device__ __forceinline__ void gemm_phase(PG8_LAS unsigned char* lds, const Gemm g, const Sched& S, const Epi& E, const int wid) {
    const int lane = fresh_lane(), tid = wid * 64 + lane, wr = wid >> 2, wc = wid & 3, fr = lane & 15, fq = lane >> 4;
    const int K = g.K, nt = K / BK;
    unsigned voffA[2], voffB[2];
#pragma unroll
    for (int i = 0; i < 2; ++i) { int R, C; stage_rc(tid * 16 + i * 8192, R, C); const int Rb = Epi::PERM ? ((R & ~31) + perm32(R & 31)) : R;
        voffA[i] = (unsigned)(R * K + C) * 2u; voffB[i] = (unsigned)(Rb * K + C) * 2u; }
    const size_t kstep = (size_t)(BK * 2);
    const size_t hstep = (size_t)HALF * K * 2;
    const size_t tstep = 2 * hstep;
    const unsigned ldsw = (unsigned)wid * 1024u;
    const int aoff = lds_byte(wr * 64 + fr, fq * 8), boff = lds_byte(wc * 32 + fr, fq * 8);
#define PG8_SA(b, h) (((b) * 2 + (h)) * HTB)
#define PG8_SB(b, h) ((4 + (b) * 2 + (h)) * HTB)
#define PG8_STAGE(bufoff, gbase, voff) do { _Pragma("unroll") for (int _i = 0; _i < 2; ++_i) \
        __builtin_amdgcn_global_load_lds((const unsigned*)((const char*)(gbase) + (voff)[_i]), (PG8_LAS unsigned*)(lds + (bufoff) + ldsw + _i * 8192), 16, 0, 0); } while (0)
#define PG8_LDA(dst, b, h) do { _Pragma("unroll") for (int m = 0; m < 4; ++m) _Pragma("unroll") for (int k = 0; k < 2; ++k) dst[m][k] = *(const PG8_LAS bf16x8*)(lds + PG8_SA(b, h) + aoff + m * 2048 + k * 1024); } while (0)
#define PG8_LDB(dst, b, h) do { _Pragma("unroll") for (int n = 0; n < 2; ++n) _Pragma("unroll") for (int k = 0; k < 2; ++k) dst[n][k] = *(const PG8_LAS bf16x8*)(lds + PG8_SB(b, h) + boff + n * 2048 + k * 1024); } while (0)
#define PG8_MMA(ai, bj, At, Bt) do { __builtin_amdgcn_s_setprio(1); _Pragma("unroll") for (int m = 0; m < 4; ++m) _Pragma("unroll") for (int n = 0; n < 2; ++n) _Pragma("unroll") for (int k = 0; k < 2; ++k) \
        acc[ai][bj][m][n] = __builtin_amdgcn_mfma_f32_16x16x32_bf16(Bt[n][k], At[m][k], acc[ai][bj][m][n], 0, 0, 0); __builtin_amdgcn_s_setprio(0); } while (0)
#define PG8_WAIT_V(n) asm volatile("s_waitcnt vmcnt(" #n ")" ::: "memory")
#define PG8_WAIT_L(n) asm volatile("s_waitcnt lgkmcnt(" #n ")" ::: "memory")
#define PG8_BAR __builtin_amdgcn_s_barrier()
#define PG8_SCHED __builtin_amdgcn_sched_barrier(0)
    Unit cur, nxt; int ui = 0;
    if (!S.next(0, cur)) return;
    f32x4 acc[2][2][4][2];
#pragma unroll
    for (int a = 0; a < 2; ++a)
#pragma unroll
        for (int b = 0; b < 2; ++b)
#pragma unroll
            for (int m = 0; m < 4; ++m)
#pragma unroll
                for (int n = 0; n < 2; ++n) acc[a][b][m][n] = (f32x4){0.f, 0.f, 0.f, 0.f};
    bf16x8 At[4][2], B0[2][2], B1[2][2];
    const char* cA = (const char*)g.A + (size_t)cur.pm * tstep; const char* cB = (const char*)g.Bt + (size_t)cur.pn * tstep;
    S.a_ready(cur);
    if constexpr (SP2) {
        PG8_STAGE(PG8_SB(0, 0), cB, voffB); PG8_STAGE(PG8_SB(0, 1), cB + hstep, voffB); PG8_STAGE(PG8_SA(0, 0), cA, voffA); PG8_STAGE(PG8_SA(0, 1), cA + hstep, voffA);
        if (wr == 1) PG8_BAR;
        PG8_WAIT_V(2); PG8_BAR;
        PG8_STAGE(PG8_SB(1, 0), cB + kstep, voffB); PG8_STAGE(PG8_SA(1, 0), cA + kstep, voffA); PG8_STAGE(PG8_SB(1, 1), cB + hstep + kstep, voffB);
        PG8_WAIT_V(6); PG8_BAR;
    } else {
        PG8_STAGE(PG8_SB(0, 0), cB, voffB); PG8_STAGE(PG8_SA(0, 0), cA, voffA); PG8_STAGE(PG8_SB(0, 1), cB + hstep, voffB); PG8_STAGE(PG8_SA(0, 1), cA + hstep, voffA);
        if (wr == 1) PG8_BAR;
        PG8_WAIT_V(4); PG8_BAR;
        PG8_STAGE(PG8_SB(1, 0), cB + kstep, voffB); PG8_STAGE(PG8_SA(1, 0), cA + kstep, voffA); PG8_STAGE(PG8_SB(1, 1), cB + hstep + kstep, voffB);
        PG8_WAIT_V(6); PG8_BAR;
    }
    for (;;) {
        const bool has_next = S.next(ui + 1, nxt);
        const char* nA = has_next ? (const char*)g.A + (size_t)nxt.pm * tstep : cA; const char* nB = has_next ? (const char*)g.Bt + (size_t)nxt.pn * tstep : cB;
        for (int t = 0; t < nt; t += 2) {
            const bool last = (t == nt - 2);
            const char* a1 = cA + (size_t)(t + 1) * kstep;
            const char* a2 = last ? nA : cA + (size_t)(t + 2) * kstep; const char* b2 = last ? nB : cB + (size_t)(t + 2) * kstep;
            const char* a3 = a2 + kstep; const char* b3 = b2 + kstep;
            if (last && has_next) S.a_ready(nxt);
            if constexpr (SP2) {
            PG8_LDB(B0, 0, 0); PG8_LDB(B1, 0, 1); PG8_SCHED; PG8_LDA(At, 0, 0); PG8_STAGE(PG8_SA(1, 1), a1 + hstep, voffA);
            PG8_WAIT_V(8); PG8_WAIT_L(0); PG8_BAR; PG8_MMA(0, 0, At, B0); PG8_MMA(0, 1, At, B1); PG8_BAR; PG8_SCHED;
            PG8_LDA(At, 0, 1); PG8_STAGE(PG8_SB(0, 0), b2, voffB); PG8_STAGE(PG8_SB(0, 1), b2 + hstep, voffB); PG8_STAGE(PG8_SA(0, 0), a2, voffA);
            PG8_WAIT_V(8); PG8_WAIT_L(0); PG8_BAR; PG8_MMA(1, 0, At, B0); PG8_MMA(1, 1, At, B1); PG8_BAR; PG8_SCHED;
            PG8_LDB(B0, 1, 0); PG8_LDB(B1, 1, 1); PG8_SCHED; PG8_LDA(At, 1, 0); PG8_STAGE(PG8_SA(0, 1), a2 + hstep, voffA);
            PG8_WAIT_V(8); PG8_WAIT_L(0); PG8_BAR; PG8_MMA(0, 0, At, B0); PG8_MMA(0, 1, At, B1); PG8_BAR; PG8_SCHED;
            PG8_LDA(At, 1, 1); PG8_STAGE(PG8_SB(1, 0), b3, voffB); PG8_STAGE(PG8_SB(1, 1), b3 + hstep, voffB); PG8_STAGE(PG8_SA(1, 0), a3, voffA);
            PG8_WAIT_V(8); PG8_WAIT_L(0); PG8_BAR; PG8_MMA(1, 0, At, B0); PG8_MMA(1, 1, At, B1); PG8_BAR; PG8_SCHED;
            } else {
            PG8_LDB(B0, 0, 0); PG8_SCHED; PG8_LDA(At, 0, 0); PG8_STAGE(PG8_SA(1, 1), a1 + hstep, voffA);
            PG8_WAIT_L(8); PG8_BAR; PG8_WAIT_L(0); PG8_MMA(0, 0, At, B0); PG8_BAR; PG8_SCHED;
            PG8_LDB(B1, 0, 1); PG8_STAGE(PG8_SB(0, 0), b2, voffB);
            PG8_BAR; PG8_WAIT_L(0); PG8_MMA(0, 1, At, B1); PG8_BAR;
            PG8_LDA(At, 0, 1); PG8_STAGE(PG8_SA(0, 0), a2, voffA);
            PG8_BAR; PG8_WAIT_L(0); PG8_MMA(1, 0, At, B0); PG8_BAR; PG8_SCHED;
            PG8_STAGE(PG8_SB(0, 1), b2 + hstep, voffB);
            PG8_WAIT_V(6); PG8_BAR; PG8_MMA(1, 1, At, B1); PG8_BAR;
            PG8_LDB(B0, 1, 0); PG8_SCHED; PG8_LDA(At, 1, 0); PG8_STAGE(PG8_SA(0, 1), a2 + hstep, voffA);
            PG8_WAIT_L(8); PG8_BAR; PG8_WAIT_L(0); PG8_MMA(0, 0, At, B0); PG8_BAR; PG8_SCHED;
            PG8_LDB(B1, 1, 1); PG8_STAGE(PG8_SB(1, 0), b3, voffB);
            PG8_BAR; PG8_WAIT_L(0); PG8_MMA(0, 1, At, B1); PG8_BAR;
            PG8_LDA(At, 1, 1); PG8_STAGE(PG8_SA(1, 0), a3, voffA);
            PG8_BAR; PG8_WAIT_L(0); PG8_MMA(1, 0, At, B0); PG8_BAR; PG8_SCHED;
            PG8_STAGE(PG8_SB(1, 1), b3 + hstep, voffB);
            PG8_WAIT_V(6); PG8_BAR; PG8_MMA(1, 1, At, B1); PG8_BAR;
            }
        }
        if constexpr (ALIGN_EPI) { if (wr == 0) PG8_BAR; }
        if constexpr (!Epi::AFTER_DRAIN) { E(acc, cur, wr, wc, fr, fq); S.done(cur); }
        if (!has_next) break;
#pragma unroll
        for (int a = 0; a < 2; ++a)
#pragma unroll
            for (int b = 0; b < 2; ++b)
#pragma unroll
                for (int m = 0; m < 4; ++m)
#pragma unroll
                    for (int n = 0; n < 2; ++n) acc[a][b][m][n] = (f32x4){0.f, 0.f, 0.f, 0.f};
        cur = nxt; cA = nA; cB = nB; ++ui;
        if constexpr (ALIGN_EPI) { if (wr == 1) PG8_BAR; }
    }
    PG8_WAIT_V(0);
    if constexpr (!ALIGN_EPI) { if (wr == 0) PG8_BAR; }
    PG8_BAR;
    if constexpr (Epi::AFTER_DRAIN) { E.fused(acc, cur, wr, wc, fr, fq, lds, wid, lane); S.done(cur); }
#undef PG8_SA
#undef PG8_SB
#undef PG8_STAGE
#undef PG8_LDA
#undef PG8_LDB
#undef PG8_MMA
#undef PG8_WAIT_V
#undef PG8_WAIT_L
#undef PG8_BAR
#undef PG8_SCHED
}
}

namespace pg8 {
__device__ __forceinline__ u32x4 pack8(const f32x4 v0, const f32x4 v1) {
    u32x4 w; w.x = cvt_pk_bf16(v0[0], v0[1]); w.y = cvt_pk_bf16(v0[2], v0[3]); w.z = cvt_pk_bf16(v1[0], v1[1]); w.w = cvt_pk_bf16(v1[2], v1[3]); return w; }
__device__ __forceinline__ float quad_sum(float s) { s += __shfl_xor(s, 16); s += __shfl_xor(s, 32); return s; }
__device__ __forceinline__ float sq8(const f32x4 a, const f32x4 b) { return (a[0] * a[0] + a[1] * a[1]) + (a[2] * a[2] + a[3] * a[3]) + (b[0] * b[0] + b[1] * b[1]) + (b[2] * b[2] + b[3] * b[3]); }
__device__ __forceinline__ f32x4 rs_quarter(const float* rs, int row, int fq) { return *(const f32x4*)(rs + (size_t)row * 16 + 4 * fq); }
__device__ __forceinline__ float rstd_from_quarter(const f32x4 a) { return rsqrtf(quad_sum((a[0] + a[1]) + (a[2] + a[3])) * (1.0f / 1024.0f) + 1e-6f); }

struct EpiProj {
    static constexpr bool PERM = true, AFTER_DRAIN = false;
    bf16_t* O; float* ssq; const float* cosT; const float* sinT; const float* gq; const float* gk;
    __device__ __forceinline__ void operator()(const f32x4 (&acc)[2][2][4][2], const Unit& u, int wr, int wc, int fr, int fq) const {
        const int pn = u.pn, row0 = u.pm * BM + wr * 64 + fr, cw = wc * 32 + 8 * fq;
        if (pn >= 8) {
#pragma unroll
            for (int ai = 0; ai < 2; ++ai)
#pragma unroll
                for (int m = 0; m < 4; ++m) { bf16_t* rowp = O + (size_t)(row0 + ai * HALF + m * 16) * 3072 + pn * BM + cw;
#pragma unroll
                    for (int bj = 0; bj < 2; ++bj) *(u32x4*)(rowp + bj * HALF) = pack8(acc[ai][bj][m][0], acc[ai][bj][m][1]); }
        } else {
            const bool isq = pn < 6; const float* g = isq ? gq : gk;
            const f32x4 g0 = *(const f32x4*)(g + cw), g1 = *(const f32x4*)(g + cw + 4);
            const float sc = isq ? 0.08838834764831845f : 1.0f;
            const float sg = (fq < 2) ? -1.0f : 1.0f;
#pragma unroll
            for (int ai = 0; ai < 2; ++ai)
#pragma unroll
                for (int m = 0; m < 4; ++m) { const int row = row0 + ai * HALF + m * 16;
                    f32x4 c0 = {0.f, 0.f, 0.f, 0.f}, c1 = c0, s0 = c0, s1 = c0;
                    if (wc == 0) { const float* cp = cosT + (size_t)row * 16 + 8 * (fq & 1); const float* sp = sinT + (size_t)row * 16 + 8 * (fq & 1);
                        c0 = *(const f32x4*)cp; c1 = *(const f32x4*)(cp + 4); s0 = *(const f32x4*)sp; s1 = *(const f32x4*)(sp + 4); }
                    bf16_t* rowp = O + (size_t)row * 3072 + pn * BM + cw;
#pragma unroll
                    for (int bj = 0; bj < 2; ++bj) { f32x4 v0 = acc[ai][bj][m][0], v1 = acc[ai][bj][m][1];
                        const float ss = quad_sum(sq8(v0, v1));
                        if (fq == 0) ssq[(size_t)row * 64 + (pn * 2 + bj) * 4 + wc] = ss;
                        v0 = v0 * g0; v1 = v1 * g1;
                        if (wc == 0) { f32x4 p0, p1;
#pragma unroll
                            for (int j = 0; j < 4; ++j) { p0[j] = __shfl_xor(v0[j], 32); p1[j] = __shfl_xor(v1[j], 32); }
                            v0 = v0 * c0 + (p0 * s0) * sg; v1 = v1 * c1 + (p1 * s1) * sg; }
                        v0 = v0 * sc; v1 = v1 * sc;
                        *(u32x4*)(rowp + bj * HALF) = pack8(v0, v1); } }
        }
    }
};
__device__ __forceinline__ void bf8_to_f32(const u32x4 w, f32x4& b0, f32x4& b1) {
    b0 = (f32x4){__uint_as_float(w.x << 16), __uint_as_float(w.x & 0xffff0000u), __uint_as_float(w.y << 16), __uint_as_float(w.y & 0xffff0000u)};
    b1 = (f32x4){__uint_as_float(w.z << 16), __uint_as_float(w.z & 0xffff0000u), __uint_as_float(w.w << 16), __uint_as_float(w.w & 0xffff0000u)}; }
struct EpiRes {
    static constexpr bool PERM = true, AFTER_DRAIN = false;
    const float* baseF; const bf16_t* baseB; float* outF; bf16_t* outB; float* rs; const float* invr; const float* gcol;
    __device__ __forceinline__ void operator()(const f32x4 (&acc)[2][2][4][2], const Unit& u, int wr, int wc, int fr, int fq) const {
        const int row0 = u.pm * BM + wr * 64 + fr, col0 = u.pn * BM + wc * 32 + 8 * fq;
#pragma unroll
        for (int ai = 0; ai < 2; ++ai) {
            f32x4 b[4][2][2];
            if (invr) {
                f32x4 gi[2][2]; bool bad[2];
#pragma unroll
                for (int bj = 0; bj < 2; ++bj) { const f32x4 g0 = *(const f32x4*)(gcol + col0 + bj * HALF), g1 = *(const f32x4*)(gcol + col0 + bj * HALF + 4); float mn = 3.0e38f;
#pragma unroll
                    for (int j = 0; j < 4; ++j) { mn = fminf(mn, fminf(fabsf(g0[j]), fabsf(g1[j]))); gi[bj][0][j] = 1.0f / g0[j]; gi[bj][1][j] = 1.0f / g1[j]; }
                    bad[bj] = !(mn > 0.015625f); }
                u32x4 w[4][2]; float ir[4];
#pragma unroll
                for (int m = 0; m < 4; ++m) { ir[m] = invr[row0 + ai * HALF + m * 16];
#pragma unroll
                    for (int bj = 0; bj < 2; ++bj) w[m][bj] = *(const u32x4*)(baseB + (size_t)(row0 + ai * HALF + m * 16) * 1024 + col0 + bj * HALF); }
#pragma unroll
                for (int m = 0; m < 4; ++m)
#pragma unroll
                    for (int bj = 0; bj < 2; ++bj) { bf8_to_f32(w[m][bj], b[m][bj][0], b[m][bj][1]); b[m][bj][0] = b[m][bj][0] * (gi[bj][0] * ir[m]); b[m][bj][1] = b[m][bj][1] * (gi[bj][1] * ir[m]);
                        if (bad[bj]) { const float* bp = baseF + (size_t)(row0 + ai * HALF + m * 16) * 1024 + col0 + bj * HALF; b[m][bj][0] = *(const f32x4*)bp; b[m][bj][1] = *(const f32x4*)(bp + 4); } }
            } else if (baseF) {
#pragma unroll
                for (int m = 0; m < 4; ++m)
#pragma unroll
                    for (int bj = 0; bj < 2; ++bj) { const float* bp = baseF + (size_t)(row0 + ai * HALF + m * 16) * 1024 + col0 + bj * HALF; b[m][bj][0] = *(const f32x4*)bp; b[m][bj][1] = *(const f32x4*)(bp + 4); }
            } else { u32x4 w[4][2];
#pragma unroll
                for (int m = 0; m < 4; ++m)
#pragma unroll
                    for (int bj = 0; bj < 2; ++bj) w[m][bj] = *(const u32x4*)(baseB + (size_t)(row0 + ai * HALF + m * 16) * 1024 + col0 + bj * HALF);
#pragma unroll
                for (int m = 0; m < 4; ++m)
#pragma unroll
                    for (int bj = 0; bj < 2; ++bj) bf8_to_f32(w[m][bj], b[m][bj][0], b[m][bj][1]); }
#pragma unroll
            for (int m = 0; m < 4; ++m) { const int row = row0 + ai * HALF + m * 16; const size_t off = (size_t)row * 1024 + col0; float ss = 0.f;
#pragma unroll
                for (int bj = 0; bj < 2; ++bj) { const f32x4 v0 = acc[ai][bj][m][0] + b[m][bj][0], v1 = acc[ai][bj][m][1] + b[m][bj][1];
                    if (outF) { __builtin_nontemporal_store(v0, (f32x4*)(outF + off + bj * HALF)); __builtin_nontemporal_store(v1, (f32x4*)(outF + off + bj * HALF + 4)); }
                    if (outB) *(u32x4*)(outB + off + bj * HALF) = pack8(v0, v1);
                    ss += sq8(v0, v1); }
                if (rs) { ss = quad_sum(ss); if (fq == 0) rs[(size_t)row * 16 + u.pn * 4 + wc] = ss; } }
        }
    }
};
struct EpiCq {
    static constexpr bool PERM = true, AFTER_DRAIN = false;
    const float* rs1; bf16_t* O; float* ssqc; const float* g;
    __device__ __forceinline__ void operator()(const f32x4 (&acc)[2][2][4][2], const Unit& u, int wr, int wc, int fr, int fq) const {
        const int row0 = u.pm * BM + wr * 64 + fr, cw = wc * 32 + 8 * fq;
        const f32x4 g0 = *(const f32x4*)(g + cw) * 0.08838834764831845f, g1 = *(const f32x4*)(g + cw + 4) * 0.08838834764831845f;
        f32x4 rq[2][4];
#pragma unroll
        for (int ai = 0; ai < 2; ++ai)
#pragma unroll
            for (int m = 0; m < 4; ++m) rq[ai][m] = rs_quarter(rs1, row0 + ai * HALF + m * 16, fq);
#pragma unroll
        for (int ai = 0; ai < 2; ++ai)
#pragma unroll
            for (int m = 0; m < 4; ++m) { const int row = row0 + ai * HALF + m * 16; const float rstd = rstd_from_quarter(rq[ai][m]);
                bf16_t* rowp = O + (size_t)row * 512 + u.pn * BM + cw;
#pragma unroll
                for (int bj = 0; bj < 2; ++bj) { f32x4 v0 = acc[ai][bj][m][0] * rstd, v1 = acc[ai][bj][m][1] * rstd;
                    const float ss = quad_sum(sq8(v0, v1));
                    if (fq == 0) ssqc[(size_t)row * 16 + (u.pn * 2 + bj) * 4 + wc] = ss;
                    *(u32x4*)(rowp + bj * HALF) = pack8(v0 * g0, v1 * g1); } }
    }
};
struct EpiKv {
    static constexpr bool PERM = true, AFTER_DRAIN = false;
    bf16_t* O; float* ssqm; const float* g;
    __device__ __forceinline__ void operator()(const f32x4 (&acc)[2][2][4][2], const Unit& u, int wr, int wc, int fr, int fq) const {
        const int row0 = u.pm * BM + wr * 64 + fr, cw = wc * 32 + 8 * fq; const bool isk = u.pn < 2;
        f32x4 g0 = {1.f, 1.f, 1.f, 1.f}, g1 = g0;
        if (isk) { g0 = *(const f32x4*)(g + cw); g1 = *(const f32x4*)(g + cw + 4); }
#pragma unroll
        for (int ai = 0; ai < 2; ++ai)
#pragma unroll
            for (int m = 0; m < 4; ++m) { const int row = row0 + ai * HALF + m * 16; bf16_t* rowp = O + (size_t)row * 1024 + u.pn * BM + cw;
#pragma unroll
                for (int bj = 0; bj < 2; ++bj) { const f32x4 v0 = acc[ai][bj][m][0], v1 = acc[ai][bj][m][1];
                    if (isk) { const float ss = quad_sum(sq8(v0, v1)); if (fq == 0) ssqm[(size_t)row * 16 + (u.pn * 2 + bj) * 4 + wc] = ss; }
                    *(u32x4*)(rowp + bj * HALF) = pack8(v0 * g0, v1 * g1); } }
    }
};
struct EpiSwiglu {
    static constexpr bool PERM = true, AFTER_DRAIN = false;
    const float* rs2; bf16_t* act;
    __device__ __forceinline__ void operator()(const f32x4 (&acc)[2][2][4][2], const Unit& u, int wr, int wc, int fr, int fq) const {
        const int row0 = u.pm * BM + wr * 64 + fr, cw = wc * 32 + 8 * fq;
        f32x4 rq[2][4];
#pragma unroll
        for (int ai = 0; ai < 2; ++ai)
#pragma unroll
            for (int m = 0; m < 4; ++m) rq[ai][m] = rs_quarter(rs2, row0 + ai * HALF + m * 16, fq);
#pragma unroll
        for (int ai = 0; ai < 2; ++ai)
#pragma unroll
            for (int m = 0; m < 4; ++m) { const int row = row0 + ai * HALF + m * 16; const float rstd = rstd_from_quarter(rq[ai][m]);
                f32x4 a[2];
#pragma unroll
                for (int n = 0; n < 2; ++n) { const f32x4 gg = acc[ai][0][m][n] * rstd, uu = acc[ai][1][m][n] * rstd;
#pragma unroll
                    for (int j = 0; j < 4; ++j) a[n][j] = gg[j] * __builtin_amdgcn_rcpf(1.0f + __expf(-gg[j])) * uu[j]; }
                *(u32x4*)(act + (size_t)row * 2816 + u.pn * HALF + cw) = pack8(a[0], a[1]); }
    }
};
}

#define LAS __attribute__((address_space(3)))
typedef unsigned short bf16_t;
typedef short bf16x8 __attribute__((ext_vector_type(8)));
typedef short s16x4 __attribute__((ext_vector_type(4)));
typedef float f32x4 __attribute__((ext_vector_type(4)));
typedef unsigned u32x4 __attribute__((ext_vector_type(4)));
typedef unsigned u32x2 __attribute__((ext_vector_type(2)));
constexpr int M = 16384, SEQ = 8192, DM = 1024, INW = 3072, DFF = 2816, NMEM = 256;
constexpr size_t MiB = 1u << 20;
constexpr size_t WS_WIN = 1 * MiB, WS_WOUT = 7 * MiB, WS_WCQ = 9 * MiB, WS_WCKV = 10 * MiB, WS_WCO = 12 * MiB, WS_WGU = 13 * MiB, WS_WDN = 24 * MiB;
constexpr size_t WS_SSQ = 30 * MiB, WS_COS = 34 * MiB, WS_SIN = 35 * MiB, WS_RS1 = 36 * MiB, WS_RS2 = 37 * MiB, WS_SSQC = 38 * MiB, WS_MEMN = 39 * MiB, WS_MEMKV = 40 * MiB, WS_SSQM = 41 * MiB, WS_ML = 42 * MiB;
constexpr size_t WS_INVR = 44 * MiB;
constexpr size_t WS_A = 48 * MiB;
constexpr size_t WS_B = 80 * MiB;
constexpr size_t WS_OG = 80 * MiB;
constexpr size_t WS_QC = 112 * MiB, WS_OC = 128 * MiB;
constexpr size_t WS_BIG = 144 * MiB;
constexpr size_t WS_END = 240 * MiB;
constexpr int LDS_BYTES = 149504, XB_LDS_OFF = 149000;
constexpr int KST = 288, KSK = 272, A_KOFF = 0, A_VOFF = 256 * KSK, A_RKOFF = A_VOFF + 256 * KST;
static_assert(A_RKOFF + 1024 <= LDS_BYTES && pg8::STAGE_BYTES <= LDS_BYTES, "LDS map");

struct Args { const float* in[20]; float* out; unsigned char* ws; float invf[16]; };

__device__ __forceinline__ float wave_sum(float v) {
#pragma unroll
    for (int o = 1; o < 64; o <<= 1) v += __shfl_xor(v, o);
    return v;
}
__device__ __forceinline__ float bf_lo(unsigned w) { return __uint_as_float(w << 16); }
__device__ __forceinline__ float bf_hi(unsigned w) { return __uint_as_float(w & 0xffff0000u); }
__device__ __forceinline__ void unpack8(const u32x4 w, float (&f)[8]) { f[0] = bf_lo(w.x); f[1] = bf_hi(w.x); f[2] = bf_lo(w.y); f[3] = bf_hi(w.y); f[4] = bf_lo(w.z); f[5] = bf_hi(w.z); f[6] = bf_lo(w.w); f[7] = bf_hi(w.w); }

template <int MODE>
__device__ __forceinline__ void tr_item(const float* W, int Nsrc, int Ndst, const float* gain, bf16_t* WT, int ldt, LAS float* scr, int item, int lane) {
    const int nblk = Ndst / 32, kb = item / nblk, nb = item % nblk, k0 = 64 * kb, n0 = 32 * nb;
    const int s0 = MODE == 1 ? (((n0 >> 7) & 1) * DFF + (n0 >> 8) * 128 + (n0 & 127)) : n0;
    const int kr = lane >> 3, ch = lane & 7; f32x4 w[8];
#pragma unroll
    for (int i = 0; i < 8; ++i) w[i] = __builtin_nontemporal_load((const f32x4*)(W + (size_t)(k0 + kr + 8 * i) * Nsrc + s0 + 4 * ch));
#pragma unroll
    for (int i = 0; i < 8; ++i) { const int kk = kr + 8 * i; const float gm = gain ? gain[k0 + kk] : 1.0f;
#pragma unroll
        for (int j = 0; j < 4; ++j) scr[kk * 33 + 4 * ch + j] = w[i][j] * gm; }
    asm volatile("s_waitcnt lgkmcnt(0)" ::: "memory");
    const int c = lane & 7;
#pragma unroll
    for (int j = 0; j < 4; ++j) { const int n = (lane >> 3) + 8 * j; const LAS float* s = scr + (8 * c) * 33 + n;
        u32x4 o; o.x = pg8::cvt_pk_bf16(s[0 * 33], s[1 * 33]); o.y = pg8::cvt_pk_bf16(s[2 * 33], s[3 * 33]); o.z = pg8::cvt_pk_bf16(s[4 * 33], s[5 * 33]); o.w = pg8::cvt_pk_bf16(s[6 * 33], s[7 * 33]);
        *(u32x4*)(WT + (size_t)(n0 + n) * ldt + k0 + 8 * c) = o; }
    asm volatile("s_waitcnt lgkmcnt(0)" ::: "memory");
}
__device__ __forceinline__ void rms_rows2(const float* x0, const float* g0, bf16_t* o0, float* iv0, const float* x1, const float* g1, bf16_t* o1, float* iv1, bool has1, int lane) {
    const f32x4* xr0 = (const f32x4*)x0 + lane; const f32x4* xr1 = (const f32x4*)x1 + lane;
    f32x4 v0[4], v1[4]; float s0 = 0.f, s1 = 0.f;
#pragma unroll
    for (int j = 0; j < 4; ++j) { v0[j] = __builtin_nontemporal_load(xr0 + 64 * j); v1[j] = __builtin_nontemporal_load(xr1 + 64 * j); }
#pragma unroll
    for (int j = 0; j < 4; ++j) { s0 += (v0[j][0] * v0[j][0] + v0[j][1] * v0[j][1]) + (v0[j][2] * v0[j][2] + v0[j][3] * v0[j][3]); s1 += (v1[j][0] * v1[j][0] + v1[j][1] * v1[j][1]) + (v1[j][2] * v1[j][2] + v1[j][3] * v1[j][3]); }
    const float r0 = rsqrtf(wave_sum(s0) * (1.0f / 1024.0f) + 1e-6f), r1 = rsqrtf(wave_sum(s1) * (1.0f / 1024.0f) + 1e-6f);
    if (lane == 0) { if (iv0) *iv0 = 1.0f / r0; if (iv1 && has1) *iv1 = 1.0f / r1; }
    const f32x4* gr0 = (const f32x4*)g0 + lane; const f32x4* gr1 = (const f32x4*)g1 + lane;
    u32x2* p0 = (u32x2*)o0 + lane; u32x2* p1 = (u32x2*)o1 + lane;
#pragma unroll
    for (int j = 0; j < 4; ++j) { const f32x4 y = v0[j] * r0 * gr0[64 * j]; u32x2 w; w.x = pg8::cvt_pk_bf16(y[0], y[1]); w.y = pg8::cvt_pk_bf16(y[2], y[3]); p0[64 * j] = w; }
    if (has1) {
#pragma unroll
        for (int j = 0; j < 4; ++j) { const f32x4 y = v1[j] * r1 * gr1[64 * j]; u32x2 w; w.x = pg8::cvt_pk_bf16(y[0], y[1]); w.y = pg8::cvt_pk_bf16(y[2], y[3]); p1[64 * j] = w; } }
}
__device__ __forceinline__ void sincos_d(float ang, float& s, float& c) {
    const double x = (double)ang; const double kq = rint(x * 0.63661977236758134308);
    const double r = (x - kq * 1.5707963267948966192) - kq * 6.123233995736766036e-17; const double r2 = r * r;
    double sp = -7.6471637318198164759e-13; sp = sp * r2 + 1.6059043836821614599e-10; sp = sp * r2 - 2.5052108385441718775e-08; sp = sp * r2 + 2.7557319223985890653e-06;
    sp = sp * r2 - 1.9841269841269841270e-04; sp = sp * r2 + 8.3333333333333333333e-03; sp = sp * r2 - 1.6666666666666666667e-01; sp = r + r * r2 * sp;
    double cp = 4.7794773323873852974e-14; cp = cp * r2 - 1.1470745597729724714e-11; cp = cp * r2 + 2.0876756987868098979e-09; cp = cp * r2 - 2.7557319223985890653e-07;
    cp = cp * r2 + 2.4801587301587301587e-05; cp = cp * r2 - 1.3888888888888888889e-03; cp = cp * r2 + 4.1666666666666666667e-02; cp = cp * r2 - 0.5; cp = 1.0 + r2 * cp;
    const int q = (int)((long long)kq & 3);
    const double sv = (q & 1) ? cp : sp, cv = (q & 1) ? sp : cp;
    s = (float)((q & 2) ? -sv : sv); c = (float)(((q + 1) & 2) ? -cv : cv);
}

__device__ __forceinline__ s16x4 vtr(LAS unsigned char* p) { return __builtin_bit_cast(s16x4, __builtin_amdgcn_ds_read_tr16_b64_v4i16((LAS s16x4*)p)); }
struct AD {
    const bf16_t* qb; long qstep; const float* sq; long sqstep; const bf16_t* kb; const bf16_t* vb; long kstep; int ks0; const float* sk; long skstep;
    bf16_t* ob; long ostep; float* ml; long mlstep; bool nb0; };
struct KVR { u32x4 kr[8], vr[8]; f32x4 sp; };
__device__ __forceinline__ void attn_load(const AD& d, KVR& R, int tid, bool first) {
    const int c = tid & 15, rr = tid >> 4;
#pragma unroll
    for (int it = 0; it < 4; ++it) { const int sidx = d.ks0 + 128 + rr + 32 * it; const long off = (long)sidx * d.kstep + 8 * c;
        R.kr[it] = *(const u32x4*)(d.kb + off); R.vr[it] = *(const u32x4*)(d.vb + off); }
    if (first) {
#pragma unroll
        for (int it = 4; it < 8; ++it) { int sidx = d.ks0 + rr + 32 * (it - 4); sidx = sidx < 0 ? 0 : sidx; const long off = (long)sidx * d.kstep + 8 * c;
            R.kr[it] = *(const u32x4*)(d.kb + off); R.vr[it] = *(const u32x4*)(d.vb + off); } }
    { int sidx = d.ks0 + ((tid + 128) & 255); sidx = sidx < 0 ? 0 : sidx; R.sp = *(const f32x4*)(d.sk + (long)sidx * d.skstep); }
}
__device__ __forceinline__ void attn_store(LAS unsigned char* lds, const KVR& R, int tid, bool first, int par) {
    const int c = tid & 15, rr = tid >> 4;
#pragma unroll
    for (int it = 0; it < 4; ++it) { const int row = (128 + rr + 32 * it) ^ (128 * par);
        *(LAS u32x4*)(lds + A_KOFF + row * KSK + c * 16) = R.kr[it]; *(LAS u32x4*)(lds + A_VOFF + row * KST + c * 16) = R.vr[it]; }
    if (first) {
#pragma unroll
        for (int it = 4; it < 8; ++it) { const int row = (rr + 32 * (it - 4)) ^ (128 * par);
            *(LAS u32x4*)(lds + A_KOFF + row * KSK + c * 16) = R.kr[it]; *(LAS u32x4*)(lds + A_VOFF + row * KST + c * 16) = R.vr[it]; } }
    if (tid < 128 || (first && tid < 256)) ((LAS float*)(lds + A_RKOFF))[((tid + 128) & 255) ^ (128 * par)] = rsqrtf(((R.sp[0] + R.sp[1]) + (R.sp[2] + R.sp[3])) * (1.0f / 128.0f) + 1e-6f);
}
struct QR { bf16x8 qf[4]; f32x4 sp; };
__device__ __forceinline__ void attn_loadq(const AD& d, QR& Q, int lane, int wave) {
    const int fr = lane & 15, fq = lane >> 4, qi = wave * 16 + fr;
#pragma unroll
    for (int ks = 0; ks < 4; ++ks) Q.qf[ks] = *(const bf16x8*)(d.qb + (long)qi * d.qstep + 32 * ks + 8 * fq);
    Q.sp = *(const f32x4*)(d.sq + (long)qi * d.sqstep);
}
template <int NT, bool MASK>
__device__ __forceinline__ void attn_compute(LAS unsigned char* lds, const AD& d, const QR& Q, int lane, int wave, int par) {
    const int fr = lane & 15, fq = lane >> 4, qi = wave * 16 + fr;
    const float rq2 = rsqrtf(((Q.sp[0] + Q.sp[1]) + (Q.sp[2] + Q.sp[3])) * (1.0f / 128.0f) + 1e-6f) * 1.4426950408889634f;
    const int ts = MASK ? wave : 0;
    f32x4 s[NT];
    {
        bf16x8 kf[4], kn[4];
#pragma unroll
        for (int ks = 0; ks < 4; ++ks) { kf[ks] = *(const LAS bf16x8*)(lds + A_KOFF + (((16 * ts) ^ (128 * par)) + fr) * KSK + (32 * ks + 8 * fq) * 2); kn[ks] = kf[ks]; }
#pragma unroll
        for (int tt = 0; tt < NT; ++tt) {
            if (tt + 1 < NT) {
#pragma unroll
                for (int ks = 0; ks < 4; ++ks) kn[ks] = *(const LAS bf16x8*)(lds + A_KOFF + (((16 * (ts + tt + 1)) ^ (128 * par)) + fr) * KSK + (32 * ks + 8 * fq) * 2); }
            __builtin_amdgcn_sched_barrier(0);
            f32x4 acc = {0.f, 0.f, 0.f, 0.f};
#pragma unroll
            for (int ks = 0; ks < 4; ++ks) acc = __builtin_amdgcn_mfma_f32_16x16x32_bf16(kf[ks], Q.qf[ks], acc, 0, 0, 0);
            s[tt] = acc;
            __builtin_amdgcn_sched_barrier(0);
#pragma unroll
            for (int ks = 0; ks < 4; ++ks) kf[ks] = kn[ks];
        }
    }
    float tm = -3.0e38f;
#pragma unroll
    for (int tt = 0; tt < NT; ++tt) { const f32x4 rk4 = *(const LAS f32x4*)(lds + A_RKOFF + (((16 * (ts + tt)) ^ (128 * par)) + 4 * fq) * 4);
#pragma unroll
        for (int j = 0; j < 4; ++j) { const int kj = 16 * (ts + tt) + 4 * fq + j; float v = s[tt][j] * rk4[j];
            if (MASK) { bool valid;
                if (tt == 0) valid = (kj >= qi) && (!d.nb0 || kj >= 128);
                else if (tt == NT - 1) valid = (kj <= qi + 128);
                else valid = (!d.nb0 || kj >= 128);
                v = valid ? v : -1.0e30f; }
            s[tt][j] = v; tm = fmaxf(tm, v); } }
    tm = fmaxf(tm, __shfl_xor(tm, 16)); tm = fmaxf(tm, __shfl_xor(tm, 32));
    const float mx = tm * rq2, nmx = -mx;
    float l = 0.f;
#pragma unroll
    for (int tt = 0; tt < NT; ++tt)
#pragma unroll
        for (int j = 0; j < 4; ++j) { const float p = __builtin_amdgcn_exp2f(__builtin_fmaf(s[tt][j], rq2, nmx)); s[tt][j] = p; l += p; }
    l = pg8::quad_sum(l);
    f32x4 o[8];
#pragma unroll
    for (int dt = 0; dt < 8; ++dt) o[dt] = (f32x4){0.f, 0.f, 0.f, 0.f};
    const int q4 = fr >> 2, p4 = fr & 3;
    {
        s16x4 cur[8], nxt[8];
#define VSTEP_LOAD(dst, q_) do { const int pr_ = (q_) >> 1, d0_ = 4 * ((q_) & 1), t1_ = (2 * pr_ + 1 < NT) ? 2 * pr_ + 1 : 2 * pr_; \
            LAS unsigned char* v0p = lds + A_VOFF + (((16 * (ts + 2 * pr_)) ^ (128 * par)) + 4 * fq + q4) * KST + 8 * p4; \
            LAS unsigned char* v1p = lds + A_VOFF + (((16 * (ts + t1_)) ^ (128 * par)) + 4 * fq + q4) * KST + 8 * p4; \
            _Pragma("unroll") for (int e = 0; e < 4; ++e) { dst[2 * e] = vtr(v0p + 32 * (d0_ + e)); if (2 * pr_ + 1 < NT) dst[2 * e + 1] = vtr(v1p + 32 * (d0_ + e)); else dst[2 * e + 1] = (s16x4){0, 0, 0, 0}; } } while (0)
        VSTEP_LOAD(cur, 0);
#pragma unroll
        for (int e = 0; e < 8; ++e) nxt[e] = cur[e];
        constexpr int NSTEP = 2 * ((NT + 1) / 2); const f32x4 zero4 = {0.f, 0.f, 0.f, 0.f};
        bf16x8 pf = __builtin_bit_cast(bf16x8, pg8::pack8(s[0], s[1]));
#pragma unroll
        for (int q = 0; q < NSTEP; ++q) {
            if (q + 1 < NSTEP) VSTEP_LOAD(nxt, q + 1);
            if ((q & 1) == 0) pf = __builtin_bit_cast(bf16x8, pg8::pack8(s[q < NT ? q : NT - 1], q + 1 < NT ? s[q + 1 < NT ? q + 1 : NT - 1] : zero4));
            __builtin_amdgcn_sched_barrier(0);
#pragma unroll
            for (int e = 0; e < 4; ++e) { const bf16x8 vf = __builtin_shufflevector(cur[2 * e], cur[2 * e + 1], 0, 1, 2, 3, 4, 5, 6, 7);
                o[4 * (q & 1) + e] = __builtin_amdgcn_mfma_f32_16x16x32_bf16(vf, pf, o[4 * (q & 1) + e], 0, 0, 0); }
            __builtin_amdgcn_sched_barrier(0);
#pragma unroll
            for (int e = 0; e < 8; ++e) cur[e] = nxt[e];
        }
#undef VSTEP_LOAD
    }
    const float inv = 1.0f / l;
#pragma unroll
    for (int dt = 0; dt < 8; ++dt) { u32x2 w; w.x = pg8::cvt_pk_bf16(o[dt][0] * inv, o[dt][1] * inv); w.y = pg8::cvt_pk_bf16(o[dt][2] * inv, o[dt][3] * inv);
        *(u32x2*)(d.ob + (long)qi * d.ostep + 16 * dt + 4 * fq) = w; }
    if (d.ml && fq == 0) { d.ml[(long)qi * d.mlstep] = mx * 0.6931471805599453f; d.ml[(long)qi * d.mlstep + 1] = l; }
}
__device__ __forceinline__ int chain_len(int ch) { return ch < 256 ? 4 : 2; }
__device__ __forceinline__ AD dil_desc(int ch, int i, bf16_t* BIG, float* SSQ, bf16_t* OG, float* ML) {
    int g, b, h, r, nb;
    if (ch < 256) { g = ch >> 7; const int c = ch & 127;
        if (g == 0) { const int combo = c >> 4; b = combo >> 2; h = combo & 3; r = 0; nb = (c & 15) * 4 + i; }
        else { const int combo = c >> 2; b = combo >> 4; h = (combo >> 2) & 3; r = combo & 3; nb = (c & 3) * 4 + i; } }
    else { g = 2; const int c = ch - 256, seq = c >> 1; b = seq >> 6; h = (seq >> 4) & 3; r = seq & 15; nb = (c & 1) * 2 + i; }
    const int dil = 1 << (2 * g);
    const long row0 = (long)b * SEQ + r, qrow = row0 + (long)dil * 128 * nb;
    AD d; d.qb = BIG + qrow * INW + (g * 4 + h) * 128; d.qstep = (long)dil * INW; d.sq = SSQ + qrow * 64 + (g * 4 + h) * 4; d.sqstep = (long)dil * 64;
    d.kb = BIG + row0 * INW + 1536 + h * 128; d.vb = BIG + row0 * INW + 2048 + h * 128; d.kstep = (long)dil * INW; d.ks0 = 128 * (nb - 1); d.sk = SSQ + row0 * 64 + (12 + h) * 4; d.skstep = (long)dil * 64;
    d.ob = OG + (size_t)g * M * 512 + qrow * 512 + h * 128; d.ostep = (long)dil * 512; d.ml = ML + (((size_t)g * M + qrow) * 4 + h) * 2; d.mlstep = (long)dil * 8; d.nb0 = nb == 0; return d;
}
__device__ __forceinline__ AD cross_desc(int u, bf16_t* QC, float* SSQC, bf16_t* MEMKV, float* SSQM, bf16_t* OC) {
    const int h = u & 3, qb = u >> 2, b = qb >> 6; const long qrow = (long)qb * 128;
    AD d; d.qb = QC + qrow * 512 + h * 128; d.qstep = 512; d.sq = SSQC + qrow * 16 + h * 4; d.sqstep = 16;
    d.kb = MEMKV + (size_t)b * NMEM * 1024 + h * 128; d.vb = d.kb + 512; d.kstep = 1024; d.ks0 = 0; d.sk = SSQM + (size_t)b * NMEM * 16 + h * 4; d.skstep = 16;
    d.ob = OC + qrow * 512 + h * 128; d.ostep = 512; d.ml = nullptr; d.mlstep = 0; d.nb0 = false; return d;
}

#define XB_TMO      128
#define XB_XCNT(j)  (256  + 64 * (j))
#define XB_XSUB(j)  (1280 + 64 * (j))
#define XB_XGEN(j)  (2304 + 64 * (j))
#define XB_TOP      3328
#define XB_TOPGEN   3392
#define XCD_BAR_WORDS 3456
#define XB_SPIN_CAP (1u << 18)

__device__ __forceinline__ unsigned xb_ld(unsigned* p)              { return __hip_atomic_load(p, __ATOMIC_RELAXED, __HIP_MEMORY_SCOPE_AGENT); }
__device__ __forceinline__ unsigned xb_add(unsigned* p, unsigned v) { return __hip_atomic_fetch_add(p, v, __ATOMIC_RELAXED, __HIP_MEMORY_SCOPE_AGENT); }
__device__ __forceinline__ unsigned xb_xcc_id() { return (unsigned)__builtin_amdgcn_s_getreg((3 << 11) | 20) & 0xFu; }
#define XB_SPIN(cond, bar) do { unsigned _sp = 0; while (cond) { __builtin_amdgcn_s_sleep(1); \
    if ((++_sp & 255u) == 0u) { if (xb_ld(&(bar)[XB_TMO])) break; if (_sp > XB_SPIN_CAP) { atomicAdd(&(bar)[XB_TMO], 1u); break; } } } } while (0)

struct XcdBarrier {
    unsigned* bar; unsigned x;
    volatile LAS unsigned* st;
};

__device__ __forceinline__ XcdBarrier xcd_barrier_post(unsigned* bar, volatile LAS unsigned* st) {
    XcdBarrier b; b.bar = bar; b.x = xb_xcc_id(); b.st = st;
    if (threadIdx.x == 0) (void)xb_add(&bar[XB_XCNT(b.x)], 1u);
    return b;
}
__device__ __forceinline__ void xcd_barrier_complete(unsigned* bar, unsigned x, unsigned& nloc, unsigned& nx) {
    const unsigned G = gridDim.x * gridDim.y * gridDim.z;
    unsigned sum, cnt, mine, sp = 0u;
    for (;;) {
        sum = 0u; cnt = 0u; mine = 0u;
#pragma unroll
        for (unsigned j = 0; j < 16; ++j) { const unsigned c = xb_ld(&bar[XB_XCNT(j)]); sum += c; cnt += (c > 0u) ? 1u : 0u; mine = (j == x) ? c : mine; }
        if (sum == G) break;
        __builtin_amdgcn_s_sleep(1);
        if ((++sp & 255u) == 0u) { if (xb_ld(&bar[XB_TMO])) break; if (sp > XB_SPIN_CAP) { atomicAdd(&bar[XB_TMO], 1u); break; } }
    }
    nloc = mine > 0u ? mine : 1u; nx = cnt > 0u ? cnt : 1u;
}

__device__ __forceinline__ void xcd_barrier(const XcdBarrier& b) {
    asm volatile("s_waitcnt vmcnt(0)" ::: "memory");
    __syncthreads();
    if (threadIdx.x == 0) {
        unsigned* bar = b.bar;
        __builtin_amdgcn_s_waitcnt(0);
        unsigned nloc = b.st[0], nx = b.st[1];
        if (nloc == 0u) { xcd_barrier_complete(bar, b.x, nloc, nx); b.st[0] = nloc; b.st[1] = nx; }
        const unsigned old = xb_add(&bar[XB_XSUB(b.x)], 1u);
        const unsigned gen = old / nloc;
        if (old + 1u == (gen + 1u) * nloc) {
            __builtin_amdgcn_fence(__ATOMIC_RELEASE, "agent");
            asm volatile("s_waitcnt vmcnt(0)" ::: "memory");
            const unsigned og = xb_add(&bar[XB_TOP], 1u);
            const unsigned tg = og / nx;
            if (og + 1u == (tg + 1u) * nx) xb_add(&bar[XB_TOPGEN], 1u);
            else XB_SPIN(xb_ld(&bar[XB_TOPGEN]) == tg, bar);
            __builtin_amdgcn_fence(__ATOMIC_ACQUIRE, "agent");
            xb_add(&bar[XB_XGEN(b.x)], 1u);
            asm volatile("s_waitcnt vmcnt(0)" ::: "memory");
        } else {
            XB_SPIN(xb_ld(&bar[XB_XGEN(b.x)]) == gen, bar);
            __builtin_amdgcn_fence(__ATOMIC_ACQUIRE, "agent");
            asm volatile("s_waitcnt vmcnt(0)" ::: "memory");
        }
    }
    __syncthreads();
}

#define REP_P0 1
#define REP_P1 1
#define REP_P2 1
#define REP_P2B 1
#define REP_P3 1
#define REP_P4 1
#define REP_P5 1
#define REP_P6 1
#define REP_P7 1
#define REP_P8 1
#define REP_SYNC 1
#define SKEW_MASK 0
__global__ void __launch_bounds__(512) fwd(Args a) {
    extern __shared__ __attribute__((aligned(16))) unsigned char lds_raw[];
    LAS unsigned char* lds = (LAS unsigned char*)lds_raw;
    cg::grid_group grid = cg::this_grid();
    const int wave = __builtin_amdgcn_readfirstlane(threadIdx.x >> 6);
    const int G = gridDim.x, bx = blockIdx.x;
    unsigned char* ws = a.ws;
    volatile LAS unsigned* xst = (volatile LAS unsigned*)(lds + XB_LDS_OFF);
    if (threadIdx.x < 2) xst[threadIdx.x] = 0u;
    __syncthreads();
    const XcdBarrier xbar = xcd_barrier_post((unsigned*)ws, xst);
    if (ws == nullptr) grid.sync();
    const float* x = a.in[0]; const float* mem = a.in[1]; const int* pos = (const int*)a.in[2];
    bf16_t* Win = (bf16_t*)(ws + WS_WIN); bf16_t* Wout = (bf16_t*)(ws + WS_WOUT); bf16_t* Wcq = (bf16_t*)(ws + WS_WCQ); bf16_t* Wckv = (bf16_t*)(ws + WS_WCKV);
    bf16_t* Wco = (bf16_t*)(ws + WS_WCO); bf16_t* Wgu = (bf16_t*)(ws + WS_WGU); bf16_t* Wdn = (bf16_t*)(ws + WS_WDN);
    float* SSQ = (float*)(ws + WS_SSQ); float* COS = (float*)(ws + WS_COS); float* SIN = (float*)(ws + WS_SIN); float* RS1 = (float*)(ws + WS_RS1); float* RS2 = (float*)(ws + WS_RS2);
    float* SSQC = (float*)(ws + WS_SSQC); bf16_t* MEMN = (bf16_t*)(ws + WS_MEMN); bf16_t* MEMKV = (bf16_t*)(ws + WS_MEMKV); float* SSQM = (float*)(ws + WS_SSQM); float* ML = (float*)(ws + WS_ML);
    bf16_t* BA = (bf16_t*)(ws + WS_A); bf16_t* BB = (bf16_t*)(ws + WS_B); bf16_t* OG = (bf16_t*)(ws + WS_OG); bf16_t* QC = (bf16_t*)(ws + WS_QC); bf16_t* OC = (bf16_t*)(ws + WS_OC);
    bf16_t* BIG = (bf16_t*)(ws + WS_BIG); float* INVR = (float*)(ws + WS_INVR);
    bf16_t* MIXB = (bf16_t*)a.out;

#define SEAM(k) do { if (SKEW_MASK != 0 && threadIdx.x == 0) { const unsigned long long t_ = __builtin_amdgcn_s_memrealtime(); \
        atomicAdd((unsigned long long*)(ws + 16384) + 2 * (k), t_); atomicMax((unsigned long long*)(ws + 16384) + 2 * (k) + 1, t_); } \
    for (int rep = 0; rep < REP_SYNC; ++rep) xcd_barrier(xbar); } while (0)
    for (int rep = 0; rep < REP_P0; ++rep)
    {
        const int lane = pg8::fresh_lane(), tid = wave * 64 + lane;
        LAS float* scr = (LAS float*)(lds + wave * 16384);
        const int gw = wave * G + bx, NGW = G * 8;
        constexpr int I_IN = 16 * 96, I_OUT = 8 * 32, I_CQ = 16 * 16, I_CKV = 16 * 32;
        constexpr int NITEMS = I_IN + I_OUT + I_CQ + I_CKV;
        for (int it = gw; it < NITEMS; it += NGW) {
            int r = it;
            if (r < I_IN) { tr_item<0>(a.in[4], INW, INW, nullptr, Win, 1024, scr, r, lane); continue; } r -= I_IN;
            if (r < I_OUT) { tr_item<0>(a.in[9], 1024, 1024, nullptr, Wout, 1024, scr, r, lane); continue; } r -= I_OUT;
            if (r < I_CQ) { tr_item<0>(a.in[12], 512, 512, a.in[10], Wcq, 1024, scr, r, lane); continue; } r -= I_CQ;
            tr_item<0>(a.in[13], 1024, 1024, nullptr, Wckv, 1024, scr, r, lane);
        }
        {
            const float* pw = a.in[7]; const float* psc = a.in[8]; const float* wo = a.in[9];
            LAS float* T = (LAS float*)(lds + 131072);
            for (int item = bx; item < 256; item += G) { const int g = item >> 6, n0 = (item & 63) * 16, e = tid >> 2, c4 = (tid & 3) * 4;
                *(LAS f32x4*)(T + e * 16 + c4) = *(const f32x4*)(wo + (size_t)(512 + g * 128 + e) * 1024 + n0 + c4) * psc[g * 128 + e];
                __syncthreads();
                const int kc = tid >> 2; const float* pr = pw + (size_t)(g * 128 + kc) * 128; f32x4 acc = {0.f, 0.f, 0.f, 0.f};
#pragma unroll 8
                for (int e4 = 0; e4 < 32; ++e4) { const f32x4 pv = *(const f32x4*)(pr + 4 * e4);
#pragma unroll
                    for (int q = 0; q < 4; ++q) acc += *(const LAS f32x4*)(T + (4 * e4 + q) * 16 + c4) * pv[q]; }
#pragma unroll
                for (int j = 0; j < 4; ++j) Wout[(size_t)(n0 + c4 + j) * 1024 + 512 + g * 128 + kc] = (bf16_t)(pg8::cvt_pk_bf16(acc[j], 0.f) & 0xffffu);
                __syncthreads(); }
        }
        for (int m = gw; m < M + 512; m += 2 * NGW) { const int m1 = m + NGW; const bool has1 = m1 < M + 512; const int mb = has1 ? m1 : m;
            const float* xa = m < M ? x + (size_t)m * DM : mem + (size_t)(m - M) * DM; const float* ga = m < M ? a.in[3] : a.in[11]; bf16_t* oa = m < M ? BA + (size_t)m * DM : MEMN + (size_t)(m - M) * DM;
            const float* xb = mb < M ? x + (size_t)mb * DM : mem + (size_t)(mb - M) * DM; const float* gb = mb < M ? a.in[3] : a.in[11]; bf16_t* ob = mb < M ? BA + (size_t)mb * DM : MEMN + (size_t)(mb - M) * DM;
            rms_rows2(xa, ga, oa, m < M ? INVR + m : nullptr, xb, gb, ob, mb < M ? INVR + mb : nullptr, has1, lane);
        }
        for (int idx = bx * 512 + tid; idx < M * 16; idx += G * 512) { const int row = idx >> 4, i = idx & 15;
            const float ang = (float)pos[row] * a.invf[i]; float s, c; sincos_d(ang, s, c); COS[idx] = c; SIN[idx] = s; }
    }
    SEAM(0);

    for (int rep = 0; rep < REP_P1; ++rep)
    {
        pg8::Gemm g{BA, Win, M, INW, 1024}; pg8::StaticOrder S; S.init(M, INW, G, bx);
        pg8::EpiProj E{BIG, SSQ, COS, SIN, a.in[5], a.in[6]};
        pg8::gemm_phase<pg8::EpiProj, pg8::StaticOrder, true, true>(lds, g, S, E, wave);
    }
    SEAM(1);

    for (int rep = 0; rep < REP_P2; ++rep)
    { const int lane = pg8::fresh_lane(), tid = wave * 64 + lane;
      KVR R; QR Qn; int ch = bx, i = 0;
      if (ch < 512) { const AD d = dil_desc(ch, 0, BIG, SSQ, OG, ML); attn_load(d, R, tid, true); attn_loadq(d, Qn, lane, wave); }
      while (ch < 512) {
        const AD d = dil_desc(ch, i, BIG, SSQ, OG, ML); const int par = i & 1;
        attn_store(lds, R, tid, i == 0, par); const QR Q = Qn;
        __syncthreads();
        int ni = i + 1, nch = ch; if (ni == chain_len(ch)) { ni = 0; nch = ch + G; }
        if (nch < 512) { const AD dn = dil_desc(nch, ni, BIG, SSQ, OG, ML); attn_load(dn, R, tid, ni == 0); attn_loadq(dn, Qn, lane, wave); }
        attn_compute<9, true>(lds, d, Q, lane, wave, par);
        __syncthreads();
        ch = nch; i = ni;
      } }
    SEAM(2);

    for (int rep = 0; rep < REP_P2B; ++rep)
    { const int lane = pg8::fresh_lane(), tid = wave * 64 + lane; const long gt = (long)bx * 512 + tid, NTH = (long)G * 512;
      for (long i0 = gt; i0 < (long)M * 64; i0 += 2 * NTH) {
          const long i1 = i0 + NTH; const bool has1 = i1 < (long)M * 64; const long ii[2] = {i0, has1 ? i1 : i0};
          float mm[2][3], ll[2][3]; u32x4 og[2][3];
#pragma unroll
          for (int q = 0; q < 2; ++q) { const int row = (int)(ii[q] >> 6), c = (int)(ii[q] & 63), h = c >> 4;
#pragma unroll
              for (int g = 0; g < 3; ++g) { const float* p = ML + (((size_t)g * M + row) * 4 + h) * 2; mm[q][g] = p[0]; ll[q][g] = p[1]; og[q][g] = *(const u32x4*)(OG + (size_t)g * M * 512 + (size_t)row * 512 + c * 8); } }
#pragma unroll
          for (int q = 0; q < 2; ++q) { const int row = (int)(ii[q] >> 6), c = (int)(ii[q] & 63);
              const float mmax = fmaxf(mm[q][0], fmaxf(mm[q][1], mm[q][2])); float w[3], den = 0.f;
#pragma unroll
              for (int g = 0; g < 3; ++g) { w[g] = __expf(mm[q][g] - mmax) * ll[q][g]; den += w[g]; }
              const float inv = 1.0f / den; float o[8];
#pragma unroll
              for (int j = 0; j < 8; ++j) o[j] = 0.f;
#pragma unroll
              for (int g = 0; g < 3; ++g) { float f[8]; unpack8(og[q][g], f); const float wg = w[g] * inv;
#pragma unroll
                  for (int j = 0; j < 8; ++j) o[j] += wg * f[j]; }
              if (q == 0 || has1) *(u32x4*)(MIXB + (size_t)row * DM + c * 8) = pg8::pack8((f32x4){o[0], o[1], o[2], o[3]}, (f32x4){o[4], o[5], o[6], o[7]}); }
      }
#define POOL_GROUP(GP, W) { const int j_ = (int)(jj & 65535), row0 = (j_ >> 4) * 4, ch = j_ & 15, t0 = row0 & (SEQ - 1);     \
          const bf16_t* up = BIG + (size_t)row0 * INW + 2560 + (GP) * 128 + ch * 8; u32x4 ld[(W) + 3]; \
          _Pragma("unroll") for (int k = 0; k < (W) + 3; ++k) { const int dk = k - ((W) - 1); ld[k] = *(const u32x4*)(up + (long)(t0 + dk >= 0 ? dk : 0) * INW); } \
          float win[8]; \
          _Pragma("unroll") for (int j = 0; j < 8; ++j) win[j] = 0.f; \
          _Pragma("unroll") for (int k = 0; k < (W) - 1; ++k) { float f[8]; unpack8(ld[k], f); const float v = (t0 + k - ((W) - 1) >= 0) ? 1.f : 0.f; \
              _Pragma("unroll") for (int j = 0; j < 8; ++j) win[j] += v * f[j]; } \
          _Pragma("unroll") for (int r = 0; r < 4; ++r) { float fn[8], d[8]; unpack8(ld[(W) - 1 + r], fn); \
              _Pragma("unroll") for (int j = 0; j < 8; ++j) win[j] += fn[j]; \
              const int cnt = (t0 + r + 1) < (W) ? (t0 + r + 1) : (W); const float ic = 1.0f / (float)cnt; \
              _Pragma("unroll") for (int j = 0; j < 8; ++j) d[j] = win[j] * ic - fn[j]; \
              *(u32x4*)(MIXB + (size_t)(row0 + r) * DM + 512 + (GP) * 128 + ch * 8) = pg8::pack8((f32x4){d[0], d[1], d[2], d[3]}, (f32x4){d[4], d[5], d[6], d[7]}); \
              float fo[8]; unpack8(ld[r], fo); const float vo = (t0 + r - ((W) - 1) >= 0) ? 1.f : 0.f; \
              _Pragma("unroll") for (int j = 0; j < 8; ++j) win[j] -= vo * fo[j]; } }
      for (long jj = gt; jj < 4 * 65536; jj += NTH) { const int gsel = (int)(jj >> 16);
          if (gsel == 0) POOL_GROUP(0, 2) else if (gsel == 1) POOL_GROUP(1, 4) else if (gsel == 2) POOL_GROUP(2, 8) else POOL_GROUP(3, 16) }
#undef POOL_GROUP
    }
    SEAM(3);

    for (int rep = 0; rep < REP_P3; ++rep)
    {
        pg8::Gemm g{MIXB, Wout, M, 1024, 1024}; pg8::StaticOrder S; S.init(M, 1024, G, bx);
        pg8::EpiRes E{x, BA, nullptr, BB, RS1, INVR, a.in[3]};
        pg8::gemm_phase<pg8::EpiRes, pg8::StaticOrder, true, true>(lds, g, S, E, wave);
    }
    SEAM(4);

    for (int rep = 0; rep < REP_P4; ++rep)
    {
        const bool split = G >= 136;
        if (!split || bx < G - 8) {
            pg8::Gemm g{BB, Wcq, M, 512, 1024}; pg8::StaticOrder S; S.init(M, 512, split ? G - 8 : G, bx);
            pg8::EpiCq E{RS1, QC, SSQC, a.in[14]};
            pg8::gemm_phase<pg8::EpiCq, pg8::StaticOrder, true, true>(lds, g, S, E, wave);
        }
        if (!split || bx >= G - 8) {
            pg8::Gemm g{MEMN, Wckv, 512, 1024, 1024}; pg8::StaticOrder S; S.init(512, 1024, split ? 8 : G, split ? bx - (G - 8) : bx);
            pg8::EpiKv E{MEMKV, SSQM, a.in[15]};
            pg8::gemm_phase<pg8::EpiKv, pg8::StaticOrder, true, true>(lds, g, S, E, wave);
        }
        {
            const int nidle = split ? G - 8 - 128 : 0; const bool useidle = nidle >= 32;
            if (!useidle || (bx >= 128 && bx < G - 8)) {
                const int lane = pg8::fresh_lane(); LAS float* scr = (LAS float*)(lds + wave * 16384);
                const int gw = (useidle ? bx - 128 : bx) * 8 + wave, NGW = (useidle ? nidle : G) * 8;
                constexpr int I_CO = 8 * 32, I_GU = 16 * 176, I_DN = 44 * 32;
                for (int it = gw; it < I_CO + I_GU + I_DN; it += NGW) {
                    int r = it;
                    if (r < I_CO) { tr_item<0>(a.in[16], 1024, 1024, nullptr, Wco, 512, scr, r, lane); continue; } r -= I_CO;
                    if (r < I_GU) { tr_item<1>(a.in[18], 2 * DFF, 2 * DFF, a.in[17], Wgu, 1024, scr, r, lane); continue; } r -= I_GU;
                    tr_item<0>(a.in[19], 1024, 1024, nullptr, Wdn, DFF, scr, r, lane);
                }
            }
        }
    }
    SEAM(5);

    for (int rep = 0; rep < REP_P5; ++rep)
    { const int lane = pg8::fresh_lane(), tid = wave * 64 + lane;
      for (int pr = bx; pr < 256; pr += G) {
        const int h = pr & 3, b = (pr >> 2) & 1, qb0 = b * 64 + (pr >> 3) * 2;
        const AD d0 = cross_desc(qb0 * 4 + h, QC, SSQC, MEMKV, SSQM, OC), d1 = cross_desc((qb0 + 1) * 4 + h, QC, SSQC, MEMKV, SSQM, OC);
        { KVR R; attn_load(d0, R, tid, true); attn_store(lds, R, tid, true, 0); }
        QR Q0, Q1; attn_loadq(d0, Q0, lane, wave); attn_loadq(d1, Q1, lane, wave);
        __syncthreads();
        attn_compute<16, false>(lds, d0, Q0, lane, wave, 0);
        attn_compute<16, false>(lds, d1, Q1, lane, wave, 0);
        __syncthreads();
      } }
    SEAM(6);

    for (int rep = 0; rep < REP_P6; ++rep)
    {
        pg8::Gemm g{OC, Wco, M, 1024, 512}; pg8::StaticOrder S; S.init(M, 1024, G, bx);
        pg8::EpiRes E{nullptr, BB, nullptr, BA, RS2, nullptr, nullptr};
        pg8::gemm_phase<pg8::EpiRes, pg8::StaticOrder, true, true>(lds, g, S, E, wave);
    }
    SEAM(7);

    for (int rep = 0; rep < REP_P7; ++rep)
    {
        pg8::Gemm g{BA, Wgu, M, 2 * DFF, 1024}; pg8::StaticOrder S; S.init(M, 2 * DFF, G, bx);
        pg8::EpiSwiglu E{RS2, BIG};
        pg8::gemm_phase<pg8::EpiSwiglu, pg8::StaticOrder, true, true>(lds, g, S, E, wave);
    }
    SEAM(8);

    for (int rep = 0; rep < REP_P8; ++rep)
    {
        pg8::Gemm g{BIG, Wdn, M, 1024, DFF}; pg8::StaticOrder S; S.init(M, 1024, G, bx);
        pg8::EpiRes E{nullptr, BA, a.out, nullptr, nullptr, nullptr, nullptr};
        pg8::gemm_phase<pg8::EpiRes, pg8::StaticOrder, true, true>(lds, g, S, E, wave);
    }
    if (SKEW_MASK != 0) {
        if (threadIdx.x == 0) { const unsigned long long t_ = __builtin_amdgcn_s_memrealtime(); atomicAdd((unsigned long long*)(ws + 16384) + 2 * 9, t_); atomicMax((unsigned long long*)(ws + 16384) + 2 * 9 + 1, t_); }
        xcd_barrier(xbar);
        if (bx == 0 && threadIdx.x == 0) { unsigned long long loss = 0;
            for (int k = 0; k < 10; ++k) if ((SKEW_MASK >> k) & 1) { const unsigned long long sm = __hip_atomic_load((unsigned long long*)(ws + 16384) + 2 * k, __ATOMIC_RELAXED, __HIP_MEMORY_SCOPE_AGENT), mx = __hip_atomic_load((unsigned long long*)(ws + 16384) + 2 * k + 1, __ATOMIC_RELAXED, __HIP_MEMORY_SCOPE_AGENT); loss += mx - sm / (unsigned long long)G; }
            const unsigned long long t0_ = __builtin_amdgcn_s_memrealtime(); while (__builtin_amdgcn_s_memrealtime() - t0_ < loss) __builtin_amdgcn_s_sleep(8); }
    }
}

extern "C" void kernel_launch(void* const* d_in, const int* in_sizes, int n_in, void* d_out, int out_size, void* d_ws, size_t ws_size, hipStream_t stream) {
    static int grid_blocks = 0;
    if (grid_blocks == 0) {
        if (n_in != 20 || ws_size < WS_END) { fprintf(stderr, "kernel_launch: unexpected inputs (n_in %d, ws %zu)\n", n_in, ws_size); grid_blocks = -1; return; }
        int dev = 0, cus = 0, per_cu = 0;
        hipGetDevice(&dev); hipDeviceGetAttribute(&cus, hipDeviceAttributeMultiprocessorCount, dev);
        if (hipFuncSetAttribute((const void*)fwd, hipFuncAttributeMaxDynamicSharedMemorySize, LDS_BYTES) != hipSuccess) { fprintf(stderr, "kernel_launch: hipFuncSetAttribute failed\n"); }
        if (hipOccupancyMaxActiveBlocksPerMultiprocessor(&per_cu, (const void*)fwd, 512, LDS_BYTES) != hipSuccess || per_cu < 1) { fprintf(stderr, "kernel_launch: occupancy query says %d\n", per_cu); per_cu = 1; }
        (void)hipGetLastError();
        grid_blocks = cus * 1;
        if (grid_blocks < 1) grid_blocks = 1;
    }
    if (grid_blocks < 0) return;
    if (hipMemsetAsync(d_ws, 0, 32768, stream) != hipSuccess) { fprintf(stderr, "kernel_launch: memset failed\n"); return; }
    Args a{};
    for (int i = 0; i < 20; ++i) a.in[i] = (const float*)d_in[i];
    a.out = (float*)d_out; a.ws = (unsigned char*)d_ws;
    for (int i = 0; i < 16; ++i) a.invf[i] = (float)std::pow(500000.0, -(double)i / 16.0);
    void* args[] = {&a};
    hipError_t e = hipLaunchCooperativeKernel((const void*)fwd, dim3(grid_blocks), dim3(512), args, LDS_BYTES, stream);
    if (e != hipSuccess) fprintf(stderr, "cooperative launch failed: %s (grid %d)\n", hipGetErrorString(e), grid_blocks);
}
```
